# Optimizing an MI355X kernel written in HIP

```python
import math
import jax, jax.numpy as jnp
from jax import lax
import numpy as np

D_MODEL = 1024
BATCH = 8
SEQ = 4096
DEPTH = 4

PLE_DIM = 256
D_FF = 4 * D_MODEL
N_EVEN = (DEPTH + 1) // 2
N_ODD = DEPTH // 2
EPS = 1e-6
DIFF_DH = 64
DIFF_HEADS = D_MODEL // 256
DIFF_WIDTH = DIFF_HEADS * 2 * DIFF_DH
SWA_DH = 64
SWA_WIDTH = D_MODEL - DIFF_WIDTH
SWA_HEADS = SWA_WIDTH // SWA_DH
DILATED_CONFIGS = ((128, 1), (512, 4), (2048, 16))
Q_BLOCK = 128
SSM_GROUP_CH = 16
SSM_STATE = 64
SSM_WIDTH = D_MODEL // 2
SSM_GROUPS = SSM_WIDTH // SSM_GROUP_CH
CONV_WIDTH = D_MODEL - SSM_WIDTH
CONV_K = 3
EVEN_IN = 3 * DIFF_WIDTH + 3 * SWA_WIDTH
ODD_IN = SSM_WIDTH + 3 * CONV_WIDTH

kernel_name = 'hybrid_diffattn_dilated_s5_shortconv_trunk'


def rms_norm(x, g, eps=EPS):
    xf = x.astype(jnp.float32)
    y = xf * lax.rsqrt(jnp.mean(xf * xf, axis=-1, keepdims=True) + eps) * g.astype(jnp.float32)
    return y.astype(x.dtype)


def diff_attention(q, k, v, lam, sub_gain, lam_init):
    b, s, h = q.shape[:3]
    nb = s // Q_BLOCK
    scale = DIFF_DH ** -0.5
    kf = k.astype(jnp.float32)
    vf = v.astype(jnp.float32)
    qb = jnp.moveaxis(q.astype(jnp.float32).reshape(b, nb, Q_BLOCK, h, 2, DIFF_DH), 1, 0)
    kpos = jnp.arange(s)

    def block(args):
        q_blk, n = args
        sc = jnp.einsum('bqhcd,bkhcd->bhcqk', q_blk, kf) * scale
        qpos = n * Q_BLOCK + jnp.arange(Q_BLOCK)
        sc = jnp.where(kpos[None, :] <= qpos[:, None], sc, -jnp.inf)
        a = jax.nn.softmax(sc, axis=-1)
        w = a[:, :, 0] - lam * a[:, :, 1]
        return jnp.einsum('bhqk,bkhe->bqhe', w, vf)

    o = lax.map(block, (qb, jnp.arange(nb)))
    o = jnp.moveaxis(o, 0, 1).reshape(b, s, h, 2 * DIFF_DH)
    o = o * lax.rsqrt(jnp.mean(o * o, axis=-1, keepdims=True) + 1e-5) * sub_gain.astype(jnp.float32)
    o = o * (1.0 - lam_init)
    return o.reshape(b, s, h * 2 * DIFF_DH)


def strided_window_attention(q, k, v, n_back, dil):
    b, s, h, dh = q.shape
    L = s // dil
    blk = n_back
    nb = -(-L // blk)
    pad_end = nb * blk - L

    def sub(t):
        return t.astype(jnp.float32).reshape(b, L, dil, h, dh)

    qs = jnp.pad(sub(q), ((0, 0), (0, pad_end), (0, 0), (0, 0), (0, 0))).reshape(b, nb, blk, dil, h, dh)

    def band(t):
        tp = jnp.pad(sub(t), ((0, 0), (blk, pad_end), (0, 0), (0, 0), (0, 0))).reshape(b, nb + 1, blk, dil, h, dh)
        return jnp.concatenate([tp[:, :-1], tp[:, 1:]], axis=2)

    kb, vb = band(k), band(v)
    sc = jnp.einsum('bnqrhd,bnkrhd->bnrhqk', qs, kb) * dh ** -0.5
    qi = jnp.arange(blk)[:, None]
    kk = jnp.arange(2 * blk)[None, :]
    dist = blk + qi - kk
    kpos = (jnp.arange(nb)[:, None, None] - 1) * blk + kk[None]
    valid = (dist >= 0) & (dist <= n_back) & (kpos >= 0)
    sc = jnp.where(valid[None, :, None, None], sc, -jnp.inf)
    m = jnp.max(sc, axis=-1)
    e = jnp.exp(sc - m[..., None])
    den = jnp.sum(e, axis=-1)
    o = jnp.einsum('bnrhqk,bnkrhd->bnqrhd', e, vb) / jnp.moveaxis(den, -1, 2)[..., None]
    o = o.reshape(b, nb * blk, dil, h, dh)[:, :L].reshape(b, s, h, dh)
    m = jnp.moveaxis(m, -1, 2).reshape(b, nb * blk, dil, h)[:, :L].reshape(b, s, h)
    den = jnp.moveaxis(den, -1, 2).reshape(b, nb * blk, dil, h)[:, :L].reshape(b, s, h)
    return o, m, den


def dilated_attention(q, k, v):
    b, s, h, dh = q.shape
    outs = [strided_window_attention(q, k, v, w // d, d) for (w, d) in DILATED_CONFIGS]
    m_all = jnp.max(jnp.stack([m for (_, m, _) in outs]), axis=0)
    wts = [den * jnp.exp(m - m_all) for (_, m, den) in outs]
    num = sum(wt[..., None] * o for wt, (o, _, _) in zip(wts, outs))
    tot = sum(wts)
    return (num / tot[..., None]).reshape(b, s, h * dh)


def attention_mixer(h, w_in, w_out, lq1, lk1, lq2, lk2, sub_gain, lam_init):
    b, s, _ = h.shape
    proj = h @ w_in
    cuts = list(np.cumsum([DIFF_WIDTH] * 3 + [SWA_WIDTH] * 2))
    aq, ak, av, bq, bk, bv = jnp.split(proj, cuts, axis=-1)
    f32 = jnp.float32
    lam = (jnp.exp(jnp.sum(lq1.astype(f32) * lk1.astype(f32))) - jnp.exp(jnp.sum(lq2.astype(f32) * lk2.astype(f32)))
           + lam_init)
    ya = diff_attention(aq.reshape(b, s, DIFF_HEADS, 2, DIFF_DH), ak.reshape(b, s, DIFF_HEADS, 2, DIFF_DH),
                        av.reshape(b, s, DIFF_HEADS, 2 * DIFF_DH), lam, sub_gain, lam_init)
    yb = dilated_attention(bq.reshape(b, s, SWA_HEADS, SWA_DH), bk.reshape(b, s, SWA_HEADS, SWA_DH),
                           bv.reshape(b, s, SWA_HEADS, SWA_DH))
    y = jnp.concatenate([ya, yb], axis=-1).astype(h.dtype)
    return y @ w_out


def s5_mixer(u, lam_re, lam_im, log_dt, b_re, b_im, c_re, c_im, d_skip, w_glu):
    f32 = jnp.float32
    bsz, s, _ = u.shape
    uf = u.astype(f32).reshape(bsz, s, SSM_GROUPS, SSM_GROUP_CH)
    lr, li = lam_re.astype(f32), lam_im.astype(f32)
    dt = jnp.exp(log_dt.astype(f32))[:, None]
    mag = jnp.exp(lr * dt)
    abar_re, abar_im = mag * jnp.cos(li * dt), mag * jnp.sin(li * dt)
    den = lr * lr + li * li
    nr, ni = abar_re - 1.0, abar_im
    coef_re = (nr * lr + ni * li) / den
    coef_im = (ni * lr - nr * li) / den
    br, bi = b_re.astype(f32), b_im.astype(f32)
    bb_re = coef_re[..., None] * br - coef_im[..., None] * bi
    bb_im = coef_re[..., None] * bi + coef_im[..., None] * br
    bu_re = jnp.einsum('bsgc,gpc->bsgp', uf, bb_re)
    bu_im = jnp.einsum('bsgc,gpc->bsgp', uf, bb_im)
    a_re = jnp.broadcast_to(abar_re, (1, s, SSM_GROUPS, SSM_STATE))
    a_im = jnp.broadcast_to(abar_im, (1, s, SSM_GROUPS, SSM_STATE))

    def combine(e1, e2):
        a1r, a1i, b1r, b1i = e1
        a2r, a2i, b2r, b2i = e2
        return (a1r * a2r - a1i * a2i, a1r * a2i + a1i * a2r,
                a2r * b1r - a2i * b1i + b2r, a2r * b1i + a2i * b1r + b2i)

    _, _, xr, xi = lax.associative_scan(combine, (a_re, a_im, bu_re, bu_im), axis=1)
    y = (jnp.einsum('bsgp,gcp->bsgc', xr, c_re.astype(f32)) - jnp.einsum('bsgp,gcp->bsgc', xi, c_im.astype(f32))
         + d_skip.astype(f32) * uf)
    y = jax.nn.gelu(y.reshape(bsz, s, SSM_WIDTH))
    return y * jax.nn.sigmoid(y @ w_glu.astype(f32))


def short_conv_mixer(gb, gc, xt, conv_w):
    s = xt.shape[1]
    z = gc * xt
    zp = jnp.pad(z, ((0, 0), (CONV_K - 1, 0), (0, 0)))
    y = sum(conv_w[j] * zp[:, CONV_K - 1 - j: CONV_K - 1 - j + s] for j in range(CONV_K))
    return gb * y


def recurrent_conv_mixer(h, w_in, w_out, lam_re, lam_im, log_dt, b_re, b_im, c_re, c_im, d_skip, w_glu, conv_w):
    proj = h @ w_in
    u, gb, gc, xt = jnp.split(proj, [SSM_WIDTH, SSM_WIDTH + CONV_WIDTH, SSM_WIDTH + 2 * CONV_WIDTH], axis=-1)
    yc = s5_mixer(u, lam_re, lam_im, log_dt, b_re, b_im, c_re, c_im, d_skip, w_glu)
    yd = short_conv_mixer(gb, gc, xt, conv_w)
    y = jnp.concatenate([yc.astype(h.dtype), yd.astype(h.dtype)], axis=-1)
    return y @ w_out


def setup_inputs(seed: int = 0) -> dict:
    key = jax.random.key(seed)
    ks = iter(jax.random.split(key, 32))

    def nrm(shape, scale):
        return jax.random.normal(next(ks), shape, jnp.float32) * scale

    def gain(shape):
        return 1.0 + nrm(shape, 0.02)

    return {
        'x': nrm((BATCH, SEQ, D_MODEL), 1.0),
        'p': nrm((DEPTH, BATCH, SEQ, PLE_DIM), 1.0),
        'norm_mix': gain((DEPTH, D_MODEL)),
        'norm_mlp': gain((DEPTH, D_MODEL)),
        'norm_ple': gain((DEPTH, D_MODEL)),
        'w_mlp_in': nrm((DEPTH, D_MODEL, D_FF), D_MODEL ** -0.5),
        'w_mlp_out': nrm((DEPTH, D_FF, D_MODEL), D_FF ** -0.5),
        'w_ple_proj': nrm((DEPTH, PLE_DIM, D_MODEL), PLE_DIM ** -0.5),
        'w_ple_gate': nrm((DEPTH, D_MODEL, D_MODEL), D_MODEL ** -0.5),
        'attn_w_in': nrm((N_EVEN, D_MODEL, EVEN_IN), D_MODEL ** -0.5),
        'attn_w_out': nrm((N_EVEN, DIFF_WIDTH + SWA_WIDTH, D_MODEL), D_MODEL ** -0.5),
        'diff_lq1': nrm((N_EVEN, DIFF_DH), 0.1),
        'diff_lk1': nrm((N_EVEN, DIFF_DH), 0.1),
        'diff_lq2': nrm((N_EVEN, DIFF_DH), 0.1),
        'diff_lk2': nrm((N_EVEN, DIFF_DH), 0.1),
        'diff_sub_gain': gain((N_EVEN, 2 * DIFF_DH)),
        'rc_w_in': nrm((N_ODD, D_MODEL, ODD_IN), D_MODEL ** -0.5),
        'rc_w_out': nrm((N_ODD, SSM_WIDTH + CONV_WIDTH, D_MODEL), D_MODEL ** -0.5),
        'ssm_lambda_re': -0.5 + nrm((N_ODD, SSM_GROUPS, SSM_STATE), 0.01),
        'ssm_lambda_im': math.pi * jnp.arange(SSM_STATE, dtype=jnp.float32) + nrm((N_ODD, SSM_GROUPS, SSM_STATE), 0.01),
        'ssm_log_dt': jax.random.uniform(next(ks), (N_ODD, SSM_GROUPS), jnp.float32, math.log(1e-3), math.log(1e-1)),
        'ssm_b_re': nrm((N_ODD, SSM_GROUPS, SSM_STATE, SSM_GROUP_CH), (2 * SSM_GROUP_CH) ** -0.5),
        'ssm_b_im': nrm((N_ODD, SSM_GROUPS, SSM_STATE, SSM_GROUP_CH), (2 * SSM_GROUP_CH) ** -0.5),
        'ssm_c_re': nrm((N_ODD, SSM_GROUPS, SSM_GROUP_CH, SSM_STATE), (2 * SSM_STATE) ** -0.5),
        'ssm_c_im': nrm((N_ODD, SSM_GROUPS, SSM_GROUP_CH, SSM_STATE), (2 * SSM_STATE) ** -0.5),
        'ssm_d': nrm((N_ODD, SSM_GROUPS, SSM_GROUP_CH), 1.0),
        'ssm_w_glu': nrm((N_ODD, SSM_WIDTH, SSM_WIDTH), SSM_WIDTH ** -0.5),
        'conv_w': nrm((N_ODD, CONV_K, CONV_WIDTH), CONV_K ** -0.5),
        'norm_final': gain((D_MODEL,)),
    }


def reference(x, p, norm_mix, norm_mlp, norm_ple, w_mlp_in, w_mlp_out, w_ple_proj, w_ple_gate,
              attn_w_in, attn_w_out, diff_lq1, diff_lk1, diff_lq2, diff_lk2, diff_sub_gain,
              rc_w_in, rc_w_out, ssm_lambda_re, ssm_lambda_im, ssm_log_dt, ssm_b_re, ssm_b_im,
              ssm_c_re, ssm_c_im, ssm_d, ssm_w_glu, conv_w, norm_final):
    h = x
    for i in range(DEPTH):
        hn = rms_norm(h, norm_mix[i])
        if i % 2 == 0:
            e = i // 2
            lam_init = 0.8 - 0.6 * math.exp(-0.3 * i)
            y = attention_mixer(hn, attn_w_in[e], attn_w_out[e], diff_lq1[e], diff_lk1[e], diff_lq2[e],
                                diff_lk2[e], diff_sub_gain[e], lam_init)
        else:
            o = i // 2
            y = recurrent_conv_mixer(hn, rc_w_in[o], rc_w_out[o], ssm_lambda_re[o], ssm_lambda_im[o],
                                     ssm_log_dt[o], ssm_b_re[o], ssm_b_im[o], ssm_c_re[o], ssm_c_im[o],
                                     ssm_d[o], ssm_w_glu[o], conv_w[o])
        h = h + y.astype(h.dtype)
        hn = rms_norm(h, norm_mlp[i])
        h = h + jnp.square(jax.nn.relu(hn @ w_mlp_in[i])) @ w_mlp_out[i]
        hn = rms_norm(h, norm_ple[i])
        h = h + (p[i] @ w_ple_proj[i]) * jax.nn.sigmoid(hn @ w_ple_gate[i])
    return rms_norm(h, norm_final)
```

```cpp
#include <hip/hip_runtime.h>
#include <cstdio>
#include <cstdint>

template <int K> __device__ __forceinline__ float xor_add(float v) {
    if constexpr (K < 32) return v + __int_as_float(__builtin_amdgcn_ds_swizzle(__float_as_int(v), (K << 10) | 0x1f));
    else { auto rr = __builtin_amdgcn_permlane32_swap(__float_as_uint(v), __float_as_uint(v), false, false); return __uint_as_float(rr[0]) + __uint_as_float(rr[1]); }
}
template <int K> __device__ __forceinline__ float xor_max(float v) {
    if constexpr (K < 32) return fmaxf(v, __int_as_float(__builtin_amdgcn_ds_swizzle(__float_as_int(v), (K << 10) | 0x1f)));
    else { auto rr = __builtin_amdgcn_permlane32_swap(__float_as_uint(v), __float_as_uint(v), false, false); return fmaxf(__uint_as_float(rr[0]), __uint_as_float(rr[1])); }
}
namespace pg8 {
#define PG8_LAS __attribute__((address_space(3)))
typedef unsigned short bf16_t;
typedef short bf16x8 __attribute__((ext_vector_type(8)));
typedef float f32x4 __attribute__((ext_vector_type(4)));
typedef unsigned u32x4 __attribute__((ext_vector_type(4)));
constexpr int BM = 256, BK = 64, HALF = 128, HTB = HALF * BK * 2  , STAGE_BYTES = 8 * HTB, NXCD = 8, WGM = 8;

__host__ __device__ __forceinline__ int lds_byte(int r, int c) { const int st = (r >> 4) * 2 + (c >> 5), rr = r & 15, cc = c & 31, ob = rr * 64 + cc * 2; return st * 1024 + (ob ^ (((ob >> 9) & 1) << 5)); }
__host__ __device__ __forceinline__ void stage_rc(int b, int& R, int& C) { const int st = b / 1024, sb = b % 1024, swz = sb ^ (((sb >> 9) & 1) << 5); R = (st >> 1) * 16 + swz / 64; C = (st & 1) * 32 + (swz % 64) / 2; }
__host__ __device__ __forceinline__ int perm32(int rho) { const int n = rho >> 4, i = rho & 15; return 8 * (i >> 2) + 4 * n + (i & 3); }

struct Unit { int pm, pn; };
struct Gemm { const bf16_t* A; const bf16_t* Bt; int M, N, K; };

struct StaticOrder {
    int nM, nN, nwg, G, c;
    __host__ __device__ void init(int M, int N, int G_, int c_) { nM = M / BM; nN = N / BM; nwg = nM * nN; G = G_; c = c_; }
    __host__ __device__ bool next(int i, Unit& u) const {
        const long L = (long)i * G + c; if (L >= nwg) return false;
        int wgid = (int)L; { const int q = nwg / NXCD, r = nwg % NXCD, xcd = wgid % NXCD, off = wgid / NXCD; wgid = (xcd < r ? xcd * (q + 1) : r * (q + 1) + (xcd - r) * q) + off; }
        const int nig = WGM * nN, gid = wgid / nig, fm = gid * WGM, gsz = (nM - fm) < WGM ? (nM - fm) : WGM;
        u.pm = fm + ((wgid % nig) % gsz); u.pn = (wgid % nig) / gsz; return true;
    }
    __device__ __forceinline__ void a_ready(const Unit&) const {}
    __device__ __forceinline__ void done(const Unit&) const {}
};

__device__ __forceinline__ unsigned cvt_pk_bf16(float lo, float hi) { unsigned r; asm volatile("v_cvt_pk_bf16_f32 %0, %1, %2" : "=v"(r) : "v"(lo), "v"(hi)); return r; }
typedef float f32x2 __attribute__((ext_vector_type(2)));
constexpr float RMS_EPS = 1e-6f;
typedef unsigned u32x2 __attribute__((ext_vector_type(2)));
__device__ __forceinline__ float sigm(float x) { return __builtin_amdgcn_rcpf(1.0f + __expf(-x)); }
__device__ __forceinline__ float bflo(unsigned w) { return __uint_as_float(w << 16); }
__device__ __forceinline__ float bfhi(unsigned w) { return __uint_as_float(w & 0xffff0000u); }
__device__ __forceinline__ float ssq16(const float* s, int r) { const f32x4* q = (const f32x4*)(s + (size_t)r * 16); const f32x4 a = q[0] + q[1], b = q[2] + q[3], c = a + b; return (c[0] + c[1]) + (c[2] + c[3]); }
template <int ACT> struct EpiRow {
    static constexpr bool PERM = true, AFTER_DRAIN = false;
    bf16_t* O; int ldc; const float* ssq; unsigned qmask; float qscale; int split_cols; size_t split_stride;
    __device__ __forceinline__ void operator()(const f32x4 (&acc)[2][2][4][2], const Unit& u, int wr, int wc, int fr, int fq) const {
        int colt = u.pn * BM; bf16_t* Ob = O; if (split_cols) { const int t = colt / split_cols; Ob += (size_t)t * split_stride; colt -= t * split_cols; }
        const int row0 = u.pm * BM + wr * 64 + fr, col0 = colt + wc * 32 + 8 * fq;
        const float cs = ((qmask >> u.pn) & 1u) ? qscale : 1.f;
#pragma unroll
        for (int ai = 0; ai < 2; ++ai)
#pragma unroll
            for (int m = 0; m < 4; ++m) { const int r = row0 + ai * HALF + m * 16; const float rs = rsqrtf(ssq16(ssq, r) * (1.0f / 1024.0f) + RMS_EPS) * cs;
                bf16_t* rowp = Ob + (size_t)r * ldc + col0;
#pragma unroll
                for (int bj = 0; bj < 2; ++bj) { f32x4 v0 = acc[ai][bj][m][0] * rs, v1 = acc[ai][bj][m][1] * rs;
                    if (ACT == 1) {
#pragma unroll
                        for (int e = 0; e < 4; ++e) { const float a = fmaxf(v0[e], 0.f), b = fmaxf(v1[e], 0.f); v0[e] = a * a; v1[e] = b * b; } }
                    u32x4 w; w.x = cvt_pk_bf16(v0[0], v0[1]); w.y = cvt_pk_bf16(v0[2], v0[3]); w.z = cvt_pk_bf16(v1[0], v1[1]); w.w = cvt_pk_bf16(v1[2], v1[3]);
                    *(u32x4*)(rowp + bj * HALF) = w; } }
    }
};
template <int MODE> struct EpiRes {
    static constexpr bool PERM = false, AFTER_DRAIN = false;
    const bf16_t* base; bf16_t* outb; float* ssq_next; const float* ssq_cur; const bf16_t* pp;
    __device__ __forceinline__ void operator()(const f32x4 (&acc)[2][2][4][2], const Unit& u, int wr, int wc, int fr, int fq) const {
        const int row0 = u.pm * BM + wr * 64 + fr, col0 = u.pn * BM + wc * 32 + 4 * fq;
#pragma unroll
        for (int ai = 0; ai < 2; ++ai)
#pragma unroll
            for (int m = 0; m < 4; ++m) { const int r = row0 + ai * HALF + m * 16; const size_t off = (size_t)r * 1024 + col0; float sq = 0.f;
                float rs = 0.f; if (MODE == 1) rs = rsqrtf(ssq16(ssq_cur, r) * (1.0f / 1024.0f) + RMS_EPS);
#pragma unroll
                for (int bj = 0; bj < 2; ++bj)
#pragma unroll
                    for (int n = 0; n < 2; ++n) { const size_t o = off + bj * HALF + n * 16; f32x4 a = acc[ai][bj][m][n];
                        if (MODE == 1) { const u32x2 g = *(const u32x2*)(pp + o);
                            a[0] = bflo(g.x) * sigm(a[0] * rs); a[1] = bfhi(g.x) * sigm(a[1] * rs); a[2] = bflo(g.y) * sigm(a[2] * rs); a[3] = bfhi(g.y) * sigm(a[3] * rs); }
                        const u32x2 bv = *(const u32x2*)(base + o);
                        const f32x4 hv = (f32x4){bflo(bv.x), bfhi(bv.x), bflo(bv.y), bfhi(bv.y)} + a;
                        u32x2 w; w.x = cvt_pk_bf16(hv[0], hv[1]); w.y = cvt_pk_bf16(hv[2], hv[3]); *(u32x2*)(outb + o) = w;
                        sq += (hv[0] * hv[0] + hv[1] * hv[1]) + (hv[2] * hv[2] + hv[3] * hv[3]); }
                sq = xor_add<16>(sq); sq = xor_add<32>(sq);
                if (fq == 0) ssq_next[(size_t)r * 16 + u.pn * 4 + wc] = sq; }
    }
};
struct EpiPP {
    static constexpr bool PERM = false, AFTER_DRAIN = false;
    bf16_t* O;
    __device__ __forceinline__ void operator()(const f32x4 (&acc)[2][2][4][2], const Unit& u, int wr, int wc, int fr, int fq) const {
        const int row0 = u.pm * BM + wr * 64 + fr, col0 = u.pn * BM + wc * 32 + 4 * fq;
#pragma unroll
        for (int ai = 0; ai < 2; ++ai)
#pragma unroll
            for (int m = 0; m < 4; ++m) { const size_t off = (size_t)(row0 + ai * HALF + m * 16) * 1024 + col0;
#pragma unroll
                for (int bj = 0; bj < 2; ++bj)
#pragma unroll
                    for (int n = 0; n < 2; ++n) { const f32x4 a = acc[ai][bj][m][n]; u32x2 w; w.x = cvt_pk_bf16(a[0], a[1]); w.y = cvt_pk_bf16(a[2], a[3]); *(u32x2*)(O + off + bj * HALF + n * 16) = w; } }
    }
};
struct EpiGlu {
    static constexpr bool PERM = true, AFTER_DRAIN = false;
    bf16_t* O; const bf16_t* yg;
    __device__ __forceinline__ void operator()(const f32x4 (&acc)[2][2][4][2], const Unit& u, int wr, int wc, int fr, int fq) const {
        const int row0 = u.pm * BM + wr * 64 + fr, col0 = u.pn * BM + wc * 32 + 8 * fq;
#pragma unroll
        for (int ai = 0; ai < 2; ++ai)
#pragma unroll
            for (int m = 0; m < 4; ++m) { const int r = row0 + ai * HALF + m * 16;
#pragma unroll
                for (int bj = 0; bj < 2; ++bj) { const int c = col0 + bj * HALF; const u32x4 y = *(const u32x4*)(yg + (size_t)r * 512 + c);
                    const f32x4 v0 = acc[ai][bj][m][0], v1 = acc[ai][bj][m][1]; u32x4 w;
                    w.x = cvt_pk_bf16(bflo(y.x) * sigm(v0[0]), bfhi(y.x) * sigm(v0[1])); w.y = cvt_pk_bf16(bflo(y.y) * sigm(v0[2]), bfhi(y.y) * sigm(v0[3]));
                    w.z = cvt_pk_bf16(bflo(y.z) * sigm(v1[0]), bfhi(y.z) * sigm(v1[1])); w.w = cvt_pk_bf16(bflo(y.w) * sigm(v1[2]), bfhi(y.w) * sigm(v1[3]));
                    *(u32x4*)(O + (size_t)r * 1024 + c) = w; } }
    }
};
template <class Epi, class Sched, bool ALIGN_EPI = false, bool SP2 = false>
__device__ __forceinline__ void gemm_phase(PG8_LAS unsigned char* lds, const Gemm g, const Sched& S, const Epi& E) {
    int tid = threadIdx.x; asm volatile("" : "+v"(tid)); const int wid = __builtin_amdgcn_readfirstlane(tid >> 6), lane = tid & 63, wr = wid >> 2, wc = wid & 3, fr = lane & 15, fq = lane >> 4;
    const int K = g.K, nt = K / BK;
    unsigned voffA[2], voffB[2];
#pragma unroll
    for (int i = 0; i < 2; ++i) { int R, C; stage_rc(tid * 16 + i * 8192, R, C); const int Rb = Epi::PERM ? ((R & ~31) + perm32(R & 31)) : R;
        voffA[i] = (unsigned)(R * K + C) * 2u; voffB[i] = (unsigned)(Rb * K + C) * 2u; }
    const size_t kstep = (size_t)(BK * 2);
    const size_t hstep = (size_t)HALF * K * 2;
    const size_t tstep = 2 * hstep;
    const unsigned ldsw = (unsigned)wid * 1024u;
    const int aoff = lds_byte(wr * 64 + fr, fq * 8), boff = lds_byte(wc * 32 + fr, fq * 8);
#define PG8_SA(b, h) (((b) * 2 + (h)) * HTB)
#define PG8_SB(b, h) ((4 + (b) * 2 + (h)) * HTB)
#define PG8_STAGE(bufoff, gbase, voff) do { _Pragma("unroll") for (int _i = 0; _i < 2; ++_i) \
        __builtin_amdgcn_global_load_lds((const unsigned*)((const char*)(gbase) + (voff)[_i]), (PG8_LAS unsigned*)(lds + (bufoff) + ldsw + _i * 8192), 16, 0, 0); } while (0)
#define PG8_LDA(dst, b, h) do { _Pragma("unroll") for (int m = 0; m < 4; ++m) _Pragma("unroll") for (int k = 0; k < 2; ++k) dst[m][k] = *(const PG8_LAS bf16x8*)(lds + PG8_SA(b, h) + aoff + m * 2048 + k * 1024); } while (0)
#define PG8_LDB(dst, b, h) do { _Pragma("unroll") for (int n = 0; n < 2; ++n) _Pragma("unroll") for (int k = 0; k < 2; ++k) dst[n][k] = *(const PG8_LAS bf16x8*)(lds + PG8_SB(b, h) + boff + n * 2048 + k * 1024); } while (0)
#define PG8_MMA(ai, bj, At, Bt) do { __builtin_amdgcn_s_setprio(1); _Pragma("unroll") for (int m = 0; m < 4; ++m) _Pragma("unroll") for (int n = 0; n < 2; ++n) _Pragma("unroll") for (int k = 0; k < 2; ++k) \
        acc[ai][bj][m][n] = __builtin_amdgcn_mfma_f32_16x16x32_bf16(Bt[n][k], At[m][k], acc[ai][bj][m][n], 0, 0, 0); __builtin_amdgcn_s_setprio(0); } while (0)
#define PG8_WAIT_V(n) asm volatile("s_waitcnt vmcnt(" #n ")" ::: "memory")
#define PG8_WAIT_L(n) asm volatile("s_waitcnt lgkmcnt(" #n ")" ::: "memory")
#define PG8_BAR __builtin_amdgcn_s_barrier()
#define PG8_SCHED __builtin_amdgcn_sched_barrier(0)
    Unit cur, nxt; int ui = 0;
    if (!S.next(0, cur)) return;
    f32x4 acc[2][2][4][2];
#pragma unroll
    for (int a = 0; a < 2; ++a)
#pragma unroll
        for (int b = 0; b < 2; ++b)
#pragma unroll
            for (int m = 0; m < 4; ++m)
#pragma unroll
                for (int n = 0; n < 2; ++n) acc[a][b][m][n] = (f32x4){0.f, 0.f, 0.f, 0.f};
    bf16x8 At[4][2], B0[2][2], B1[2][2];
    const char* cA = (const char*)g.A + (size_t)cur.pm * tstep; const char* cB = (const char*)g.Bt + (size_t)cur.pn * tstep;
    S.a_ready(cur);
    if constexpr (SP2) {
        PG8_STAGE(PG8_SB(0, 0), cB, voffB); PG8_STAGE(PG8_SB(0, 1), cB + hstep, voffB); PG8_STAGE(PG8_SA(0, 0), cA, voffA); PG8_STAGE(PG8_SA(0, 1), cA + hstep, voffA);
        if (wr == 1) PG8_BAR;
        PG8_WAIT_V(2); PG8_BAR;
        PG8_STAGE(PG8_SB(1, 0), cB + kstep, voffB); PG8_STAGE(PG8_SA(1, 0), cA + kstep, voffA); PG8_STAGE(PG8_SB(1, 1), cB + hstep + kstep, voffB);
        PG8_WAIT_V(6); PG8_BAR;
    } else {
        PG8_STAGE(PG8_SB(0, 0), cB, voffB); PG8_STAGE(PG8_SA(0, 0), cA, voffA); PG8_STAGE(PG8_SB(0, 1), cB + hstep, voffB); PG8_STAGE(PG8_SA(0, 1), cA + hstep, voffA);
        if (wr == 1) PG8_BAR;
        PG8_WAIT_V(4); PG8_BAR;
        PG8_STAGE(PG8_SB(1, 0), cB + kstep, voffB); PG8_STAGE(PG8_SA(1, 0), cA + kstep, voffA); PG8_STAGE(PG8_SB(1, 1), cB + hstep + kstep, voffB);
        PG8_WAIT_V(6); PG8_BAR;
    }
    for (;;) {
        const bool has_next = S.next(ui + 1, nxt);
        const char* nA = has_next ? (const char*)g.A + (size_t)nxt.pm * tstep : cA; const char* nB = has_next ? (const char*)g.Bt + (size_t)nxt.pn * tstep : cB;
        for (int t = 0; t < nt; t += 2) {
            const bool last = (t == nt - 2);
            const char* a1 = cA + (size_t)(t + 1) * kstep;
            const char* a2 = last ? nA : cA + (size_t)(t + 2) * kstep; const char* b2 = last ? nB : cB + (size_t)(t + 2) * kstep;
            const char* a3 = a2 + kstep; const char* b3 = b2 + kstep;
            if (last && has_next) S.a_ready(nxt);
            if constexpr (SP2) {
            PG8_LDB(B0, 0, 0); PG8_LDB(B1, 0, 1); PG8_SCHED; PG8_LDA(At, 0, 0); PG8_STAGE(PG8_SA(1, 1), a1 + hstep, voffA);
            PG8_WAIT_V(8); PG8_WAIT_L(0); PG8_BAR; PG8_MMA(0, 0, At, B0); PG8_MMA(0, 1, At, B1); PG8_BAR; PG8_SCHED;
            PG8_LDA(At, 0, 1); PG8_STAGE(PG8_SB(0, 0), b2, voffB); PG8_STAGE(PG8_SB(0, 1), b2 + hstep, voffB); PG8_STAGE(PG8_SA(0, 0), a2, voffA);
            PG8_WAIT_V(8); PG8_WAIT_L(0); PG8_BAR; PG8_MMA(1, 0, At, B0); PG8_MMA(1, 1, At, B1); PG8_BAR; PG8_SCHED;
            PG8_LDB(B0, 1, 0); PG8_LDB(B1, 1, 1); PG8_SCHED; PG8_LDA(At, 1, 0); PG8_STAGE(PG8_SA(0, 1), a2 + hstep, voffA);
            PG8_WAIT_V(8); PG8_WAIT_L(0); PG8_BAR; PG8_MMA(0, 0, At, B0); PG8_MMA(0, 1, At, B1); PG8_BAR; PG8_SCHED;
            PG8_LDA(At, 1, 1); PG8_STAGE(PG8_SB(1, 0), b3, voffB); PG8_STAGE(PG8_SB(1, 1), b3 + hstep, voffB); PG8_STAGE(PG8_SA(1, 0), a3, voffA);
            PG8_WAIT_V(8); PG8_WAIT_L(0); PG8_BAR; PG8_MMA(1, 0, At, B0); PG8_MMA(1, 1, At, B1); PG8_BAR; PG8_SCHED;
            } else {
            PG8_LDB(B0, 0, 0); PG8_SCHED; PG8_LDA(At, 0, 0); PG8_STAGE(PG8_SA(1, 1), a1 + hstep, voffA);
            PG8_WAIT_L(8); PG8_BAR; PG8_WAIT_L(0); PG8_MMA(0, 0, At, B0); PG8_BAR; PG8_SCHED;
            PG8_LDB(B1, 0, 1); PG8_STAGE(PG8_SB(0, 0), b2, voffB);
            PG8_BAR; PG8_WAIT_L(0); PG8_MMA(0, 1, At, B1); PG8_BAR;
            PG8_LDA(At, 0, 1); PG8_STAGE(PG8_SA(0, 0), a2, voffA);
            PG8_BAR; PG8_WAIT_L(0); PG8_MMA(1, 0, At, B0); PG8_BAR; PG8_SCHED;
            PG8_STAGE(PG8_SB(0, 1), b2 + hstep, voffB);
            PG8_WAIT_V(6); PG8_BAR; PG8_MMA(1, 1, At, B1); PG8_BAR;
            PG8_LDB(B0, 1, 0); PG8_SCHED; PG8_LDA(At, 1, 0); PG8_STAGE(PG8_SA(0, 1), a2 + hstep, voffA);
            PG8_WAIT_L(8); PG8_BAR; PG8_WAIT_L(0); PG8_MMA(0, 0, At, B0); PG8_BAR; PG8_SCHED;
            PG8_LDB(B1, 1, 1); PG8_STAGE(PG8_SB(1, 0), b3, voffB);
            PG8_BAR; PG8_WAIT_L(0); PG8_MMA(0, 1, At, B1); PG8_BAR;
            PG8_LDA(At, 1, 1); PG8_STAGE(PG8_SA(1, 0), a3, voffA);
            PG8_BAR; PG8_WAIT_L(0); PG8_MMA(1, 0, At, B0); PG8_BAR; PG8_SCHED;
            PG8_STAGE(PG8_SB(1, 1), b3 + hstep, voffB);
            PG8_WAIT_V(6); PG8_BAR; PG8_MMA(1, 1, At, B1); PG8_BAR;
            }
        }
        if constexpr (ALIGN_EPI) { if (wr == 0) PG8_BAR; }
        if constexpr (!Epi::AFTER_DRAIN) { E(acc, cur, wr, wc, fr, fq); S.done(cur); }
        if (!has_next) break;
#pragma unroll
        for (int a = 0; a < 2; ++a)
#pragma unroll
            for (int b = 0; b < 2; ++b)
#pragma unroll
                for (int m = 0; m < 4; ++m)
#pragma unroll
                    for (int n = 0; n < 2; ++n) acc[a][b][m][n] = (f32x4){0.f, 0.f, 0.f, 0.f};
        cur = nxt; cA = nA; cB = nB; ++ui;
        if constexpr (ALIGN_EPI) { if (wr == 1) PG8_BAR; }
    }
    PG8_WAIT_V(0);
    if constexpr (!ALIGN_EPI) { if (wr == 0) PG8_BAR; }
    PG8_BAR;
    if constexpr (Epi::AFTER_DRAIN) { E.fused(acc, cur, wr, wc, fr, fq, lds, wid, lane); S.done(cur); }
#undef PG8_SA
#undef PG8_SB
#undef PG8_STAGE
#undef PG8_LDA
#undef PG8_LDB
#undef PG8_MMA
#undef PG8_WAIT_V
#undef PG8_WAIT_L
#undef PG8_BAR
#undef PG8_SCHED
}
}
#include <hip/hip_bf16.h>
#include <cmath>
namespace attn_body {
using bf16=__hip_bfloat16;
using bf16x8=__attribute__((ext_vector_type(8)))short;
using s16x4=__attribute__((ext_vector_type(4)))short;
using f32x16=__attribute__((ext_vector_type(16)))float;
using u32x4=__attribute__((ext_vector_type(4)))unsigned;
constexpr int SEQ=4096,D=64,PQ=512,PO=1024;
constexpr int NW=8,QBLK=32,QB=QBLK*NW,KVBLK=64,NQB=SEQ/QB;

__device__ __forceinline__ int crow(int r,int hi){return (r&3)+8*(r>>2)+4*hi;}
#define SBAR() __builtin_amdgcn_sched_barrier(0)
__device__ __forceinline__ void cmask(f32x16&p0,f32x16&p1,int jb,int qrel,int hi){
  const float NEG=-INFINITY; int kb=64*jb+4*hi;
  #pragma unroll
  for(int r=0;r<16;++r){int kv=kb+(r&3)+8*(r>>2); if(kv>qrel)p0[r]=NEG; if(kv+32>qrel)p1[r]=NEG;}
}

constexpr int NSLOT=3, SLOTB=8192;
constexpr int LDS_K=0, LDS_V=NSLOT*SLOTB, LDS_WS=2*NSLOT*SLOTB, LDS_OST=LDS_WS+NW*64*4, LDS_BYTES=LDS_OST+NW*4096;
constexpr float C2=0.125f*1.4426950408889634f;
__device__ __forceinline__ void glds16(const void*gsrc,unsigned lds_dst){unsigned keep;
  asm volatile("s_mov_b32 %0, m0\n\ts_mov_b32 m0, %2\n\ts_nop 0\n\tglobal_load_lds_dwordx4 %1, off\n\ts_mov_b32 m0, %0":"=&s"(keep):"v"(gsrc),"s"(lds_dst):"memory");}
__device__ __forceinline__ float max3f(float a,float b,float c){float r;asm("v_max3_f32 %0, %1, %2, %3":"=v"(r):"v"(a),"v"(b),"v"(c));return r;}
__device__ __forceinline__ float max2f(float a,float b){float r;asm("v_max_f32_e32 %0, %1, %2":"=v"(r):"v"(a),"v"(b));return r;}
__device__ __forceinline__ float fadd_s(float a,float b){float r;asm("v_add_f32_e32 %0, %1, %2":"=v"(r):"v"(a),"v"(b));return r;}
__device__ __forceinline__ float fsub_s(float a,float b){float r;asm("v_sub_f32_e32 %0, %1, %2":"=v"(r):"v"(a),"v"(b));return r;}
typedef float f32x2_t __attribute__((ext_vector_type(2))); typedef __bf16 bf16x2_t __attribute__((ext_vector_type(2)));
__device__ __forceinline__ unsigned cvtpk_s(float lo,float hi){f32x2_t v={lo,hi};bf16x2_t b=__builtin_convertvector(v,bf16x2_t);return __builtin_bit_cast(unsigned,b);}
#define WAIT_BAR(N) asm volatile("s_waitcnt vmcnt(" #N ") lgkmcnt(0)\n\ts_barrier":::"memory")

__device__ __forceinline__ void qkt(f32x16&p0,f32x16&p1,const char*Kslot,const bf16x8*qr,const f32x16&negm,int r32,int hi){
  const char*kb=Kslot+hi*1024+r32*16;
  #pragma unroll
  for(int d0=0;d0<4;++d0){
    const bf16x8 b0=*reinterpret_cast<const bf16x8*>(kb+d0*2048);
    const bf16x8 b1=*reinterpret_cast<const bf16x8*>(kb+d0*2048+512);
    if(d0==0){p0=__builtin_amdgcn_mfma_f32_32x32x16_bf16(b0,qr[0],negm,0,0,0);p1=__builtin_amdgcn_mfma_f32_32x32x16_bf16(b1,qr[0],negm,0,0,0);}
    else{p0=__builtin_amdgcn_mfma_f32_32x32x16_bf16(b0,qr[d0],p0,0,0,0);p1=__builtin_amdgcn_mfma_f32_32x32x16_bf16(b1,qr[d0],p1,0,0,0);}}
}
typedef __attribute__((address_space(3))) const char* lds_cptr;
typedef short v4i16_t __attribute__((ext_vector_type(4)));
__device__ __forceinline__ void kload8(bf16x8*kf,lds_cptr kp){
  kf[0]=*(const __attribute__((address_space(3))) bf16x8*)(kp);      kf[1]=*(const __attribute__((address_space(3))) bf16x8*)(kp+512);
  kf[2]=*(const __attribute__((address_space(3))) bf16x8*)(kp+2048); kf[3]=*(const __attribute__((address_space(3))) bf16x8*)(kp+2560);
  kf[4]=*(const __attribute__((address_space(3))) bf16x8*)(kp+4096); kf[5]=*(const __attribute__((address_space(3))) bf16x8*)(kp+4608);
  kf[6]=*(const __attribute__((address_space(3))) bf16x8*)(kp+6144); kf[7]=*(const __attribute__((address_space(3))) bf16x8*)(kp+6656);
}
__device__ __forceinline__ void kload2(bf16x8*kf,lds_cptr kp,int j){ kf[2*j]=*(const __attribute__((address_space(3))) bf16x8*)(kp+j*2048); kf[2*j+1]=*(const __attribute__((address_space(3))) bf16x8*)(kp+j*2048+512); }
__device__ __forceinline__ s16x4 vtr(lds_cptr p){ return __builtin_bit_cast(s16x4,__builtin_amdgcn_ds_read_tr16_b64_v4i16((__attribute__((address_space(3))) v4i16_t*)p)); }
__device__ __forceinline__ float rowmax(const f32x16&p0,const f32x16&p1){
  float a=max3f(p0[0],p0[1],p1[0]),b=max3f(p0[2],p0[3],p1[1]);a=max3f(a,p1[2],p1[3]);
  #pragma unroll
  for(int r=4;r<16;r+=4){a=max3f(a,p0[r],p0[r+1]);b=max3f(b,p0[r+2],p0[r+3]);a=max3f(a,p1[r],p1[r+1]);b=max3f(b,p1[r+2],p1[r+3]);}
  const float m=max2f(a,b);
  auto rr=__builtin_amdgcn_permlane32_swap(__float_as_uint(m),__float_as_uint(m),false,false);
  return max2f(__uint_as_float(rr[0]),__uint_as_float(rr[1]));
}
__device__ __forceinline__ void pv(f32x16*o,int vb,bf16x8 pa0,bf16x8 pa1,bf16x8 pa2,bf16x8 pa3){
  #pragma unroll
  for(int d0=0;d0<2;++d0){s16x4 lo[4],hi[4];
    #pragma unroll
    for(int ks=0;ks<4;++ks){
      asm volatile("ds_read_b64_tr_b16 %0,%1 offset:%c2":"=&v"(lo[ks]):"v"(vb),"i"(d0*4096+ks*1024):"memory");
      asm volatile("ds_read_b64_tr_b16 %0,%1 offset:%c2":"=&v"(hi[ks]):"v"(vb),"i"(d0*4096+ks*1024+512):"memory");}
    asm volatile("s_waitcnt lgkmcnt(0)":::"memory");SBAR();
    #define PK(k) (bf16x8){lo[k][0],lo[k][1],lo[k][2],lo[k][3],hi[k][0],hi[k][1],hi[k][2],hi[k][3]}
    o[d0]=__builtin_amdgcn_mfma_f32_32x32x16_bf16(pa0,PK(0),o[d0],0,0,0);
    o[d0]=__builtin_amdgcn_mfma_f32_32x32x16_bf16(pa1,PK(1),o[d0],0,0,0);
    o[d0]=__builtin_amdgcn_mfma_f32_32x32x16_bf16(pa2,PK(2),o[d0],0,0,0);
    o[d0]=__builtin_amdgcn_mfma_f32_32x32x16_bf16(pa3,PK(3),o[d0],0,0,0);
    #undef PK
  }
}

#ifndef ATTN_STORE16
#define ATTN_STORE16(p,v) (*(u32x4*)(p)=(v))
#endif
template<int THRL> __device__ __forceinline__ void attn_unit(int b,int h,int qb,const bf16*Q,const bf16*__restrict__ K,const bf16*__restrict__ V,bf16*O,char*shm){
  int tid=threadIdx.x; asm volatile("":"+v"(tid)); const int lane=tid&63,r32=lane&31,hi=lane>>5; const int wid=__builtin_amdgcn_readfirstlane(tid>>6);
  const long rowbase=(long)b*SEQ; const int q0=qb*QB;
  const bf16*Qw=Q+(rowbase+q0+wid*QBLK)*PQ;
  const bf16*Kh=K+rowbase*PQ,*Vh=V+rowbase*PQ;
  const unsigned lds0=(unsigned)(uintptr_t)shm;
  float*wsf=(float*)(shm+LDS_WS)+wid*64;
  const bf16*ksrc=Kh+(long)lane*PQ+wid*8;
  const bf16*vsrc=Vh+(long)(16*(wid&3)+(lane>>2))*PQ+(wid>>2)*32+(lane&3)*8;
  const unsigned kdst=lds0+LDS_K+wid*1024, vdst=lds0+LDS_V+wid*1024;
  #define DMA_K(t,slot) glds16(ksrc+(long)(t)*KVBLK*PQ,(unsigned)__builtin_amdgcn_readfirstlane(kdst+(slot)))
  #define DMA_V(t,slot) glds16(vsrc+(long)(t)*KVBLK*PQ,(unsigned)__builtin_amdgcn_readfirstlane(vdst+(slot)))
  const int vb0=(int)(lds0+LDS_V)+((lane>>4)&1)*32+(lane&3)*8+(4*hi+((lane&15)>>2))*64;
  const char*Kbase=shm+LDS_K; bf16x8 kf[8];
  const lds_cptr shm3=(lds_cptr)shm; const lds_cptr kp0=shm3+LDS_K+hi*1024+r32*16; const lds_cptr vp0=shm3+LDS_V+((lane>>4)&1)*32+(lane&3)*8+(4*hi+((lane&15)>>2))*64;
  const int NT=(q0+QB)/KVBLK;
  DMA_K(0,0);DMA_V(0,0);DMA_K(1,SLOTB);
  bf16x8 qr[4];
  #pragma unroll
  for(int d0=0;d0<4;++d0)qr[d0]=*reinterpret_cast<const bf16x8*>(&Qw[(long)r32*PQ+d0*16+hi*8]);
  float mhat=0.f,l_reg=0.f;f32x16 o[2];o[0]=f32x16{};o[1]=f32x16{};float zz_=0.f;asm volatile("":"+v"(zz_));f32x16 negm;
  _Pragma("unroll") for(int r=0;r<16;++r)negm[r]=zz_;
  const int qrel=wid*QBLK+r32;
  #define CMASK(P0,P1,t) do{int jb_=(t)-(NT-4); if(jb_>=0)cmask(P0,P1,jb_,qrel,hi);}while(0)
  bool resc=false;
  #define START(P0,P1) do{ const float rm=rowmax(P0,P1); resc=false; \
    { const float dl=rm; mhat=fadd_s(mhat,dl); \
      _Pragma("unroll") for(int r=0;r<16;++r){P0[r]=fsub_s(P0[r],dl);P1[r]=fsub_s(P1[r],dl);} \
      _Pragma("unroll") for(int r=0;r<16;++r)negm[r]=-mhat; asm volatile("":"+v"(negm)); } \
    _Pragma("unroll") for(int r=0;r<16;++r)P0[r]=__builtin_amdgcn_exp2f(P0[r]); }while(0)
  #define RESC() do{ if(resc){ asm volatile("s_waitcnt lgkmcnt(0)":::"memory"); \
      _Pragma("unroll") for(int d_=0;d_<2;++d_) _Pragma("unroll") for(int r=0;r<16;++r)o[d_][r]*=wsf[crow(r,hi)]; } }while(0)
  f32x16 pA0,pA1,pB0,pB1;
  int sl_prev=0,sl_cur=0,sl_next=SLOTB;
  #define ROT() do{sl_prev=sl_cur;sl_cur=sl_next;sl_next=(sl_next==(NSLOT-1)*SLOTB)?0:sl_next+SLOTB;}while(0)
  DMA_K(2,2*SLOTB);
  WAIT_BAR(3);
  qkt(pA0,pA1,Kbase,qr,negm,r32,hi);asm volatile("s_nop 15\n\ts_nop 7":"+v"(pA0),"+v"(pA1));CMASK(pA0,pA1,0);
  START(pA0,pA1);
  _Pragma("unroll") for(int r=0;r<16;++r)pA1[r]=__builtin_amdgcn_exp2f(pA1[r]);
  WAIT_BAR(0);
  DMA_K(3,0);DMA_V(1,SLOTB);
  ROT();
  kload8(kf,kp0+sl_cur);
  WAIT_BAR(2);
  s16x4 vlo[8],vhi[8]; u32x4 pw0,pw1,pw2,pw3;
  #define PKW(P,B) cvtpk_s(P[B],P[B+1])
  #define PAF(k) __builtin_bit_cast(bf16x8,pw##k)
  #define VFR(i) (bf16x8){vlo[i][0],vlo[i][1],vlo[i][2],vlo[i][3],vhi[i][0],vhi[i][1],vhi[i][2],vhi[i][3]}
  #define PIN(x) asm volatile("":"+v"(x))
  #define MX3(a,b,c) __builtin_fmaxf(__builtin_fmaxf((a),(b)),(c))
  #define GAPA(MF,A0,A1,A2,A3,W0,W1,PW) do{ MF; sacc+=A0; sacc+=A1; sacc+=A2; sacc+=A3; PIN(sacc); W0; W1; PIN(PW); SBAR(); }while(0)
  #define EX(v) __builtin_amdgcn_exp2f(v)
  #define GAPB(MF,X,B) do{ MF; X[B]=EX(X[B]); X[B+1]=EX(X[B+1]); X[B+2]=EX(X[B+2]); X[B+3]=EX(X[B+3]); PIN(X); SBAR(); }while(0)
  #define VRD(i) do{ vlo[i]=vtr(vp_+(((i)>>2)*4096+((i)&3)*1024)); vhi[i]=vtr(vp_+(((i)>>2)*4096+((i)&3)*1024+512)); }while(0)
  #define KRD(G,j) do{ if(G){ kload2(kf,kp0+sl_next,j); SBAR(); } }while(0)
  #define STEP(C0,C1,P0,P1,t,GK,GV,GL) do{ SBAR(); \
    const lds_cptr vp_=vp0+sl_prev; \
    VRD(0); SBAR(); float sacc=(P0[0]+P0[1]); \
    GAPA(C0=__builtin_amdgcn_mfma_f32_32x32x16_bf16(kf[0],qr[0],negm,0,0,0), P0[2],P0[3],P0[4],P0[5],     pw0[0]=PKW(P0,0), pw0[1]=PKW(P0,2), pw0); \
    VRD(4); SBAR(); GAPA(C1=__builtin_amdgcn_mfma_f32_32x32x16_bf16(kf[1],qr[0],negm,0,0,0), P0[6],P0[7],P0[8],P0[9],     pw0[2]=PKW(P0,4), pw0[3]=PKW(P0,6), pw0); \
    VRD(1); SBAR(); GAPA(C0=__builtin_amdgcn_mfma_f32_32x32x16_bf16(kf[2],qr[1],C0,0,0,0),   P0[10],P0[11],P0[12],P0[13], pw1[0]=PKW(P0,8), pw1[1]=PKW(P0,10), pw1); \
    VRD(5); SBAR(); GAPA(C1=__builtin_amdgcn_mfma_f32_32x32x16_bf16(kf[3],qr[1],C1,0,0,0),   P0[14],P0[15],P1[0],P1[1],   pw1[2]=PKW(P0,12),pw1[3]=PKW(P0,14), pw1); \
    VRD(2); SBAR(); GAPA(C0=__builtin_amdgcn_mfma_f32_32x32x16_bf16(kf[4],qr[2],C0,0,0,0),   P1[2],P1[3],P1[4],P1[5],     pw2[0]=PKW(P1,0), pw2[1]=PKW(P1,2), pw2); \
    VRD(6); SBAR(); GAPA(C1=__builtin_amdgcn_mfma_f32_32x32x16_bf16(kf[5],qr[2],C1,0,0,0),   P1[6],P1[7],P1[8],P1[9],     pw2[2]=PKW(P1,4), pw2[3]=PKW(P1,6), pw2); \
    VRD(3); SBAR(); GAPA(C0=__builtin_amdgcn_mfma_f32_32x32x16_bf16(kf[6],qr[3],C0,0,0,0),   P1[10],P1[11],P1[12],P1[13], pw3[0]=PKW(P1,8), pw3[1]=PKW(P1,10), pw3); \
    VRD(7); SBAR(); GAPA(C1=__builtin_amdgcn_mfma_f32_32x32x16_bf16(kf[7],qr[3],C1,0,0,0),   P1[14],P1[15],0.f,0.f,       pw3[2]=PKW(P1,12),pw3[3]=PKW(P1,14), pw3); \
    l_reg+=sacc; \
    if(GK){DMA_K((t)+3,sl_cur);} if(GV){DMA_V((t)+1,sl_next);} \
    CMASK(C0,C1,t); \
    { float a=MX3(C0[0],C0[1],C1[0]),b=MX3(C0[2],C0[3],C1[1]); a=MX3(a,C1[2],C1[3]); \
      _Pragma("unroll") for(int r=4;r<16;r+=4){a=MX3(a,C0[r],C0[r+1]);b=MX3(b,C0[r+2],C0[r+3]);a=MX3(a,C1[r],C1[r+1]);b=MX3(b,C1[r+2],C1[r+3]);} \
      float rm=__builtin_fmaxf(a,b); { auto rr=__builtin_amdgcn_permlane32_swap(__float_as_uint(rm),__float_as_uint(rm),false,false); rm=__builtin_fmaxf(__uint_as_float(rr[0]),__uint_as_float(rr[1])); } \
      resc=false; \
      if(__builtin_expect(__any(rm>(float)THRL),0)){ const float dl=__builtin_fmaxf(rm,0.f); mhat+=dl; \
        _Pragma("unroll") for(int r=0;r<16;++r){C0[r]-=dl;C1[r]-=dl;} \
        _Pragma("unroll") for(int r=0;r<16;++r)negm[r]=-mhat; asm volatile("":"+v"(negm)); \
        const float f=__builtin_amdgcn_exp2f(-dl); l_reg*=f; if(hi==0)wsf[r32]=f; resc=true; } } \
    SBAR(); \
    GAPB(o[0]=__builtin_amdgcn_mfma_f32_32x32x16_bf16(PAF(0),VFR(0),o[0],0,0,0), C0,0); \
    GAPB(o[1]=__builtin_amdgcn_mfma_f32_32x32x16_bf16(PAF(0),VFR(4),o[1],0,0,0), C0,4); \
    KRD(GL,0); GAPB(o[0]=__builtin_amdgcn_mfma_f32_32x32x16_bf16(PAF(1),VFR(1),o[0],0,0,0), C0,8); \
    KRD(GL,1); GAPB(o[1]=__builtin_amdgcn_mfma_f32_32x32x16_bf16(PAF(1),VFR(5),o[1],0,0,0), C0,12); \
    KRD(GL,2); GAPB(o[0]=__builtin_amdgcn_mfma_f32_32x32x16_bf16(PAF(2),VFR(2),o[0],0,0,0), C1,0); \
    KRD(GL,3); GAPB(o[1]=__builtin_amdgcn_mfma_f32_32x32x16_bf16(PAF(2),VFR(6),o[1],0,0,0), C1,4); \
    GAPB(o[0]=__builtin_amdgcn_mfma_f32_32x32x16_bf16(PAF(3),VFR(3),o[0],0,0,0), C1,8); \
    GAPB(o[1]=__builtin_amdgcn_mfma_f32_32x32x16_bf16(PAF(3),VFR(7),o[1],0,0,0), C1,12); \
    }while(0)
  int t=1;
  #undef CMASK
  #define CMASK(P0,P1,t) do{}while(0)
  for(;t+5<NT;t+=2){
    STEP(pB0,pB1,pA0,pA1,t,true,true,true);     WAIT_BAR(2); RESC(); ROT();
    STEP(pA0,pA1,pB0,pB1,t+1,true,true,true);   WAIT_BAR(2); RESC(); ROT();
  }
  #undef CMASK
  #define CMASK(P0,P1,t) do{int jb_=(t)-(NT-4); if(jb_>=0)cmask(P0,P1,jb_,qrel,hi);}while(0)
  #define ENDW(tt) do{ if((tt)+3<NT){WAIT_BAR(2);} else if((tt)+2<NT){WAIT_BAR(1);} else {WAIT_BAR(0);} }while(0)
  for(;t+1<NT;t+=2){
    STEP(pB0,pB1,pA0,pA1,t,(t+3<NT),(t+1<NT),(t+1<NT));       ENDW(t);   RESC(); ROT();
    STEP(pA0,pA1,pB0,pB1,t+1,(t+4<NT),(t+2<NT),(t+2<NT));     ENDW(t+1); RESC(); ROT();
  }
  STEP(pB0,pB1,pA0,pA1,NT-1,false,false,false); RESC();
  { float sacc=pB0[0]+pB0[1]; _Pragma("unroll") for(int r=2;r<16;++r)sacc+=pB0[r]; _Pragma("unroll") for(int r=0;r<16;++r)sacc+=pB1[r]; l_reg+=sacc;
    pw0=(u32x4){PKW(pB0,0),PKW(pB0,2),PKW(pB0,4),PKW(pB0,6)};pw1=(u32x4){PKW(pB0,8),PKW(pB0,10),PKW(pB0,12),PKW(pB0,14)};pw2=(u32x4){PKW(pB1,0),PKW(pB1,2),PKW(pB1,4),PKW(pB1,6)};pw3=(u32x4){PKW(pB1,8),PKW(pB1,10),PKW(pB1,12),PKW(pB1,14)};
    SBAR(); pv(o,vb0+sl_cur,PAF(0),PAF(1),PAF(2),PAF(3)); }
  #undef PKW
  #undef PAF
  #undef VFR
  #undef PIN
  #undef MX3
  #undef GAPA
  #undef GAPB
  #undef EX
  #undef VRD
  #undef KRD
  #undef STEP
  #undef ENDW
  {auto rr=__builtin_amdgcn_permlane32_swap(__float_as_uint(l_reg),__float_as_uint(l_reg),false,false);l_reg=__uint_as_float(rr[0])+__uint_as_float(rr[1]);}
  if(hi==0)wsf[32+r32]=l_reg;asm volatile("s_waitcnt lgkmcnt(0)":::"memory");
  float rli[16];
  #pragma unroll
  for(int r=0;r<16;++r)rli[r]=__builtin_amdgcn_rcpf(wsf[32+crow(r,hi)]);
  bf16*Ow=O+(rowbase+q0+wid*QBLK)*PO;
  { bf16*stg=(bf16*)(shm+LDS_OST)+wid*2048;
    #pragma unroll
    for(int r=0;r<16;++r){const int orow=crow(r,hi);
      #pragma unroll
      for(int d0=0;d0<2;++d0)stg[orow*64+d0*32+r32]=__float2bfloat16(o[d0][r]*rli[r]);}
    asm volatile("s_waitcnt lgkmcnt(0)":::"memory");
    #pragma unroll
    for(int i=0;i<4;++i){const int row=i*8+(lane>>3),ch=lane&7; const u32x4 v=*(const u32x4*)(stg+row*64+ch*8); ATTN_STORE16(Ow+(long)row*PO+ch*8,v);} }
  asm volatile("s_waitcnt lgkmcnt(0)\n\ts_barrier":::"memory");
  #undef DMA_K
  #undef DMA_V
  #undef CMASK
  #undef START
  #undef RESC
  #undef ROT
}
constexpr int ATTN_LDS_BYTES=LDS_BYTES;
#undef SBAR
#undef WAIT_BAR
}
#include <hip/hip_cooperative_groups.h>
namespace cg = cooperative_groups;
namespace mk {
typedef unsigned short bf16_t;
typedef short bf16x8 __attribute__((ext_vector_type(8)));
typedef short s16x4 __attribute__((ext_vector_type(4)));
typedef float f32x4 __attribute__((ext_vector_type(4)));
typedef float f32x16 __attribute__((ext_vector_type(16)));
typedef unsigned u32x4 __attribute__((ext_vector_type(4)));
typedef unsigned u32x2 __attribute__((ext_vector_type(2)));
typedef float f32x2_t __attribute__((ext_vector_type(2))); typedef __bf16 bf16x2_t __attribute__((ext_vector_type(2)));
constexpr int T = 32768, S = 4096;
constexpr size_t TSQ = (size_t)T * 512;
constexpr size_t MiB = 1u << 20;
constexpr size_t WS_SSQ = 0, WS_DML = 4 * MiB, WS_W = 6 * MiB, WS_WL = 18 * MiB + MiB / 2, WS_WM = WS_W + 74 * MiB, WS_PB = 112 * MiB, WS_HB = 128 * MiB, WS_YMIX = 192 * MiB, WS_BIG = 256 * MiB, WS_O16 = WS_BIG + 192 * MiB, WS_END = 512 * MiB;
constexpr int LDS_BYTES = 147456;
constexpr float C2 = 0.125f * 1.4426950408889634f;
struct Params { const float* in[29]; float* out; unsigned char* ws; };

__device__ __forceinline__ unsigned pk2(float lo, float hi) { f32x2_t v = {lo, hi}; bf16x2_t b = __builtin_convertvector(v, bf16x2_t); return __builtin_bit_cast(unsigned, b); }
__device__ __forceinline__ float bflo(unsigned w) { return __uint_as_float(w << 16); }
__device__ __forceinline__ float bfhi(unsigned w) { return __uint_as_float(w & 0xffff0000u); }
__device__ __forceinline__ float bf1(bf16_t h) { return __uint_as_float((unsigned)h << 16); }
__device__ __forceinline__ float wave_sum(float v) {
v = xor_add<1>(v); v = xor_add<2>(v); v = xor_add<4>(v); v = xor_add<8>(v); v = xor_add<16>(v); v = xor_add<32>(v);
    return v;
}
#define WAVE_LDS_SYNC() asm volatile("s_waitcnt lgkmcnt(0)" ::: "memory")
__device__ __forceinline__ int crow(int r, int hi) { return (r & 3) + 8 * (r >> 2) + 4 * hi; }

__device__ __forceinline__ void transpose_items(const float* W, int K, int N, const float* gain, bf16_t* WT, float* scr, int gw, int ngw, int lane) {
    const int nblk = N / 32, nitems = (K / 64) * nblk;
    const int lr = lane >> 3, lc = (lane & 7) * 4;
    f32x4 r[8];
    int it = gw;
    if (it < nitems) { const int k0 = 64 * (it / nblk), n0 = 32 * (it % nblk);
#pragma unroll
        for (int i = 0; i < 8; ++i) r[i] = *(const f32x4*)(W + (size_t)(k0 + lr + 8 * i) * N + n0 + lc); }
    for (; it < nitems; it += ngw) {
        const int kb = it / nblk, nb = it % nblk, k0 = 64 * kb, n0 = 32 * nb;
#pragma unroll
        for (int i = 0; i < 8; ++i) { const int kk = lr + 8 * i; const float g = gain ? gain[k0 + kk] : 1.0f; float* d = scr + kk * 33 + lc;
            d[0] = r[i][0] * g; d[1] = r[i][1] * g; d[2] = r[i][2] * g; d[3] = r[i][3] * g; }
        WAVE_LDS_SYNC();
        const int itn = it + ngw;
        if (itn < nitems) { const int k1 = 64 * (itn / nblk), n1 = 32 * (itn % nblk);
#pragma unroll
            for (int i = 0; i < 8; ++i) r[i] = *(const f32x4*)(W + (size_t)(k1 + lr + 8 * i) * N + n1 + lc); }
        const int c = lane & 7;
#pragma unroll
        for (int j = 0; j < 4; ++j) { const int n = (lane >> 3) + 8 * j; const float* s = scr + (8 * c) * 33 + n;
            u32x4 o; o.x = pk2(s[0 * 33], s[1 * 33]); o.y = pk2(s[2 * 33], s[3 * 33]); o.z = pk2(s[4 * 33], s[5 * 33]); o.w = pk2(s[6 * 33], s[7 * 33]);
            *(u32x4*)(WT + (size_t)(n0 + n) * K + k0 + 8 * c) = o; }
        WAVE_LDS_SYNC();
    }
}
__device__ __forceinline__ void convert_p(const float* psrc, bf16_t* pb, int gtid, int nthr) {
    int i = gtid; f32x4 a = (f32x4){0.f, 0.f, 0.f, 0.f}, b = a;
    if (i < T * 256 / 8) { a = ((const f32x4*)psrc)[2 * i]; b = ((const f32x4*)psrc)[2 * i + 1]; }
    for (; i < T * 256 / 8; i += nthr) { const f32x4 ca = a, cb = b; const int in = i + nthr;
        if (in < T * 256 / 8) { a = ((const f32x4*)psrc)[2 * in]; b = ((const f32x4*)psrc)[2 * in + 1]; }
        u32x4 o; o.x = pk2(ca[0], ca[1]); o.y = pk2(ca[2], ca[3]); o.z = pk2(cb[0], cb[1]); o.w = pk2(cb[2], cb[3]); ((u32x4*)pb)[i] = o; }
}

template <int PASS> __device__ __forceinline__ void dil_unit(int u, int dilv, const bf16_t* proj, float* accst, float* mst, float* lst, bf16_t* ymix, short* vts, int lane) {
    const int r32 = lane & 31, hi = lane >> 5;
    const int LB = 128 / dilv, ql = u & 127, head = (u >> 7) & 7, b = u >> 10, r = ql / LB, qblk = ql % LB;
    const long rowq = (long)b * S + (long)(32 * qblk + r32) * dilv + r;
    const bf16_t* qp = proj + 3 * TSQ + rowq * 512 + head * 64 + 8 * hi;
    bf16x8 qf[4];
#pragma unroll
    for (int d0 = 0; d0 < 4; ++d0) qf[d0] = *(const bf16x8*)(qp + 16 * d0);
    const int j0 = qblk < 4 ? 4 - qblk : 0;
    const float NEG = -1e30f;
    f32x16 st[5]; float mt = NEG;
#pragma unroll
    for (int j = 0; j < 5; ++j) {
        if (j >= j0) {
            const long rowk = (long)b * S + (long)(32 * qblk - 128 + 32 * j + r32) * dilv + r;
            const bf16_t* kp = proj + 4 * TSQ + rowk * 512 + head * 64 + 8 * hi;
            f32x16 a = f32x16{};
#pragma unroll
            for (int d0 = 0; d0 < 4; ++d0) { const bf16x8 kf = *(const bf16x8*)(kp + 16 * d0); a = __builtin_amdgcn_mfma_f32_32x32x16_bf16(kf, qf[d0], a, 0, 0, 0); }
            if (j == 0) {
#pragma unroll
                for (int i = 0; i < 16; ++i) if (crow(i, hi) < r32) a[i] = NEG; }
            if (j == 4) {
#pragma unroll
                for (int i = 0; i < 16; ++i) if (crow(i, hi) > r32) a[i] = NEG; }
#pragma unroll
            for (int i = 0; i < 16; ++i) mt = fmaxf(mt, a[i]);
            st[j] = a;
        } else st[j] = f32x16{};
    }
    mt = xor_max<32>(mt);
    const size_t sidx = (size_t)rowq * 8 + head;
    float m_old = NEG, l_old = 0.f;
    if (PASS > 0) { m_old = mst[sidx]; l_old = lst[sidx]; }
    const float m_new = fmaxf(m_old, mt), sc = __builtin_amdgcn_exp2f(m_old - m_new);
    float ls = 0.f;
#pragma unroll
    for (int j = 0; j < 5; ++j) if (j >= j0) {
#pragma unroll
        for (int i = 0; i < 16; ++i) { const float e = __builtin_amdgcn_exp2f(st[j][i] - m_new); st[j][i] = e; ls += e; } }
    ls = xor_add<32>(ls);
    const float l_new = l_old * sc + ls;
    f32x16 O[2]; float* ap = accst + sidx * 64 + 4 * hi;
    if (PASS > 0) {
#pragma unroll
        for (int dt = 0; dt < 2; ++dt)
#pragma unroll
            for (int i4 = 0; i4 < 4; ++i4) { const f32x4 v = *(const f32x4*)(ap + 32 * dt + 8 * i4);
#pragma unroll
                for (int e = 0; e < 4; ++e) O[dt][4 * i4 + e] = v[e] * sc; }
    } else { O[0] = f32x16{}; O[1] = f32x16{}; }
#pragma unroll
    for (int j = 0; j < 5; ++j) if (j >= j0) {
        const long rowk = (long)b * S + (long)(32 * qblk - 128 + 32 * j + r32) * dilv + r;
        const bf16_t* vp = proj + 5 * TSQ + rowk * 512 + head * 64 + 8 * hi;
#pragma unroll
        for (int d0 = 0; d0 < 4; ++d0) { const bf16x8 vv = *(const bf16x8*)(vp + 16 * d0);
#pragma unroll
            for (int e = 0; e < 8; ++e) vts[(16 * d0 + 8 * hi + e) * 36 + r32] = vv[e]; }
        WAVE_LDS_SYNC();
#pragma unroll
        for (int cc = 0; cc < 2; ++cc) {
            u32x4 pw; pw.x = pk2(st[j][8 * cc + 0], st[j][8 * cc + 1]); pw.y = pk2(st[j][8 * cc + 2], st[j][8 * cc + 3]); pw.z = pk2(st[j][8 * cc + 4], st[j][8 * cc + 5]); pw.w = pk2(st[j][8 * cc + 6], st[j][8 * cc + 7]);
            const bf16x8 pf = __builtin_bit_cast(bf16x8, pw);
#pragma unroll
            for (int dt = 0; dt < 2; ++dt) { const short* vr = vts + (r32 + 32 * dt) * 36 + 16 * cc + 4 * hi;
                const s16x4 lo = *(const s16x4*)vr, h4 = *(const s16x4*)(vr + 8);
                const bf16x8 vf = (bf16x8){lo[0], lo[1], lo[2], lo[3], h4[0], h4[1], h4[2], h4[3]};
                O[dt] = __builtin_amdgcn_mfma_f32_32x32x16_bf16(vf, pf, O[dt], 0, 0, 0); }
        }
        WAVE_LDS_SYNC();
    }
    if (PASS < 2) {
#pragma unroll
        for (int dt = 0; dt < 2; ++dt)
#pragma unroll
            for (int i4 = 0; i4 < 4; ++i4) *(f32x4*)(ap + 32 * dt + 8 * i4) = (f32x4){O[dt][4 * i4], O[dt][4 * i4 + 1], O[dt][4 * i4 + 2], O[dt][4 * i4 + 3]};
        if (hi == 0) { mst[sidx] = m_new; lst[sidx] = l_new; }
    } else {
        const float inv = 1.0f / l_new; bf16_t* yp = ymix + (size_t)rowq * 1024 + 512 + head * 64 + 4 * hi;
#pragma unroll
        for (int dt = 0; dt < 2; ++dt)
#pragma unroll
            for (int i4 = 0; i4 < 4; ++i4) { u32x2 w; w.x = pk2(O[dt][4 * i4] * inv, O[dt][4 * i4 + 1] * inv); w.y = pk2(O[dt][4 * i4 + 2] * inv, O[dt][4 * i4 + 3] * inv); *(u32x2*)(yp + 32 * dt + 8 * i4) = w; }
    }
}
template <int PASS> __device__ __forceinline__ void dil_pass(int dilv, const bf16_t* proj, float* accst, float* mst, float* lst, bf16_t* ymix, unsigned char* lds, int wid, int lane, int gw, int ngw) {
    short* vts = (short*)(lds + wid * 4608);
    for (int u = gw; u < 8192; u += ngw) dil_unit<PASS>(u, dilv, proj, accst, mst, lst, ymix, vts, lane);
}

__device__ __forceinline__ void s5_coef(float lr, float li, float dt, float& ar, float& ai, float& cr, float& ci) {
    const float mag = expf(lr * dt); const float th = li * dt; const float kq = rintf(th * 0.15915494309189535f);
    float rr = fmaf(-kq, 6.2831854820251465f, th); rr = fmaf(-kq, -1.7484556000744883e-07f, rr);
    const float sn = __sinf(rr), cs = __cosf(rr); ar = mag * cs; ai = mag * sn;
    const float den = lr * lr + li * li, nr = ar - 1.f, ni = ai; cr = (nr * lr + ni * li) / den; ci = (ni * lr - nr * li) / den;
}
__device__ __forceinline__ float gelu_tanh(float x) { const float z = 1.5957691216057308f * (x + 0.044715f * x * x * x); return x * __builtin_amdgcn_rcpf(1.0f + __expf(-z)); }

}
#ifndef RP_ATTN
#define RP_ATTN 1
#define RP_DIL 1
#define RP_S5 1
#define RP_BAR 1
#define RP_UP 1
#define RP_PRO 1
#define RP_INP 1
#define RP_PP 1
#define RP_ELT 1
#define RP_OUT 1
#define RP_DOWN 1
#define RP_PLE 1
#define RP_GLU 1
#endif
namespace mk {
#define GAS __attribute__((address_space(1)))
struct DParams { GAS const float* in[29]; GAS float* out; GAS unsigned char* ws; };
typedef const __attribute__((address_space(4))) DParams* KArgs;
__device__ __forceinline__ void s5_phase(KArgs p, int o, const bf16_t* proj, bf16_t* yg, unsigned char* lds, int tid, int lane, int wid, int G, int bid) {
    constexpr int TC = 64, NCH = S / TC, BUP = 132, XP = 136;
    float* Bu = (float*)lds;
    bf16_t* Xs = (bf16_t*)(lds + 2 * TC * BUP * 4);
    const int r32 = lane & 31, hi = lane >> 5, l16 = lane & 15, kq = lane >> 4;
    for (int bg = bid; bg < 256; bg += G) {
        const int b = bg >> 5, g = bg & 31, og = o * 32 + g;
        const float* lam_re = (const float*)p->in[18] + og * 64; const float* lam_im = (const float*)p->in[19] + og * 64; const float dt = expf(p->in[20][og]);
        const float* b_re = (const float*)p->in[21] + (size_t)og * 1024; const float* b_im = (const float*)p->in[22] + (size_t)og * 1024;
        const float* c_re = (const float*)p->in[23] + (size_t)og * 1024; const float* c_im = (const float*)p->in[24] + (size_t)og * 1024; const float* dsk = (const float*)p->in[25] + og * 16;
        const bf16_t* ub = proj + (size_t)b * S * 512 + g * 16;
        float ar = 0.f, ai = 0.f, xr = 0.f, xi = 0.f;
        bf16x8 Bf[4], Cf[4]; float dsc = 0.f;
        if (wid == 0) { float cr, ci; s5_coef(lam_re[lane], lam_im[lane], dt, ar, ai, cr, ci); }
        else {
#pragma unroll
            for (int nt = 0; nt < 4; ++nt) { const int pp = 16 * nt + (r32 >> 1); float a0, a1, cr, ci; s5_coef(lam_re[pp], lam_im[pp], dt, a0, a1, cr, ci);
                const f32x4 br0 = *(const f32x4*)(b_re + pp * 16 + 8 * hi), br1 = *(const f32x4*)(b_re + pp * 16 + 8 * hi + 4);
                const f32x4 bi0 = *(const f32x4*)(b_im + pp * 16 + 8 * hi), bi1 = *(const f32x4*)(b_im + pp * 16 + 8 * hi + 4);
                f32x4 v0, v1; if (r32 & 1) { v0 = cr * bi0 + ci * br0; v1 = cr * bi1 + ci * br1; } else { v0 = cr * br0 - ci * bi0; v1 = cr * br1 - ci * bi1; }
                u32x4 w; w.x = pk2(v0[0], v0[1]); w.y = pk2(v0[2], v0[3]); w.z = pk2(v1[0], v1[1]); w.w = pk2(v1[2], v1[3]); Bf[nt] = __builtin_bit_cast(bf16x8, w); }
#pragma unroll
            for (int ks = 0; ks < 4; ++ks) { const int p0 = 16 * ks + 4 * kq; const f32x4 cr4 = *(const f32x4*)(c_re + l16 * 64 + p0), ci4 = *(const f32x4*)(c_im + l16 * 64 + p0);
                u32x4 w; w.x = pk2(cr4[0], -ci4[0]); w.y = pk2(cr4[1], -ci4[1]); w.z = pk2(cr4[2], -ci4[2]); w.w = pk2(cr4[3], -ci4[3]); Cf[ks] = __builtin_bit_cast(bf16x8, w); }
            dsc = dsk[l16];
        }
#define S5_LDU(k, tt) (*(const bf16x8*)(ub + (size_t)(((k) < NCH ? (k) : NCH - 1) * TC + 32 * (tt) + r32) * 512 + 8 * hi))
#define S5_BU(k) do { float* Bb = Bu + ((k) & 1) * TC * BUP; \
        { const int tile = wid - 1, tt = tile >> 2, nt = tile & 3; \
            const f32x16 a = __builtin_amdgcn_mfma_f32_32x32x16_bf16(ufa, nt == 0 ? Bf[0] : nt == 1 ? Bf[1] : nt == 2 ? Bf[2] : Bf[3], f32x16{}, 0, 0, 0); \
            _Pragma("unroll") for (int i = 0; i < 16; ++i) Bb[(32 * tt + crow(i, hi)) * BUP + 32 * nt + r32] = a[i]; } \
        if (wid == 1) { const f32x16 a = __builtin_amdgcn_mfma_f32_32x32x16_bf16(ufb, Bf[3], f32x16{}, 0, 0, 0); \
            _Pragma("unroll") for (int i = 0; i < 16; ++i) Bb[(32 + crow(i, hi)) * BUP + 96 + r32] = a[i]; } \
        ufa = S5_LDU((k) + 1, (wid - 1) >> 2); if (wid == 1) ufb = S5_LDU((k) + 1, 1); } while (0)
#define S5_LDUU(k) do { if (wid <= 4) { _Pragma("unroll") for (int j = 0; j < 4; ++j) uun[j] = proj[((size_t)b * S + ((k) < NCH ? (k) : NCH - 1) * TC + 16 * (wid - 1) + 4 * kq + j) * 512 + g * 16 + l16]; } } while (0)
#define S5_CP(k) do { const bf16_t* Xb = Xs + ((k) & 1) * TC * XP; \
        if (wid <= 4) { const int tile = wid - 1; f32x4 a = (f32x4){0.f, 0.f, 0.f, 0.f}; \
            _Pragma("unroll") for (int ks = 0; ks < 4; ++ks) { const bf16x8 xf = *(const bf16x8*)(Xb + (16 * tile + l16) * XP + 32 * ks + 8 * kq); \
                a = __builtin_amdgcn_mfma_f32_16x16x32_bf16(xf, Cf[ks], a, 0, 0, 0); } \
            _Pragma("unroll") for (int j = 0; j < 4; ++j) { const size_t tok = (size_t)b * S + (k) * TC + 16 * tile + 4 * kq + j; \
                const float y = gelu_tanh(a[j] + dsc * bf1(uun[j])); \
                yg[tok * 512 + g * 16 + l16] = (bf16_t)(pk2(y, 0.f) & 0xffffu); } } \
        S5_LDUU((k) + 1); } while (0)
        bf16x8 ufa = bf16x8{}, ufb = bf16x8{}; bf16_t uun[4] = {0, 0, 0, 0};
        if (wid > 0) { ufa = S5_LDU(0, (wid - 1) >> 2); if (wid == 1) ufb = S5_LDU(0, 1); S5_LDUU(0); S5_BU(0); }
        __syncthreads();
        for (int k = 0; k < NCH; ++k) {
            if (wid == 0) {
                const float* Bb = Bu + (k & 1) * TC * BUP; bf16_t* Xb = Xs + (k & 1) * TC * XP;
                for (int t0 = 0; t0 < TC; t0 += 16) { f32x2_t bv[16];
#pragma unroll
                    for (int j = 0; j < 16; ++j) bv[j] = *(const f32x2_t*)(Bb + (t0 + j) * BUP + 2 * lane);
#pragma unroll
                    for (int j = 0; j < 16; ++j) { const float nr = fmaf(ar, xr, fmaf(-ai, xi, bv[j].x)), ni = fmaf(ar, xi, fmaf(ai, xr, bv[j].y)); xr = nr; xi = ni;
                        *(unsigned*)(Xb + (t0 + j) * XP + 2 * lane) = pk2(xr, xi); } }
            } else {
                if (k + 1 < NCH) S5_BU(k + 1);
                if (k >= 1) S5_CP(k - 1);
            }
            __syncthreads();
        }
        if (wid > 0) S5_CP(NCH - 1);
        __syncthreads();
#undef S5_BU
#undef S5_LDU
#undef S5_LDUU
#undef S5_CP
    }
}
__device__ __forceinline__ void conv_phase(const float* cw, const bf16_t* proj, bf16_t* ymix, int gtid, int nthr) {
    for (int idx = gtid; idx < T * 64; idx += nthr) { const int t = idx >> 6, c8 = (idx & 63) * 8, s = t & (S - 1);
        const bf16_t* row = proj + (size_t)t * 512;
        float y[8];
#pragma unroll
        for (int e = 0; e < 8; ++e) y[e] = 0.f;
#pragma unroll
        for (int j = 0; j < 3; ++j) if (s - j >= 0) { const u32x4 gc = *(const u32x4*)(row + 2 * TSQ - (size_t)j * 512 + c8), xt = *(const u32x4*)(row + 3 * TSQ - (size_t)j * 512 + c8);
            const f32x4 w0 = *(const f32x4*)(cw + j * 512 + c8), w1 = *(const f32x4*)(cw + j * 512 + c8 + 4);
            y[0] += w0[0] * bflo(gc.x) * bflo(xt.x); y[1] += w0[1] * bfhi(gc.x) * bfhi(xt.x); y[2] += w0[2] * bflo(gc.y) * bflo(xt.y); y[3] += w0[3] * bfhi(gc.y) * bfhi(xt.y);
            y[4] += w1[0] * bflo(gc.z) * bflo(xt.z); y[5] += w1[1] * bfhi(gc.z) * bfhi(xt.z); y[6] += w1[2] * bflo(gc.w) * bflo(xt.w); y[7] += w1[3] * bfhi(gc.w) * bfhi(xt.w); }
        const u32x4 gb = *(const u32x4*)(row + TSQ + c8); u32x4 o;
        o.x = pk2(y[0] * bflo(gb.x), y[1] * bfhi(gb.x)); o.y = pk2(y[2] * bflo(gb.y), y[3] * bfhi(gb.y)); o.z = pk2(y[4] * bflo(gb.z), y[5] * bfhi(gb.z)); o.w = pk2(y[6] * bflo(gb.w), y[7] * bfhi(gb.w));
        *(u32x4*)(ymix + (size_t)t * 1024 + 512 + c8) = o; }
}
__device__ __forceinline__ void diff_post(KArgs p, int e, float lam_init, const bf16_t* O16, bf16_t* ymix, int lane, int gtid, int nthr) {
    float a = p->in[11][e * 64 + lane] * p->in[12][e * 64 + lane], bb = p->in[13][e * 64 + lane] * p->in[14][e * 64 + lane];
    a = wave_sum(a); bb = wave_sum(bb);
    const float lam = expf(a) - expf(bb) + lam_init; const float* gain = (const float*)p->in[15] + e * 128;
    const int j = gtid & 15, vhalf = j >> 3, dd = (j & 7) * 8;
    const f32x4 g0 = *(const f32x4*)(gain + 8 * j), g1 = *(const f32x4*)(gain + 8 * j + 4);
    for (int grp = gtid >> 4; grp < T * 4; grp += nthr >> 4) { const int t = grp >> 2, h = grp & 3;
        const u32x4 o1 = *(const u32x4*)(O16 + (size_t)t * 1024 + ((h * 2 + 0) * 2 + vhalf) * 64 + dd), o2 = *(const u32x4*)(O16 + (size_t)t * 1024 + ((h * 2 + 1) * 2 + vhalf) * 64 + dd);
        float v[8];
        v[0] = bflo(o1.x) - lam * bflo(o2.x); v[1] = bfhi(o1.x) - lam * bfhi(o2.x); v[2] = bflo(o1.y) - lam * bflo(o2.y); v[3] = bfhi(o1.y) - lam * bfhi(o2.y);
        v[4] = bflo(o1.z) - lam * bflo(o2.z); v[5] = bfhi(o1.z) - lam * bfhi(o2.z); v[6] = bflo(o1.w) - lam * bflo(o2.w); v[7] = bfhi(o1.w) - lam * bfhi(o2.w);
        float ss = 0.f;
#pragma unroll
        for (int q = 0; q < 8; ++q) ss += v[q] * v[q];
        ss = xor_add<1>(ss); ss = xor_add<2>(ss); ss = xor_add<4>(ss); ss = xor_add<8>(ss);
        const float rs = rsqrtf(ss * (1.0f / 128.0f) + 1e-5f) * (1.0f - lam_init);
        u32x4 o; o.x = pk2(v[0] * rs * g0[0], v[1] * rs * g0[1]); o.y = pk2(v[2] * rs * g0[2], v[3] * rs * g0[3]); o.z = pk2(v[4] * rs * g1[0], v[5] * rs * g1[1]); o.w = pk2(v[6] * rs * g1[2], v[7] * rs * g1[3]);
        *(u32x4*)(ymix + (size_t)t * 1024 + h * 128 + 8 * j) = o; }
}

__device__ __forceinline__ KArgs kargs() { KArgs k = (KArgs)__builtin_amdgcn_kernarg_segment_ptr(); asm volatile("" : "+s"(k)); return k; }
constexpr size_t WS_BAR = WS_WM + 8 * MiB + 6 * MiB + MiB / 2;
constexpr int LDS_XB = 131072 + 1024;
#define LAS __attribute__((address_space(3)))
#define XB_TMO      128
#define XB_XCNT(j)  (256  + 64 * (j))
#define XB_XSUB(j)  (1280 + 64 * (j))
#define XB_XGEN(j)  (2304 + 64 * (j))
#define XB_TOP      3328
#define XB_TOPGEN   3392
#define XCD_BAR_WORDS 3456
#define XB_SPIN_CAP (1u << 18)

__device__ __forceinline__ unsigned xb_ld(unsigned* p)              { return __hip_atomic_load(p, __ATOMIC_RELAXED, __HIP_MEMORY_SCOPE_AGENT); }
__device__ __forceinline__ unsigned xb_add(unsigned* p, unsigned v) { return __hip_atomic_fetch_add(p, v, __ATOMIC_RELAXED, __HIP_MEMORY_SCOPE_AGENT); }
__device__ __forceinline__ unsigned xb_xcc_id() { return (unsigned)__builtin_amdgcn_s_getreg((3 << 11) | 20) & 0xFu; }
#define XB_SPIN(cond, bar) do { unsigned _sp = 0; while (cond) { __builtin_amdgcn_s_sleep(1); \
    if ((++_sp & 255u) == 0u) { if (xb_ld(&(bar)[XB_TMO])) break; if (_sp > XB_SPIN_CAP) { atomicAdd(&(bar)[XB_TMO], 1u); break; } } } } while (0)

struct XcdBarrier {
    unsigned* bar; unsigned x;
    volatile LAS unsigned* st;
};

__device__ __forceinline__ XcdBarrier xcd_barrier_post(unsigned* bar, volatile LAS unsigned* st) {
    XcdBarrier b; b.bar = bar; b.x = xb_xcc_id(); b.st = st;
    if (threadIdx.x == 0) (void)xb_add(&bar[XB_XCNT(b.x)], 1u);
    return b;
}
__device__ __forceinline__ void xcd_barrier_complete(unsigned* bar, unsigned x, unsigned& nloc, unsigned& nx) {
    const unsigned G = gridDim.x * gridDim.y * gridDim.z;
    unsigned sum, cnt, mine, sp = 0u;
    for (;;) {
        sum = 0u; cnt = 0u; mine = 0u;
#pragma unroll
        for (unsigned j = 0; j < 16; ++j) { const unsigned c = xb_ld(&bar[XB_XCNT(j)]); sum += c; cnt += (c > 0u) ? 1u : 0u; mine = (j == x) ? c : mine; }
        if (sum == G) break;
        __builtin_amdgcn_s_sleep(1);
        if ((++sp & 255u) == 0u) { if (xb_ld(&bar[XB_TMO])) break; if (sp > XB_SPIN_CAP) { atomicAdd(&bar[XB_TMO], 1u); break; } }
    }
    nloc = mine > 0u ? mine : 1u; nx = cnt > 0u ? cnt : 1u;
}

__device__ __forceinline__ void xcd_barrier(const XcdBarrier& b) {
    asm volatile("s_waitcnt vmcnt(0)" ::: "memory");
    __syncthreads();
    if (threadIdx.x == 0) {
        unsigned* bar = b.bar;
        __builtin_amdgcn_s_waitcnt(0);
        unsigned nloc = b.st[0], nx = b.st[1];
        if (nloc == 0u) { xcd_barrier_complete(bar, b.x, nloc, nx); b.st[0] = nloc; b.st[1] = nx; }
        const unsigned old = xb_add(&bar[XB_XSUB(b.x)], 1u);
        const unsigned gen = old / nloc;
        if (old + 1u == (gen + 1u) * nloc) {
            __builtin_amdgcn_fence(__ATOMIC_RELEASE, "agent");
            asm volatile("s_waitcnt vmcnt(0)" ::: "memory");
            const unsigned og = xb_add(&bar[XB_TOP], 1u);
            const unsigned tg = og / nx;
            if (og + 1u == (tg + 1u) * nx) xb_add(&bar[XB_TOPGEN], 1u);
            else XB_SPIN(xb_ld(&bar[XB_TOPGEN]) == tg, bar);
            __builtin_amdgcn_fence(__ATOMIC_ACQUIRE, "agent");
            xb_add(&bar[XB_XGEN(b.x)], 1u);
            asm volatile("s_waitcnt vmcnt(0)" ::: "memory");
        } else {
            XB_SPIN(xb_ld(&bar[XB_XGEN(b.x)]) == gen, bar);
            __builtin_amdgcn_fence(__ATOMIC_ACQUIRE, "agent");
            asm volatile("s_waitcnt vmcnt(0)" ::: "memory");
        }
    }
    __syncthreads();
}

__device__ __forceinline__ void grid_bar1(unsigned) {
    XcdBarrier xbv; xbv.bar = (unsigned*)((unsigned char*)kargs()->ws + WS_BAR); xbv.x = xb_xcc_id(); xbv.st = (volatile LAS unsigned*)(LDS_XB);
    xcd_barrier(xbv);
}
__device__ __forceinline__ void grid_bar(unsigned epoch) { for (int rp = 0; rp < RP_BAR; ++rp) grid_bar1(epoch); }
#define PH_BEGIN KArgs ka = kargs(); unsigned char* ws = (unsigned char*)ka->ws; int tid = threadIdx.x; asm volatile("" : "+v"(tid)); int bid = blockIdx.x; asm volatile("" : "+s"(bid)); const int lane = tid & 63, wid = __builtin_amdgcn_readfirstlane(tid >> 6), G = gridDim.x; \
    const int gw = bid * 8 + wid, ngw = G * 8, gtid = bid * 512 + tid, nthr = G * 512; (void)lane; (void)gw; (void)ngw; (void)gtid; (void)nthr; (void)ws;
#define WL(i) (ws + WS_W + (size_t)(i) * WS_WL)
#define WM(i) (ws + WS_WM + (size_t)(i) * 8 * MiB)
#define SBUF(j) ((bf16_t*)ka->out + (size_t)((j) & 1) * T * 1024)
#define SSQ(k) ((float*)(ws + WS_SSQ + (size_t)((k) & 1) * 2 * MiB))
template <int i> __device__ __forceinline__ void layer_body(unsigned char* lds, PG8_LAS unsigned char* ldsp) {
    unsigned ep = (i == 0 ? 0u : i == 1 ? 8u : i == 2 ? 15u : 23u);
        for (int rp = 0; rp < RP_INP; ++rp) { PH_BEGIN const bool odd = (i & 1) != 0; const int N = odd ? 2048 : 3072;
            pg8::Gemm g{SBUF(i), (const bf16_t*)WM(i), T, N, 1024};     pg8::StaticOrder SO; SO.init(T, N, G, bid);
            pg8::EpiRow<0> E{(bf16_t*)(ws + WS_BIG), 512, SSQ(3 * i), odd ? 0u : 0xC3u, C2, 512, TSQ};
            pg8::gemm_phase<pg8::EpiRow<0>, pg8::StaticOrder, true, true>(ldsp, g, SO, E); }
        grid_bar(++ep);
        if ((i & 1) == 0) {
            { PH_BEGIN const int vcu0 = (G % 8 == 0) ? (bid % 8) * (G / 8) + (bid / 8) : bid;
                for (int rp = 0; rp < RP_ATTN; ++rp) for (int vcu = vcu0; vcu < 256; vcu += G) { const int pair = vcu >> 1, s = vcu & 1, b = pair >> 4, vh = pair & 15, h = vh >> 2, c = (vh >> 1) & 1, vhalf = vh & 1;
                    for (int it = 0; it < 8; ++it) { const int j = s + 2 * (it >> 1), qb = (it & 1) ? 15 - j : j;
                        const attn_body::bf16* P = (const attn_body::bf16*)((unsigned char*)kargs()->ws + WS_BIG);
                        attn_body::attn_unit<8>(b, 0, qb, P + h * 128 + c * 64, P + TSQ + h * 128 + c * 64, P + 2 * TSQ + h * 128 + vhalf * 64, (attn_body::bf16*)((unsigned char*)kargs()->ws + WS_O16) + vh * 64, (char*)lds); } } }
            __syncthreads();
            { PH_BEGIN float* dm = (float*)(ws + WS_DML);
                for (int rp = 0; rp < RP_DIL; ++rp) dil_pass<0>(1, (const bf16_t*)(ws + WS_BIG), (float*)(ws + WS_HB), dm, dm + (size_t)T * 8, (bf16_t*)(ws + WS_YMIX), lds, wid, lane, gw, ngw);
                convert_p((const float*)ka->in[1] + (size_t)i * T * 256, (bf16_t*)(ws + WS_PB), gtid, nthr); }
            grid_bar(++ep);
            { PH_BEGIN float* dm = (float*)(ws + WS_DML);
                dil_pass<1>(4, (const bf16_t*)(ws + WS_BIG), (float*)(ws + WS_HB), dm, dm + (size_t)T * 8, (bf16_t*)(ws + WS_YMIX), lds, wid, lane, gw, ngw); }
            grid_bar(++ep);
            { PH_BEGIN float* dm = (float*)(ws + WS_DML);
                dil_pass<2>(16, (const bf16_t*)(ws + WS_BIG), (float*)(ws + WS_HB), dm, dm + (size_t)T * 8, (bf16_t*)(ws + WS_YMIX), lds, wid, lane, gw, ngw); }
            { PH_BEGIN const float lam_init = 0.8f - 0.6f * expf(-0.3f * (float)i);
                for (int rp = 0; rp < RP_ELT; ++rp) diff_post(ka, i >> 1, lam_init, (const bf16_t*)(ws + WS_O16), (bf16_t*)(ws + WS_YMIX), lane, gtid, nthr); }
            grid_bar(++ep);
        } else {
            for (int rp = 0; rp < RP_S5; ++rp) { PH_BEGIN s5_phase(ka, i >> 1, (const bf16_t*)(ws + WS_BIG), (bf16_t*)(ws + WS_HB), lds, tid, lane, wid, G, bid); }
            for (int rp = 0; rp < RP_ELT; ++rp) { PH_BEGIN conv_phase((const float*)ka->in[27] + (i >> 1) * 3 * 512, (const bf16_t*)(ws + WS_BIG), (bf16_t*)(ws + WS_YMIX), gtid, nthr);
                convert_p((const float*)ka->in[1] + (size_t)i * T * 256, (bf16_t*)(ws + WS_PB), gtid, nthr); }
            grid_bar(++ep);
            for (int rp = 0; rp < RP_GLU; ++rp) { PH_BEGIN pg8::Gemm g{(const bf16_t*)(ws + WS_HB), (const bf16_t*)(WM(i) + 6 * MiB), T, 512, 512}; pg8::StaticOrder SO; SO.init(T, 512, G, bid);
                pg8::EpiGlu E{(bf16_t*)(ws + WS_YMIX), (const bf16_t*)(ws + WS_HB)};
                pg8::gemm_phase<pg8::EpiGlu, pg8::StaticOrder, true, true>(ldsp, g, SO, E); }
            grid_bar(++ep);
        }
        for (int rp = 0; rp < RP_OUT; ++rp) { PH_BEGIN const bool odd = (i & 1) != 0;
            pg8::Gemm g{(const bf16_t*)(ws + WS_YMIX), (const bf16_t*)(WM(i) + (odd ? 4 : 6) * MiB), T, 1024, 1024}; pg8::StaticOrder SO; SO.init(T, 1024, G, bid);
            pg8::EpiRes<0> E{SBUF(i), (rp < RP_OUT - 1) ? (bf16_t*)(ws + WS_HB) : SBUF(i), SSQ(3 * i + 1), nullptr, nullptr};
            pg8::gemm_phase<pg8::EpiRes<0>, pg8::StaticOrder, true, true>(ldsp, g, SO, E); }
        grid_bar(++ep);
        for (int rp = 0; rp < RP_UP; ++rp) { PH_BEGIN pg8::Gemm g{SBUF(i), (const bf16_t*)WL(i), T, 4096, 1024}; pg8::StaticOrder SO; SO.init(T, 4096, G, bid);
            pg8::EpiRow<1> E{(bf16_t*)(ws + WS_BIG), 4096, SSQ(3 * i + 1), 0u, 1.f, 0, 0};
            pg8::gemm_phase<pg8::EpiRow<1>, pg8::StaticOrder, true, true>(ldsp, g, SO, E); }
        for (int rp = 0; rp < RP_PP; ++rp) { PH_BEGIN pg8::Gemm g{(const bf16_t*)(ws + WS_PB), (const bf16_t*)(WL(i) + 18 * MiB), T, 1024, 256}; pg8::StaticOrder SO; SO.init(T, 1024, G, bid);
            pg8::EpiPP E{(bf16_t*)(ws + WS_YMIX)};
            pg8::gemm_phase<pg8::EpiPP, pg8::StaticOrder, true, true>(ldsp, g, SO, E); }
        grid_bar(++ep);
        for (int rp = 0; rp < RP_DOWN; ++rp) { PH_BEGIN pg8::Gemm g{(const bf16_t*)(ws + WS_BIG), (const bf16_t*)(WL(i) + 8 * MiB), T, 1024, 4096}; pg8::StaticOrder SO; SO.init(T, 1024, G, bid);
            pg8::EpiRes<0> E{SBUF(i), (rp < RP_DOWN - 1) ? (bf16_t*)(ws + WS_HB) : SBUF(i), SSQ(3 * i + 2), nullptr, nullptr};
            pg8::gemm_phase<pg8::EpiRes<0>, pg8::StaticOrder, true, true>(ldsp, g, SO, E); }
        grid_bar(++ep);
        for (int rp = 0; rp < RP_PLE; ++rp) { PH_BEGIN pg8::Gemm g{SBUF(i), (const bf16_t*)(WL(i) + 16 * MiB), T, 1024, 1024}; pg8::StaticOrder SO; SO.init(T, 1024, G, bid);
            pg8::EpiRes<1> E{SBUF(i), (rp < RP_PLE - 1) ? (bf16_t*)(ws + WS_BIG) : (i == 3) ? (bf16_t*)(ws + WS_HB) : SBUF(i + 1), SSQ(3 * i + 3), SSQ(3 * i + 2), (const bf16_t*)(ws + WS_YMIX)};
            pg8::gemm_phase<pg8::EpiRes<1>, pg8::StaticOrder, true, true>(ldsp, g, SO, E); }
        grid_bar(++ep);
}
__global__ void __launch_bounds__(512, 2) fwd(Params p_unused) {
    extern __shared__ __attribute__((aligned(16))) unsigned char lds[];
    PG8_LAS unsigned char* ldsp = (PG8_LAS unsigned char*)lds;
    for (int rp = 0; rp < RP_PRO; ++rp) {
    { PH_BEGIN
        float* ssq = SSQ(0); bf16_t* hb = SBUF(0); const float* x = (const float*)ka->in[0];
        { f32x4 vn[4]; int m = gw;
            if (m < T) { const f32x4* xr = (const f32x4*)(x + (size_t)m * 1024) + lane;
#pragma unroll
                for (int j = 0; j < 4; ++j) vn[j] = xr[64 * j]; }
            for (; m < T; m += ngw) { f32x4 v[4]; float s = 0.f;
#pragma unroll
                for (int j = 0; j < 4; ++j) v[j] = vn[j];
                if (m + ngw < T) { const f32x4* xn = (const f32x4*)(x + (size_t)(m + ngw) * 1024) + lane;
#pragma unroll
                    for (int j = 0; j < 4; ++j) vn[j] = xn[64 * j]; }
#pragma unroll
                for (int j = 0; j < 4; ++j) s += (v[j][0] * v[j][0] + v[j][1] * v[j][1]) + (v[j][2] * v[j][2] + v[j][3] * v[j][3]);
                s = wave_sum(s); if (lane < 16) ssq[(size_t)m * 16 + lane] = (lane == 0) ? s : 0.f;
                u32x2* o8 = (u32x2*)(hb + (size_t)m * 1024) + lane;
#pragma unroll
                for (int j = 0; j < 4; ++j) { u32x2 w; w.x = pk2(v[j][0], v[j][1]); w.y = pk2(v[j][2], v[j][3]); o8[64 * j] = w; } } } }
    for (int i = 0; i < 4; ++i) { PH_BEGIN
        float* scr = (float*)(lds + wid * 8448); unsigned char* wl = WL(i); unsigned char* wm = WM(i); const int e = i >> 1;
        transpose_items((const float*)ka->in[5] + (size_t)i * 1024 * 4096, 1024, 4096, (const float*)ka->in[3] + i * 1024, (bf16_t*)wl, scr, gw, ngw, lane);
        transpose_items((const float*)ka->in[6] + (size_t)i * 1024 * 4096, 4096, 1024, nullptr, (bf16_t*)(wl + 8 * MiB), scr, gw, ngw, lane);
        transpose_items((const float*)ka->in[8] + (size_t)i * 1024 * 1024, 1024, 1024, (const float*)ka->in[4] + i * 1024, (bf16_t*)(wl + 16 * MiB), scr, gw, ngw, lane);
        transpose_items((const float*)ka->in[7] + (size_t)i * 256 * 1024, 256, 1024, nullptr, (bf16_t*)(wl + 18 * MiB), scr, gw, ngw, lane);
        if ((i & 1) == 0) {
            transpose_items((const float*)ka->in[9] + (size_t)e * 1024 * 3072, 1024, 3072, (const float*)ka->in[2] + i * 1024, (bf16_t*)wm, scr, gw, ngw, lane);
            transpose_items((const float*)ka->in[10] + (size_t)e * 1024 * 1024, 1024, 1024, nullptr, (bf16_t*)(wm + 6 * MiB), scr, gw, ngw, lane);
        } else {
            transpose_items((const float*)ka->in[16] + (size_t)e * 1024 * 2048, 1024, 2048, (const float*)ka->in[2] + i * 1024, (bf16_t*)wm, scr, gw, ngw, lane);
            transpose_items((const float*)ka->in[17] + (size_t)e * 1024 * 1024, 1024, 1024, nullptr, (bf16_t*)(wm + 4 * MiB), scr, gw, ngw, lane);
            transpose_items((const float*)ka->in[26] + (size_t)e * 512 * 512, 512, 512, nullptr, (bf16_t*)(wm + 6 * MiB), scr, gw, ngw, lane);
        } }
    }
    { KArgs ka0 = kargs(); unsigned* bw = (unsigned*)((unsigned char*)ka0->ws + WS_BAR);
        if (blockIdx.x == 0) for (int w = threadIdx.x; w < XCD_BAR_WORDS; w += 512) __hip_atomic_store(bw + w, 0u, __ATOMIC_RELAXED, __HIP_MEMORY_SCOPE_AGENT);
        if (threadIdx.x < 2) ((volatile LAS unsigned*)(LDS_XB))[threadIdx.x] = 0u; }
    cg::this_grid().sync();
    { KArgs ka0 = kargs(); (void)xcd_barrier_post((unsigned*)((unsigned char*)ka0->ws + WS_BAR), (volatile LAS unsigned*)(LDS_XB)); }
    layer_body<0>(lds, ldsp); layer_body<1>(lds, ldsp); layer_body<2>(lds, ldsp); layer_body<3>(lds, ldsp);
    { PH_BEGIN const float* gf = (const float*)ka->in[28]; const float* sq = SSQ(12); float* hf = (float*)ka->out; const bf16_t* hs = (const bf16_t*)(ws + WS_HB);
        for (int m = gw; m < T; m += ngw) { f32x4* xr = (f32x4*)(hf + (size_t)m * 1024) + lane; const u32x2* hr = (const u32x2*)(hs + (size_t)m * 1024) + lane; const float rs = rsqrtf(pg8::ssq16(sq, m) * (1.0f / 1024.0f) + 1e-6f);
#pragma unroll
            for (int j = 0; j < 4; ++j) { const f32x4 gv = ((const f32x4*)gf)[lane + 64 * j]; const u32x2 hv = hr[64 * j]; xr[64 * j] = (f32x4){bflo(hv.x), bfhi(hv.x), bflo(hv.y), bfhi(hv.y)} * rs * gv; } } }
}
}

extern "C" void kernel_launch(void* const* d_in, const int* in_sizes, int n_in, void* d_out, int out_size, void* d_ws, size_t ws_size, hipStream_t stream) {
    static int grid_blocks = 0;
    if (!grid_blocks) {
        int dev = 0, cus = 0, per_cu = 0;
        (void)hipGetDevice(&dev);
        (void)hipDeviceGetAttribute(&cus, hipDeviceAttributeMultiprocessorCount, dev);
        (void)hipFuncSetAttribute((const void*)mk::fwd, hipFuncAttributeMaxDynamicSharedMemorySize, mk::LDS_BYTES);
        (void)hipOccupancyMaxActiveBlocksPerMultiprocessor(&per_cu, (const void*)mk::fwd, 512, mk::LDS_BYTES);
        (void)hipGetLastError();
        grid_blocks = cus > 0 ? cus : 256;
        if (ws_size < mk::WS_END || n_in != 29) { fprintf(stderr, "kernel_launch: workspace %zu < %zu or n_in %d != 29\n", ws_size, (size_t)mk::WS_END, n_in); }
    }
    (void)hipMemsetAsync((unsigned char*)d_ws + mk::WS_BAR, 0, 256, stream);
    mk::Params p{};
    for (int i = 0; i < 29; ++i) p.in[i] = (const float*)d_in[i];
    p.out = (float*)d_out; p.ws = (unsigned char*)d_ws;
    void* args[] = {&p};
    hipError_t e = hipLaunchCooperativeKernel((const void*)mk::fwd, dim3(grid_blocks), dim3(512), args, mk::LDS_BYTES, stream);
    if (e != hipSuccess) fprintf(stderr, "cooperative launch failed: %s (grid %d)\n", hipGetErrorString(e), grid_blocks);
}
```

```cpp
#include <hip/hip_runtime.h>
#include <cstdio>
#include <cstdint>

template <int K> __device__ __forceinline__ float xor_add(float v) {
    if constexpr (K < 32) return v + __int_as_float(__builtin_amdgcn_ds_swizzle(__float_as_int(v), (K << 10) | 0x1f));
    else { auto rr = __builtin_amdgcn_permlane32_swap(__float_as_uint(v), __float_as_uint(v), false, false); return __uint_as_float(rr[0]) + __uint_as_float(rr[1]); }
}
template <int K> __device__ __forceinline__ float xor_max(float v) {
    if constexpr (K < 32) return fmaxf(v, __int_as_float(__builtin_amdgcn_ds_swizzle(__float_as_int(v), (K << 10) | 0x1f)));
    else { auto rr = __builtin_amdgcn_permlane32_swap(__float_as_uint(v), __float_as_uint(v), false, false); return fmaxf(__uint_as_float(rr[0]), __uint_as_float(rr[1])); }
}
namespace pg8 {
#define PG8_LAS __attribute__((address_space(3)))
typedef unsigned short bf16_t;
typedef short bf16x8 __attribute__((ext_vector_type(8)));
typedef float f32x4 __attribute__((ext_vector_type(4)));
typedef unsigned u32x4 __attribute__((ext_vector_type(4)));
constexpr int BM = 256, BK = 64, HALF = 128, HTB = HALF * BK * 2  , STAGE_BYTES = 8 * HTB, NXCD = 8, WGM = 8;

__host__ __device__ __forceinline__ int lds_byte(int r, int c) { const int st = (r >> 4) * 2 + (c >> 5), rr = r & 15, cc = c & 31, ob = rr * 64 + cc * 2; return st * 1024 + (ob ^ (((ob >> 9) & 1) << 5)); }
__host__ __device__ __forceinline__ void stage_rc(int b, int& R, int& C) { const int st = b / 1024, sb = b % 1024, swz = sb ^ (((sb >> 9) & 1) << 5); R = (st >> 1) * 16 + swz / 64; C = (st & 1) * 32 + (swz % 64) / 2; }
__host__ __device__ __forceinline__ int perm32(int rho) { const int n = rho >> 4, i = rho & 15; return 8 * (i >> 2) + 4 * n + (i & 3); }

struct Unit { int pm, pn; };
struct Gemm { const bf16_t* A; const bf16_t* Bt; int M, N, K; };

struct StaticOrder {
    int nM, nN, nwg, G, c;
    __host__ __device__ void init(int M, int N, int G_, int c_) { nM = M / BM; nN = N / BM; nwg = nM * nN; G = G_; c = c_; }
    __host__ __device__ bool next(int i, Unit& u) const {
        const long L = (long)i * G + c; if (L >= nwg) return false;
        int wgid = (int)L; { const int q = nwg / NXCD, r = nwg % NXCD, xcd = wgid % NXCD, off = wgid / NXCD; wgid = (xcd < r ? xcd * (q + 1) : r * (q + 1) + (xcd - r) * q) + off; }
        const int nig = WGM * nN, gid = wgid / nig, fm = gid * WGM, gsz = (nM - fm) < WGM ? (nM - fm) : WGM;
        u.pm = fm + ((wgid % nig) % gsz); u.pn = (wgid % nig) / gsz; return true;
    }
    __device__ __forceinline__ void a_ready(const Unit&) const {}
    __device__ __forceinline__ void done(const Unit&) const {}
};

__device__ __forceinline__ unsigned cvt_pk_bf16(float lo, float hi) { unsigned r; asm volatile("v_cvt_pk_bf16_f32 %0, %1, %2" : "=v"(r) : "v"(lo), "v"(hi)); return r; }
typedef float f32x2 __attribute__((ext_vector_type(2)));
constexpr float RMS_EPS = 1e-6f;
typedef unsigned u32x2 __attribute__((ext_vector_type(2)));
__device__ __forceinline__ float sigm(float x) { return __builtin_amdgcn_rcpf(1.0f + __expf(-x)); }
__device__ __forceinline__ float bflo(unsigned w) { return __uint_as_float(w << 16); }
__device__ __forceinline__ float bfhi(unsigned w) { return __uint_as_float(w & 0xffff0000u); }
__device__ __forceinline__ float ssq16(const float* s, int r) { const f32x4* q = (const f32x4*)(s + (size_t)r * 16); const f32x4 a = q[0] + q[1], b = q[2] + q[3], c = a + b; return (c[0] + c[1]) + (c[2] + c[3]); }
template <int ACT> struct EpiRow {
    static constexpr bool PERM = true, AFTER_DRAIN = false;
    bf16_t* O; int ldc; const float* ssq; unsigned qmask; float qscale; int split_cols; size_t split_stride;
    __device__ __forceinline__ void operator()(const f32x4 (&acc)[2][2][4][2], const Unit& u, int wr, int wc, int fr, int fq) const {
        int colt = u.pn * BM; bf16_t* Ob = O; if (split_cols) { const int t = colt / split_cols; Ob += (size_t)t * split_stride; colt -= t * split_cols; }
        const int row0 = u.pm * BM + wr * 64 + fr, col0 = colt + wc * 32 + 8 * fq;
        const float cs = ((qmask >> u.pn) & 1u) ? qscale : 1.f;
#pragma unroll
        for (int ai = 0; ai < 2; ++ai)
#pragma unroll
            for (int m = 0; m < 4; ++m) { const int r = row0 + ai * HALF + m * 16; const float rs = rsqrtf(ssq16(ssq, r) * (1.0f / 1024.0f) + RMS_EPS) * cs;
                bf16_t* rowp = Ob + (size_t)r * ldc + col0;
#pragma unroll
                for (int bj = 0; bj < 2; ++bj) { f32x4 v0 = acc[ai][bj][m][0] * rs, v1 = acc[ai][bj][m][1] * rs;
                    if (ACT == 1) {
#pragma unroll
                        for (int e = 0; e < 4; ++e) { const float a = fmaxf(v0[e], 0.f), b = fmaxf(v1[e], 0.f); v0[e] = a * a; v1[e] = b * b; } }
                    u32x4 w; w.x = cvt_pk_bf16(v0[0], v0[1]); w.y = cvt_pk_bf16(v0[2], v0[3]); w.z = cvt_pk_bf16(v1[0], v1[1]); w.w = cvt_pk_bf16(v1[2], v1[3]);
                    *(u32x4*)(rowp + bj * HALF) = w; } }
    }
};
template <int MODE> struct EpiRes {
    static constexpr bool PERM = false, AFTER_DRAIN = false;
    const bf16_t* base; bf16_t* outb; float* ssq_next; const float* ssq_cur; const bf16_t* pp;
    __device__ __forceinline__ void operator()(const f32x4 (&acc)[2][2][4][2], const Unit& u, int wr, int wc, int fr, int fq) const {
        const int row0 = u.pm * BM + wr * 64 + fr, col0 = u.pn * BM + wc * 32 + 4 * fq;
#pragma unroll
        for (int ai = 0; ai < 2; ++ai)
#pragma unroll
            for (int m = 0; m < 4; ++m) { const int r = row0 + ai * HALF + m * 16; const size_t off = (size_t)r * 1024 + col0; float sq = 0.f;
                float rs = 0.f; if (MODE == 1) rs = rsqrtf(ssq16(ssq_cur, r) * (1.0f / 1024.0f) + RMS_EPS);
#pragma unroll
                for (int bj = 0; bj < 2; ++bj)
#pragma unroll
                    for (int n = 0; n < 2; ++n) { const size_t o = off + bj * HALF + n * 16; f32x4 a = acc[ai][bj][m][n];
                        if (MODE == 1) { const u32x2 g = *(const u32x2*)(pp + o);
                            a[0] = bflo(g.x) * sigm(a[0] * rs); a[1] = bfhi(g.x) * sigm(a[1] * rs); a[2] = bflo(g.y) * sigm(a[2] * rs); a[3] = bfhi(g.y) * sigm(a[3] * rs); }
                        const u32x2 bv = *(const u32x2*)(base + o);
                        const f32x4 hv = (f32x4){bflo(bv.x), bfhi(bv.x), bflo(bv.y), bfhi(bv.y)} + a;
                        u32x2 w; w.x = cvt_pk_bf16(hv[0], hv[1]); w.y = cvt_pk_bf16(hv[2], hv[3]); *(u32x2*)(outb + o) = w;
                        sq += (hv[0] * hv[0] + hv[1] * hv[1]) + (hv[2] * hv[2] + hv[3] * hv[3]); }
                sq = xor_add<16>(sq); sq = xor_add<32>(sq);
                if (fq == 0) ssq_next[(size_t)r * 16 + u.pn * 4 + wc] = sq; }
    }
};
struct EpiPP {
    static constexpr bool PERM = false, AFTER_DRAIN = false;
    bf16_t* O;
    __device__ __forceinline__ void operator()(const f32x4 (&acc)[2][2][4][2], const Unit& u, int wr, int wc, int fr, int fq) const {
        const int row0 = u.pm * BM + wr * 64 + fr, col0 = u.pn * BM + wc * 32 + 4 * fq;
#pragma unroll
        for (int ai = 0; ai < 2; ++ai)
#pragma unroll
            for (int m = 0; m < 4; ++m) { const size_t off = (size_t)(row0 + ai * HALF + m * 16) * 1024 + col0;
#pragma unroll
                for (int bj = 0; bj < 2; ++bj)
#pragma unroll
                    for (int n = 0; n < 2; ++n) { const f32x4 a = acc[ai][bj][m][n]; u32x2 w; w.x = cvt_pk_bf16(a[0], a[1]); w.y = cvt_pk_bf16(a[2], a[3]); *(u32x2*)(O + off + bj * HALF + n * 16) = w; } }
    }
};
struct EpiGlu {
    static constexpr bool PERM = true, AFTER_DRAIN = false;
    bf16_t* O; const bf16_t* yg;
    __device__ __forceinline__ void operator()(const f32x4 (&acc)[2][2][4][2], const Unit& u, int wr, int wc, int fr, int fq) const {
        const int row0 = u.pm * BM + wr * 64 + fr, col0 = u.pn * BM + wc * 32 + 8 * fq;
#pragma unroll
        for (int ai = 0; ai < 2; ++ai)
#pragma unroll
            for (int m = 0; m < 4; ++m) { const int r = row0 + ai * HALF + m * 16;
#pragma unroll
                for (int bj = 0; bj < 2; ++bj) { const int c = col0 + bj * HALF; const u32x4 y = *(const u32x4*)(yg + (size_t)r * 512 + c);
                    const f32x4 v0 = acc[ai][bj][m][0], v1 = acc[ai][bj][m][1]; u32x4 w;
                    w.x = cvt_pk_bf16(bflo(y.x) * sigm(v0[0]), bfhi(y.x) * sigm(v0[1])); w.y = cvt_pk_bf16(bflo(y.y) * sigm(v0[2]), bfhi(y.y) * sigm(v0[3]));
                    w.z = cvt_pk_bf16(bflo(y.z) * sigm(v1[0]), bfhi(y.z) * sigm(v1[1])); w.w = cvt_pk_bf16(bflo(y.w) * sigm(v1[2]), bfhi(y.w) * sigm(v1[3]));
                    *(u32x4*)(O + (size_t)r * 1024 + c) = w; } }
    }
};
template <class Epi, class Sched, bool ALIGN_EPI = false, bool SP2 = false>
__device__ __forceinline__ void gemm_phase(PG8_LAS unsigned char* lds, const Gemm g, const Sched& S, const Epi& E) {
    int tid = threadIdx.x; asm volatile("" : "+v"(tid)); const int wid = __builtin_amdgcn_readfirstlane(tid >> 6), lane = tid & 63, wr = wid >> 2, wc = wid & 3, fr = lane & 15, fq = lane >> 4;
    const int K = g.K, nt = K / BK;
    unsigned voffA[2], voffB[2];
#pragma unroll
    for (int i = 0; i < 2; ++i) { int R, C; stage_rc(tid * 16 + i * 8192, R, C); const int Rb = Epi::PERM ? ((R & ~31) + perm32(R & 31)) : R;
        voffA[i] = (unsigned)(R * K + C) * 2u; voffB[i] = (unsigned)(Rb * K + C) * 2u; }
    const size_t kstep = (size_t)(BK * 2);
    const size_t hstep = (size_t)HALF * K * 2;
    const size_t tstep = 2 * hstep;
    const unsigned ldsw = (unsigned)wid * 1024u;
    const int aoff = lds_byte(wr * 64 + fr, fq * 8), boff = lds_byte(wc * 32 + fr, fq * 8);
#define PG8_SA(b, h) (((b) * 2 + (h)) * HTB)
#define PG8_SB(b, h) ((4 + (b) * 2 + (h)) * HTB)
#define PG8_STAGE(bufoff, gbase, voff) do { _Pragma("unroll") for (int _i = 0; _i < 2; ++_i) \
        __builtin_amdgcn_global_load_lds((const unsigned*)((const char*)(gbase) + (voff)[_i]), (PG8_LAS unsigned*)(lds + (bufoff) + ldsw + _i * 8192), 16, 0, 0); } while (0)
#define PG8_LDA(dst, b, h) do { _Pragma("unroll") for (int m = 0; m < 4; ++m) _Pragma("unroll") for (int k = 0; k < 2; ++k) dst[m][k] = *(const PG8_LAS bf16x8*)(lds + PG8_SA(b, h) + aoff + m * 2048 + k * 1024); } while (0)
#define PG8_LDB(dst, b, h) do { _Pragma("unroll") for (int n = 0; n < 2; ++n) _Pragma("unroll") for (int k = 0; k < 2; ++k) dst[n][k] = *(const PG8_LAS bf16x8*)(lds + PG8_SB(b, h) + boff + n * 2048 + k * 1024); } while (0)
#define PG8_MMA(ai, bj, At, Bt) do { __builtin_amdgcn_s_setprio(1); _Pragma("unroll") for (int m = 0; m < 4; ++m) _Pragma("unroll") for (int n = 0; n < 2; ++n) _Pragma("unroll") for (int k = 0; k < 2; ++k) \
        acc[ai][bj][m][n] = __builtin_amdgcn_mfma_f32_16x16x32_bf16(Bt[n][k], At[m][k], acc[ai][bj][m][n], 0, 0, 0); __builtin_amdgcn_s_setprio(0); } while (0)
#define PG8_WAIT_V(n) asm volatile("s_waitcnt vmcnt(" #n ")" ::: "memory")
#define PG8_WAIT_L(n) asm volatile("s_waitcnt lgkmcnt(" #n ")" ::: "memory")
#define PG8_BAR __builtin_amdgcn_s_barrier()
#define PG8_SCHED __builtin_amdgcn_sched_barrier(0)
    Unit cur, nxt; int ui = 0;
    if (!S.next(0, cur)) return;
    f32x4 acc[2][2][4][2];
#pragma unroll
    for (int a = 0; a < 2; ++a)
#pragma unroll
        for (int b = 0; b < 2; ++b)
#pragma unroll
            for (int m = 0; m < 4; ++m)
#pragma unroll
                for (int n = 0; n < 2; ++n) acc[a][b][m][n] = (f32x4){0.f, 0.f, 0.f, 0.f};
    bf16x8 At[4][2], B0[2][2], B1[2][2];
    const char* cA = (const char*)g.A + (size_t)cur.pm * tstep; const char* cB = (const char*)g.Bt + (size_t)cur.pn * tstep;
    S.a_ready(cur);
    if constexpr (SP2) {
        PG8_STAGE(PG8_SB(0, 0), cB, voffB); PG8_STAGE(PG8_SB(0, 1), cB + hstep, voffB); PG8_STAGE(PG8_SA(0, 0), cA, voffA); PG8_STAGE(PG8_SA(0, 1), cA + hstep, voffA);
        if (wr == 1) PG8_BAR;
        PG8_WAIT_V(2); PG8_BAR;
        PG8_STAGE(PG8_SB(1, 0), cB + kstep, voffB); PG8_STAGE(PG8_SA(1, 0), cA + kstep, voffA); PG8_STAGE(PG8_SB(1, 1), cB + hstep + kstep, voffB);
        PG8_WAIT_V(6); PG8_BAR;
    } else {
        PG8_STAGE(PG8_SB(0, 0), cB, voffB); PG8_STAGE(PG8_SA(0, 0), cA, voffA); PG8_STAGE(PG8_SB(0, 1), cB + hstep, voffB); PG8_STAGE(PG8_SA(0, 1), cA + hstep, voffA);
        if (wr == 1) PG8_BAR;
        PG8_WAIT_V(4); PG8_BAR;
        PG8_STAGE(PG8_SB(1, 0), cB + kstep, voffB); PG8_STAGE(PG8_SA(1, 0), cA + kstep, voffA); PG8_STAGE(PG8_SB(1, 1), cB + hstep + kstep, voffB);
        PG8_WAIT_V(6); PG8_BAR;
    }
    for (;;) {
        const bool has_next = S.next(ui + 1, nxt);
        const char* nA = has_next ? (const char*)g.A + (size_t)nxt.pm * tstep : cA; const char* nB = has_next ? (const char*)g.Bt + (size_t)nxt.pn * tstep : cB;
        for (int t = 0; t < nt; t += 2) {
            const bool last = (t == nt - 2);
            const char* a1 = cA + (size_t)(t + 1) * kstep;
            const char* a2 = last ? nA : cA + (size_t)(t + 2) * kstep; const char* b2 = last ? nB : cB + (size_t)(t + 2) * kstep;
            const char* a3 = a2 + kstep; const char* b3 = b2 + kstep;
            if (last && has_next) S.a_ready(nxt);
            if constexpr (SP2) {
            PG8_LDB(B0, 0, 0); PG8_LDB(B1, 0, 1); PG8_SCHED; PG8_LDA(At, 0, 0); PG8_STAGE(PG8_SA(1, 1), a1 + hstep, voffA);
            PG8_WAIT_V(8); PG8_WAIT_L(0); PG8_BAR; PG8_MMA(0, 0, At, B0); PG8_MMA(0, 1, At, B1); PG8_BAR; PG8_SCHED;
            PG8_LDA(At, 0, 1); PG8_STAGE(PG8_SB(0, 0), b2, voffB); PG8_STAGE(PG8_SB(0, 1), b2 + hstep, voffB); PG8_STAGE(PG8_SA(0, 0), a2, voffA);
            PG8_WAIT_V(8); PG8_WAIT_L(0); PG8_BAR; PG8_MMA(1, 0, At, B0); PG8_MMA(1, 1, At, B1); PG8_BAR; PG8_SCHED;
            PG8_LDB(B0, 1, 0); PG8_LDB(B1, 1, 1); PG8_SCHED; PG8_LDA(At, 1, 0); PG8_STAGE(PG8_SA(0, 1), a2 + hstep, voffA);
            PG8_WAIT_V(8); PG8_WAIT_L(0); PG8_BAR; PG8_MMA(0, 0, At, B0); PG8_MMA(0, 1, At, B1); PG8_BAR; PG8_SCHED;
            PG8_LDA(At, 1, 1); PG8_STAGE(PG8_SB(1, 0), b3, voffB); PG8_STAGE(PG8_SB(1, 1), b3 + hstep, voffB); PG8_STAGE(PG8_SA(1, 0), a3, voffA);
            PG8_WAIT_V(8); PG8_WAIT_L(0); PG8_BAR; PG8_MMA(1, 0, At, B0); PG8_MMA(1, 1, At, B1); PG8_BAR; PG8_SCHED;
            } else {
            PG8_LDB(B0, 0, 0); PG8_SCHED; PG8_LDA(At, 0, 0); PG8_STAGE(PG8_SA(1, 1), a1 + hstep, voffA);
            PG8_WAIT_L(8); PG8_BAR; PG8_WAIT_L(0); PG8_MMA(0, 0, At, B0); PG8_BAR; PG8_SCHED;
            PG8_LDB(B1, 0, 1); PG8_STAGE(PG8_SB(0, 0), b2, voffB);
            PG8_BAR; PG8_WAIT_L(0); PG8_MMA(0, 1, At, B1); PG8_BAR;
            PG8_LDA(At, 0, 1); PG8_STAGE(PG8_SA(0, 0), a2, voffA);
            PG8_BAR; PG8_WAIT_L(0); PG8_MMA(1, 0, At, B0); PG8_BAR; PG8_SCHED;
            PG8_STAGE(PG8_SB(0, 1), b2 + hstep, voffB);
            PG8_WAIT_V(6); PG8_BAR; PG8_MMA(1, 1, At, B1); PG8_BAR;
            PG8_LDB(B0, 1, 0); PG8_SCHED; PG8_LDA(At, 1, 0); PG8_STAGE(PG8_SA(0, 1), a2 + hstep, voffA);
            PG8_WAIT_L(8); PG8_BAR; PG8_WAIT_L(0); PG8_MMA(0, 0, At, B0); PG8_BAR; PG8_SCHED;
            PG8_LDB(B1, 1, 1); PG8_STAGE(PG8_SB(1, 0), b3, voffB);
            PG8_BAR; PG8_WAIT_L(0); PG8_MMA(0, 1, At, B1); PG8_BAR;
            PG8_LDA(At, 1, 1); PG8_STAGE(PG8_SA(1, 0), a3, voffA);
            PG8_BAR; PG8_WAIT_L(0); PG8_MMA(1, 0, At, B0); PG8_BAR; PG8_SCHED;
            PG8_STAGE(PG8_SB(1, 1), b3 + hstep, voffB);
            PG8_WAIT_V(6); PG8_BAR; PG8_MMA(1, 1, At, B1); PG8_BAR;
            }
        }
        if constexpr (ALIGN_EPI) { if (wr == 0) PG8_BAR; }
        if constexpr (!Epi::AFTER_DRAIN) { E(acc, cur, wr, wc, fr, fq); S.done(cur); }
        if (!has_next) break;
#pragma unroll
        for (int a = 0; a < 2; ++a)
#pragma unroll
            for (int b = 0; b < 2; ++b)
#pragma unroll
                for (int m = 0; m < 4; ++m)
#pragma unroll
                    for (int n = 0; n < 2; ++n) acc[a][b][m][n] = (f32x4){0.f, 0.f, 0.f, 0.f};
        cur = nxt; cA = nA; cB = nB; ++ui;
        if constexpr (ALIGN_EPI) { if (wr == 1) PG8_BAR; }
    }
    PG8_WAIT_V(0);
    if constexpr (!ALIGN_EPI) { if (wr == 0) PG8_BAR; }
    PG8_BAR;
    if constexpr (Epi::AFTER_DRAIN) { E.fused(acc, cur, wr, wc, fr, fq, lds, wid, lane); S.done(cur); }
#undef PG8_SA
#undef PG8_SB
#undef PG8_STAGE
#undef PG8_LDA
#undef PG8_LDB
#undef PG8_MMA
#undef PG8_WAIT_V
#undef PG8_WAIT_L
#undef PG8_BAR
#undef PG8_SCHED
}
}
#include <hip/hip_bf16.h>
#include <cmath>
namespace attn_body {
using bf16=__hip_bfloat16;
using bf16x8=__attribute__((ext_vector_type(8)))short;
using s16x4=__attribute__((ext_vector_type(4)))short;
using f32x16=__attribute__((ext_vector_type(16)))float;
using u32x4=__attribute__((ext_vector_type(4)))unsigned;
constexpr int SEQ=4096,D=64,PQ=512,PO=1024;
constexpr int NW=8,QBLK=32,QB=QBLK*NW,KVBLK=64,NQB=SEQ/QB;

__device__ __forceinline__ int crow(int r,int hi){return (r&3)+8*(r>>2)+4*hi;}
#define SBAR() __builtin_amdgcn_sched_barrier(0)
__device__ __forceinline__ void cmask(f32x16&p0,f32x16&p1,int jb,int qrel,int hi){
  const float NEG=-INFINITY; int kb=64*jb+4*hi;
  #pragma unroll
  for(int r=0;r<16;++r){int kv=kb+(r&3)+8*(r>>2); if(kv>qrel)p0[r]=NEG; if(kv+32>qrel)p1[r]=NEG;}
}

constexpr int NSLOT=3, SLOTB=8192;
constexpr int LDS_K=0, LDS_V=NSLOT*SLOTB, LDS_WS=2*NSLOT*SLOTB, LDS_OST=LDS_WS+NW*64*4, LDS_BYTES=LDS_OST+NW*4096;
constexpr float C2=0.125f*1.4426950408889634f;
__device__ __forceinline__ void glds16(const void*gsrc,unsigned lds_dst){unsigned keep;
  asm volatile("s_mov_b32 %0, m0\n\ts_mov_b32 m0, %2\n\ts_nop 0\n\tglobal_load_lds_dwordx4 %1, off\n\ts_mov_b32 m0, %0":"=&s"(keep):"v"(gsrc),"s"(lds_dst):"memory");}
__device__ __forceinline__ float max3f(float a,float b,float c){float r;asm("v_max3_f32 %0, %1, %2, %3":"=v"(r):"v"(a),"v"(b),"v"(c));return r;}
__device__ __forceinline__ float max2f(float a,float b){float r;asm("v_max_f32_e32 %0, %1, %2":"=v"(r):"v"(a),"v"(b));return r;}
__device__ __forceinline__ float fadd_s(float a,float b){float r;asm("v_add_f32_e32 %0, %1, %2":"=v"(r):"v"(a),"v"(b));return r;}
__device__ __forceinline__ float fsub_s(float a,float b){float r;asm("v_sub_f32_e32 %0, %1, %2":"=v"(r):"v"(a),"v"(b));return r;}
typedef float f32x2_t __attribute__((ext_vector_type(2))); typedef __bf16 bf16x2_t __attribute__((ext_vector_type(2)));
__device__ __forceinline__ unsigned cvtpk_s(float lo,float hi){f32x2_t v={lo,hi};bf16x2_t b=__builtin_convertvector(v,bf16x2_t);return __builtin_bit_cast(unsigned,b);}
#define WAIT_BAR(N) asm volatile("s_waitcnt vmcnt(" #N ") lgkmcnt(0)\n\ts_barrier":::"memory")

__device__ __forceinline__ void qkt(f32x16&p0,f32x16&p1,const char*Kslot,const bf16x8*qr,const f32x16&negm,int r32,int hi){
  const char*kb=Kslot+hi*1024+r32*16;
  #pragma unroll
  for(int d0=0;d0<4;++d0){
    const bf16x8 b0=*reinterpret_cast<const bf16x8*>(kb+d0*2048);
    const bf16x8 b1=*reinterpret_cast<const bf16x8*>(kb+d0*2048+512);
    if(d0==0){p0=__builtin_amdgcn_mfma_f32_32x32x16_bf16(b0,qr[0],negm,0,0,0);p1=__builtin_amdgcn_mfma_f32_32x32x16_bf16(b1,qr[0],negm,0,0,0);}
    else{p0=__builtin_amdgcn_mfma_f32_32x32x16_bf16(b0,qr[d0],p0,0,0,0);p1=__builtin_amdgcn_mfma_f32_32x32x16_bf16(b1,qr[d0],p1,0,0,0);}}
}
typedef __attribute__((address_space(3))) const char* lds_cptr;
typedef short v4i16_t __attribute__((ext_vector_type(4)));
__device__ __forceinline__ void kload8(bf16x8*kf,lds_cptr kp){
  kf[0]=*(const __attribute__((address_space(3))) bf16x8*)(kp);      kf[1]=*(const __attribute__((address_space(3))) bf16x8*)(kp+512);
  kf[2]=*(const __attribute__((address_space(3))) bf16x8*)(kp+2048); kf[3]=*(const __attribute__((address_space(3))) bf16x8*)(kp+2560);
  kf[4]=*(const __attribute__((address_space(3))) bf16x8*)(kp+4096); kf[5]=*(const __attribute__((address_space(3))) bf16x8*)(kp+4608);
  kf[6]=*(const __attribute__((address_space(3))) bf16x8*)(kp+6144); kf[7]=*(const __attribute__((address_space(3))) bf16x8*)(kp+6656);
}
__device__ __forceinline__ void kload2(bf16x8*kf,lds_cptr kp,int j){ kf[2*j]=*(const __attribute__((address_space(3))) bf16x8*)(kp+j*2048); kf[2*j+1]=*(const __attribute__((address_space(3))) bf16x8*)(kp+j*2048+512); }
__device__ __forceinline__ s16x4 vtr(lds_cptr p){ return __builtin_bit_cast(s16x4,__builtin_amdgcn_ds_read_tr16_b64_v4i16((__attribute__((address_space(3))) v4i16_t*)p)); }
__device__ __forceinline__ float rowmax(const f32x16&p0,const f32x16&p1){
  float a=max3f(p0[0],p0[1],p1[0]),b=max3f(p0[2],p0[3],p1[1]);a=max3f(a,p1[2],p1[3]);
  #pragma unroll
  for(int r=4;r<16;r+=4){a=max3f(a,p0[r],p0[r+1]);b=max3f(b,p0[r+2],p0[r+3]);a=max3f(a,p1[r],p1[r+1]);b=max3f(b,p1[r+2],p1[r+3]);}
  const float m=max2f(a,b);
  auto rr=__builtin_amdgcn_permlane32_swap(__float_as_uint(m),__float_as_uint(m),false,false);
  return max2f(__uint_as_float(rr[0]),__uint_as_float(rr[1]));
}
__device__ __forceinline__ void pv(f32x16*o,int vb,bf16x8 pa0,bf16x8 pa1,bf16x8 pa2,bf16x8 pa3){
  #pragma unroll
  for(int d0=0;d0<2;++d0){s16x4 lo[4],hi[4];
    #pragma unroll
    for(int ks=0;ks<4;++ks){
      asm volatile("ds_read_b64_tr_b16 %0,%1 offset:%c2":"=&v"(lo[ks]):"v"(vb),"i"(d0*4096+ks*1024):"memory");
      asm volatile("ds_read_b64_tr_b16 %0,%1 offset:%c2":"=&v"(hi[ks]):"v"(vb),"i"(d0*4096+ks*1024+512):"memory");}
    asm volatile("s_waitcnt lgkmcnt(0)":::"memory");SBAR();
    #define PK(k) (bf16x8){lo[k][0],lo[k][1],lo[k][2],lo[k][3],hi[k][0],hi[k][1],hi[k][2],hi[k][3]}
    o[d0]=__builtin_amdgcn_mfma_f32_32x32x16_bf16(pa0,PK(0),o[d0],0,0,0);
    o[d0]=__builtin_amdgcn_mfma_f32_32x32x16_bf16(pa1,PK(1),o[d0],0,0,0);
    o[d0]=__builtin_amdgcn_mfma_f32_32x32x16_bf16(pa2,PK(2),o[d0],0,0,0);
    o[d0]=__builtin_amdgcn_mfma_f32_32x32x16_bf16(pa3,PK(3),o[d0],0,0,0);
    #undef PK
  }
}

#ifndef ATTN_STORE16
#define ATTN_STORE16(p,v) (*(u32x4*)(p)=(v))
#endif
template<int THRL> __device__ __forceinline__ void attn_unit(int b,int h,int qb,const bf16*Q,const bf16*__restrict__ K,const bf16*__restrict__ V,bf16*O,char*shm){
  int tid=threadIdx.x; asm volatile("":"+v"(tid)); const int lane=tid&63,r32=lane&31,hi=lane>>5; const int wid=__builtin_amdgcn_readfirstlane(tid>>6);
  const long rowbase=(long)b*SEQ; const int q0=qb*QB;
  const bf16*Qw=Q+(rowbase+q0+wid*QBLK)*PQ;
  const bf16*Kh=K+rowbase*PQ,*Vh=V+rowbase*PQ;
  const unsigned lds0=(unsigned)(uintptr_t)shm;
  float*wsf=(float*)(shm+LDS_WS)+wid*64;
  const bf16*ksrc=Kh+(long)lane*PQ+wid*8;
  const bf16*vsrc=Vh+(long)(16*(wid&3)+(lane>>2))*PQ+(wid>>2)*32+(lane&3)*8;
  const unsigned kdst=lds0+LDS_K+wid*1024, vdst=lds0+LDS_V+wid*1024;
  #define DMA_K(t,slot) glds16(ksrc+(long)(t)*KVBLK*PQ,(unsigned)__builtin_amdgcn_readfirstlane(kdst+(slot)))
  #define DMA_V(t,slot) glds16(vsrc+(long)(t)*KVBLK*PQ,(unsigned)__builtin_amdgcn_readfirstlane(vdst+(slot)))
  const int vb0=(int)(lds0+LDS_V)+((lane>>4)&1)*32+(lane&3)*8+(4*hi+((lane&15)>>2))*64;
  const char*Kbase=shm+LDS_K; bf16x8 kf[8];
  const lds_cptr shm3=(lds_cptr)shm; const lds_cptr kp0=shm3+LDS_K+hi*1024+r32*16; const lds_cptr vp0=shm3+LDS_V+((lane>>4)&1)*32+(lane&3)*8+(4*hi+((lane&15)>>2))*64;
  const int NT=(q0+QB)/KVBLK;
  DMA_K(0,0);DMA_V(0,0);DMA_K(1,SLOTB);
  bf16x8 qr[4];
  #pragma unroll
  for(int d0=0;d0<4;++d0)qr[d0]=*reinterpret_cast<const bf16x8*>(&Qw[(long)r32*PQ+d0*16+hi*8]);
  float mhat=0.f,l_reg=0.f;f32x16 o[2];o[0]=f32x16{};o[1]=f32x16{};float zz_=0.f;asm volatile("":"+v"(zz_));f32x16 negm;
  _Pragma("unroll") for(int r=0;r<16;++r)negm[r]=zz_;
  const int qrel=wid*QBLK+r32;
  #define CMASK(P0,P1,t) do{int jb_=(t)-(NT-4); if(jb_>=0)cmask(P0,P1,jb_,qrel,hi);}while(0)
  bool resc=false;
  #define START(P0,P1) do{ const float rm=rowmax(P0,P1); resc=false; \
    { const float dl=rm; mhat=fadd_s(mhat,dl); \
      _Pragma("unroll") for(int r=0;r<16;++r){P0[r]=fsub_s(P0[r],dl);P1[r]=fsub_s(P1[r],dl);} \
      _Pragma("unroll") for(int r=0;r<16;++r)negm[r]=-mhat; asm volatile("":"+v"(negm)); } \
    _Pragma("unroll") for(int r=0;r<16;++r)P0[r]=__builtin_amdgcn_exp2f(P0[r]); }while(0)
  #define RESC() do{ if(resc){ asm volatile("s_waitcnt lgkmcnt(0)":::"memory"); \
      _Pragma("unroll") for(int d_=0;d_<2;++d_) _Pragma("unroll") for(int r=0;r<16;++r)o[d_][r]*=wsf[crow(r,hi)]; } }while(0)
  f32x16 pA0,pA1,pB0,pB1;
  int sl_prev=0,sl_cur=0,sl_next=SLOTB;
  #define ROT() do{sl_prev=sl_cur;sl_cur=sl_next;sl_next=(sl_next==(NSLOT-1)*SLOTB)?0:sl_next+SLOTB;}while(0)
  DMA_K(2,2*SLOTB);
  WAIT_BAR(3);
  qkt(pA0,pA1,Kbase,qr,negm,r32,hi);asm volatile("s_nop 15\n\ts_nop 7":"+v"(pA0),"+v"(pA1));CMASK(pA0,pA1,0);
  START(pA0,pA1);
  _Pragma("unroll") for(int r=0;r<16;++r)pA1[r]=__builtin_amdgcn_exp2f(pA1[r]);
  WAIT_BAR(0);
  DMA_K(3,0);DMA_V(1,SLOTB);
  ROT();
  kload8(kf,kp0+sl_cur);
  WAIT_BAR(2);
  s16x4 vlo[8],vhi[8]; u32x4 pw0,pw1,pw2,pw3;
  #define PKW(P,B) cvtpk_s(P[B],P[B+1])
  #define PAF(k) __builtin_bit_cast(bf16x8,pw##k)
  #define VFR(i) (bf16x8){vlo[i][0],vlo[i][1],vlo[i][2],vlo[i][3],vhi[i][0],vhi[i][1],vhi[i][2],vhi[i][3]}
  #define PIN(x) asm volatile("":"+v"(x))
  #define MX3(a,b,c) __builtin_fmaxf(__builtin_fmaxf((a),(b)),(c))
  #define GAPA(MF,A0,A1,A2,A3,W0,W1,PW) do{ MF; sacc+=A0; sacc+=A1; sacc+=A2; sacc+=A3; PIN(sacc); W0; W1; PIN(PW); SBAR(); }while(0)
  #define EX(v) __builtin_amdgcn_exp2f(v)
  #define GAPB(MF,X,B) do{ MF; X[B]=EX(X[B]); X[B+1]=EX(X[B+1]); X[B+2]=EX(X[B+2]); X[B+3]=EX(X[B+3]); PIN(X); SBAR(); }while(0)
  #define VRD(i) do{ vlo[i]=vtr(vp_+(((i)>>2)*4096+((i)&3)*1024)); vhi[i]=vtr(vp_+(((i)>>2)*4096+((i)&3)*1024+512)); }while(0)
  #define KRD(G,j) do{ if(G){ kload2(kf,kp0+sl_next,j); SBAR(); } }while(0)
  #define STEP(C0,C1,P0,P1,t,GK,GV,GL) do{ SBAR(); \
    const lds_cptr vp_=vp0+sl_prev; \
    VRD(0); SBAR(); float sacc=(P0[0]+P0[1]); \
    GAPA(C0=__builtin_amdgcn_mfma_f32_32x32x16_bf16(kf[0],qr[0],negm,0,0,0), P0[2],P0[3],P0[4],P0[5],     pw0[0]=PKW(P0,0), pw0[1]=PKW(P0,2), pw0); \
    VRD(4); SBAR(); GAPA(C1=__builtin_amdgcn_mfma_f32_32x32x16_bf16(kf[1],qr[0],negm,0,0,0), P0[6],P0[7],P0[8],P0[9],     pw0[2]=PKW(P0,4), pw0[3]=PKW(P0,6), pw0); \
    VRD(1); SBAR(); GAPA(C0=__builtin_amdgcn_mfma_f32_32x32x16_bf16(kf[2],qr[1],C0,0,0,0),   P0[10],P0[11],P0[12],P0[13], pw1[0]=PKW(P0,8), pw1[1]=PKW(P0,10), pw1); \
    VRD(5); SBAR(); GAPA(C1=__builtin_amdgcn_mfma_f32_32x32x16_bf16(kf[3],qr[1],C1,0,0,0),   P0[14],P0[15],P1[0],P1[1],   pw1[2]=PKW(P0,12),pw1[3]=PKW(P0,14), pw1); \
    VRD(2); SBAR(); GAPA(C0=__builtin_amdgcn_mfma_f32_32x32x16_bf16(kf[4],qr[2],C0,0,0,0),   P1[2],P1[3],P1[4],P1[5],     pw2[0]=PKW(P1,0), pw2[1]=PKW(P1,2), pw2); \
    VRD(6); SBAR(); GAPA(C1=__builtin_amdgcn_mfma_f32_32x32x16_bf16(kf[5],qr[2],C1,0,0,0),   P1[6],P1[7],P1[8],P1[9],     pw2[2]=PKW(P1,4), pw2[3]=PKW(P1,6), pw2); \
    VRD(3); SBAR(); GAPA(C0=__builtin_amdgcn_mfma_f32_32x32x16_bf16(kf[6],qr[3],C0,0,0,0),   P1[10],P1[11],P1[12],P1[13], pw3[0]=PKW(P1,8), pw3[1]=PKW(P1,10), pw3); \
    VRD(7); SBAR(); GAPA(C1=__builtin_amdgcn_mfma_f32_32x32x16_bf16(kf[7],qr[3],C1,0,0,0),   P1[14],P1[15],0.f,0.f,       pw3[2]=PKW(P1,12),pw3[3]=PKW(P1,14), pw3); \
    l_reg+=sacc; \
    if(GK){DMA_K((t)+3,sl_cur);} if(GV){DMA_V((t)+1,sl_next);} \
    CMASK(C0,C1,t); \
    { float a=MX3(C0[0],C0[1],C1[0]),b=MX3(C0[2],C0[3],C1[1]); a=MX3(a,C1[2],C1[3]); \
      _Pragma("unroll") for(int r=4;r<16;r+=4){a=MX3(a,C0[r],C0[r+1]);b=MX3(b,C0[r+2],C0[r+3]);a=MX3(a,C1[r],C1[r+1]);b=MX3(b,C1[r+2],C1[r+3]);} \
      float rm=__builtin_fmaxf(a,b); { auto rr=__builtin_amdgcn_permlane32_swap(__float_as_uint(rm),__float_as_uint(rm),false,false); rm=__builtin_fmaxf(__uint_as_float(rr[0]),__uint_as_float(rr[1])); } \
      resc=false; \
      if(__builtin_expect(__any(rm>(float)THRL),0)){ const float dl=__builtin_fmaxf(rm,0.f); mhat+=dl; \
        _Pragma("unroll") for(int r=0;r<16;++r){C0[r]-=dl;C1[r]-=dl;} \
        _Pragma("unroll") for(int r=0;r<16;++r)negm[r]=-mhat; asm volatile("":"+v"(negm)); \
        const float f=__builtin_amdgcn_exp2f(-dl); l_reg*=f; if(hi==0)wsf[r32]=f; resc=true; } } \
    SBAR(); \
    GAPB(o[0]=__builtin_amdgcn_mfma_f32_32x32x16_bf16(PAF(0),VFR(0),o[0],0,0,0), C0,0); \
    GAPB(o[1]=__builtin_amdgcn_mfma_f32_32x32x16_bf16(PAF(0),VFR(4),o[1],0,0,0), C0,4); \
    KRD(GL,0); GAPB(o[0]=__builtin_amdgcn_mfma_f32_32x32x16_bf16(PAF(1),VFR(1),o[0],0,0,0), C0,8); \
    KRD(GL,1); GAPB(o[1]=__builtin_amdgcn_mfma_f32_32x32x16_bf16(PAF(1),VFR(5),o[1],0,0,0), C0,12); \
    KRD(GL,2); GAPB(o[0]=__builtin_amdgcn_mfma_f32_32x32x16_bf16(PAF(2),VFR(2),o[0],0,0,0), C1,0); \
    KRD(GL,3); GAPB(o[1]=__builtin_amdgcn_mfma_f32_32x32x16_bf16(PAF(2),VFR(6),o[1],0,0,0), C1,4); \
    GAPB(o[0]=__builtin_amdgcn_mfma_f32_32x32x16_bf16(PAF(3),VFR(3),o[0],0,0,0), C1,8); \
    GAPB(o[1]=__builtin_amdgcn_mfma_f32_32x32x16_bf16(PAF(3),VFR(7),o[1],0,0,0), C1,12); \
    }while(0)
  int t=1;
  #undef CMASK
  #define CMASK(P0,P1,t) do{}while(0)
  for(;t+5<NT;t+=2){
    STEP(pB0,pB1,pA0,pA1,t,true,true,true);     WAIT_BAR(2); RESC(); ROT();
    STEP(pA0,pA1,pB0,pB1,t+1,true,true,true);   WAIT_BAR(2); RESC(); ROT();
  }
  #undef CMASK
  #define CMASK(P0,P1,t) do{int jb_=(t)-(NT-4); if(jb_>=0)cmask(P0,P1,jb_,qrel,hi);}while(0)
  #define ENDW(tt) do{ if((tt)+3<NT){WAIT_BAR(2);} else if((tt)+2<NT){WAIT_BAR(1);} else {WAIT_BAR(0);} }while(0)
  for(;t+1<NT;t+=2){
    STEP(pB0,pB1,pA0,pA1,t,(t+3<NT),(t+1<NT),(t+1<NT));       ENDW(t);   RESC(); ROT();
    STEP(pA0,pA1,pB0,pB1,t+1,(t+4<NT),(t+2<NT),(t+2<NT));     ENDW(t+1); RESC(); ROT();
  }
  STEP(pB0,pB1,pA0,pA1,NT-1,false,false,false); RESC();
  { float sacc=pB0[0]+pB0[1]; _Pragma("unroll") for(int r=2;r<16;++r)sacc+=pB0[r]; _Pragma("unroll") for(int r=0;r<16;++r)sacc+=pB1[r]; l_reg+=sacc;
    pw0=(u32x4){PKW(pB0,0),PKW(pB0,2),PKW(pB0,4),PKW(pB0,6)};pw1=(u32x4){PKW(pB0,8),PKW(pB0,10),PKW(pB0,12),PKW(pB0,14)};pw2=(u32x4){PKW(pB1,0),PKW(pB1,2),PKW(pB1,4),PKW(pB1,6)};pw3=(u32x4){PKW(pB1,8),PKW(pB1,10),PKW(pB1,12),PKW(pB1,14)};
    SBAR(); pv(o,vb0+sl_cur,PAF(0),PAF(1),PAF(2),PAF(3)); }
  #undef PKW
  #undef PAF
  #undef VFR
  #undef PIN
  #undef MX3
  #undef GAPA
  #undef GAPB
  #undef EX
  #undef VRD
  #undef KRD
  #undef STEP
  #undef ENDW
  {auto rr=__builtin_amdgcn_permlane32_swap(__float_as_uint(l_reg),__float_as_uint(l_reg),false,false);l_reg=__uint_as_float(rr[0])+__uint_as_float(rr[1]);}
  if(hi==0)wsf[32+r32]=l_reg;asm volatile("s_waitcnt lgkmcnt(0)":::"memory");
  float rli[16];
  #pragma unroll
  for(int r=0;r<16;++r)rli[r]=__builtin_amdgcn_rcpf(wsf[32+crow(r,hi)]);
  bf16*Ow=O+(rowbase+q0+wid*QBLK)*PO;
  { bf16*stg=(bf16*)(shm+LDS_OST)+wid*2048;
    #pragma unroll
    for(int r=0;r<16;++r){const int orow=crow(r,hi);
      #pragma unroll
      for(int d0=0;d0<2;++d0)stg[orow*64+d0*32+r32]=__float2bfloat16(o[d0][r]*rli[r]);}
    asm volatile("s_waitcnt lgkmcnt(0)":::"memory");
    #pragma unroll
    for(int i=0;i<4;++i){const int row=i*8+(lane>>3),ch=lane&7; const u32x4 v=*(const u32x4*)(stg+row*64+ch*8); ATTN_STORE16(Ow+(long)row*PO+ch*8,v);} }
  asm volatile("s_waitcnt lgkmcnt(0)\n\ts_barrier":::"memory");
  #undef DMA_K
  #undef DMA_V
  #undef CMASK
  #undef START
  #undef RESC
  #undef ROT
}
constexpr int ATTN_LDS_BYTES=LDS_BYTES;
#undef SBAR
#undef WAIT_BAR
}
#include <hip/hip_cooperative_groups.h>
namespace cg = cooperative_groups;
namespace mk {
typedef unsigned short bf16_t;
typedef short bf16x8 __attribute__((ext_vector_type(8)));
typedef short s16x4 __attribute__((ext_vector_type(4)));
typedef float f32x4 __attribute__((ext_vector_type(4)));
typedef float f32x16 __attribute__((ext_vector_type(16)));
typedef unsigned u32x4 __attribute__((ext_vector_type(4)));
typedef unsigned u32x2 __attribute__((ext_vector_type(2)));
typedef float f32x2_t __attribute__((ext_vector_type(2))); typedef __bf16 bf16x2_t __attribute__((ext_vector_type(2)));
constexpr int T = 32768, S = 4096;
constexpr size_t TSQ = (size_t)T * 512;
constexpr size_t MiB = 1u << 20;
constexpr size_t WS_SSQ = 0, WS_DML = 4 * MiB, WS_W = 6 * MiB, WS_WL = 18 * MiB + MiB / 2, WS_WM = WS_W + 74 * MiB, WS_PB = 112 * MiB, WS_HB = 128 * MiB, WS_YMIX = 192 * MiB, WS_BIG = 256 * MiB, WS_O16 = WS_BIG + 192 * MiB, WS_END = 512 * MiB;
constexpr int LDS_BYTES = 147456;
constexpr float C2 = 0.125f * 1.4426950408889634f;
struct Params { const float* in[29]; float* out; unsigned char* ws; };

__device__ __forceinline__ unsigned pk2(float lo, float hi) { f32x2_t v = {lo, hi}; bf16x2_t b = __builtin_convertvector(v, bf16x2_t); return __builtin_bit_cast(unsigned, b); }
__device__ __forceinline__ float bflo(unsigned w) { return __uint_as_float(w << 16); }
__device__ __forceinline__ float bfhi(unsigned w) { return __uint_as_float(w & 0xffff0000u); }
__device__ __forceinline__ float bf1(bf16_t h) { return __uint_as_float((unsigned)h << 16); }
__device__ __forceinline__ float wave_sum(float v) {
v = xor_add<1>(v); v = xor_add<2>(v); v = xor_add<4>(v); v = xor_add<8>(v); v = xor_add<16>(v); v = xor_add<32>(v);
    return v;
}
#define WAVE_LDS_SYNC() asm volatile("s_waitcnt lgkmcnt(0)" ::: "memory")
__device__ __forceinline__ int crow(int r, int hi) { return (r & 3) + 8 * (r >> 2) + 4 * hi; }

__device__ __forceinline__ void transpose_items(const float* W, int K, int N, const float* gain, bf16_t* WT, float* scr, int gw, int ngw, int lane) {
    const int nblk = N / 32, nitems = (K / 64) * nblk;
    const int lr = lane >> 3, lc = (lane & 7) * 4;
    f32x4 r[8];
    int it = gw;
    if (it < nitems) { const int k0 = 64 * (it / nblk), n0 = 32 * (it % nblk);
#pragma unroll
        for (int i = 0; i < 8; ++i) r[i] = *(const f32x4*)(W + (size_t)(k0 + lr + 8 * i) * N + n0 + lc); }
    for (; it < nitems; it += ngw) {
        const int kb = it / nblk, nb = it % nblk, k0 = 64 * kb, n0 = 32 * nb;
#pragma unroll
        for (int i = 0; i < 8; ++i) { const int kk = lr + 8 * i; const float g = gain ? gain[k0 + kk] : 1.0f; float* d = scr + kk * 33 + lc;
            d[0] = r[i][0] * g; d[1] = r[i][1] * g; d[2] = r[i][2] * g; d[3] = r[i][3] * g; }
        WAVE_LDS_SYNC();
        const int itn = it + ngw;
        if (itn < nitems) { const int k1 = 64 * (itn / nblk), n1 = 32 * (itn % nblk);
#pragma unroll
            for (int i = 0; i < 8; ++i) r[i] = *(const f32x4*)(W + (size_t)(k1 + lr + 8 * i) * N + n1 + lc); }
        const int c = lane & 7;
#pragma unroll
        for (int j = 0; j < 4; ++j) { const int n = (lane >> 3) + 8 * j; const float* s = scr + (8 * c) * 33 + n;
            u32x4 o; o.x = pk2(s[0 * 33], s[1 * 33]); o.y = pk2(s[2 * 33], s[3 * 33]); o.z = pk2(s[4 * 33], s[5 * 33]); o.w = pk2(s[6 * 33], s[7 * 33]);
            *(u32x4*)(WT + (size_t)(n0 + n) * K + k0 + 8 * c) = o; }
        WAVE_LDS_SYNC();
    }
}
__device__ __forceinline__ void convert_p(const float* psrc, bf16_t* pb, int gtid, int nthr) {
    int i = gtid; f32x4 a = (f32x4){0.f, 0.f, 0.f, 0.f}, b = a;
    if (i < T * 256 / 8) { a = ((const f32x4*)psrc)[2 * i]; b = ((const f32x4*)psrc)[2 * i + 1]; }
    for (; i < T * 256 / 8; i += nthr) { const f32x4 ca = a, cb = b; const int in = i + nthr;
        if (in < T * 256 / 8) { a = ((const f32x4*)psrc)[2 * in]; b = ((const f32x4*)psrc)[2 * in + 1]; }
        u32x4 o; o.x = pk2(ca[0], ca[1]); o.y = pk2(ca[2], ca[3]); o.z = pk2(cb[0], cb[1]); o.w = pk2(cb[2], cb[3]); ((u32x4*)pb)[i] = o; }
}

template <int PASS> __device__ __forceinline__ void dil_unit(int u, int dilv, const bf16_t* proj, float* accst, float* mst, float* lst, bf16_t* ymix, short* vts, int lane) {
    const int r32 = lane & 31, hi = lane >> 5;
    const int LB = 128 / dilv, ql = u & 127, head = (u >> 7) & 7, b = u >> 10, r = ql / LB, qblk = ql % LB;
    const long rowq = (long)b * S + (long)(32 * qblk + r32) * dilv + r;
    const bf16_t* qp = proj + 3 * TSQ + rowq * 512 + head * 64 + 8 * hi;
    bf16x8 qf[4];
#pragma unroll
    for (int d0 = 0; d0 < 4; ++d0) qf[d0] = *(const bf16x8*)(qp + 16 * d0);
    const int j0 = qblk < 4 ? 4 - qblk : 0;
    const float NEG = -1e30f;
    f32x16 st[5]; float mt = NEG;
#pragma unroll
    for (int j = 0; j < 5; ++j) {
        if (j >= j0) {
            const long rowk = (long)b * S + (long)(32 * qblk - 128 + 32 * j + r32) * dilv + r;
            const bf16_t* kp = proj + 4 * TSQ + rowk * 512 + head * 64 + 8 * hi;
            f32x16 a = f32x16{};
#pragma unroll
            for (int d0 = 0; d0 < 4; ++d0) { const bf16x8 kf = *(const bf16x8*)(kp + 16 * d0); a = __builtin_amdgcn_mfma_f32_32x32x16_bf16(kf, qf[d0], a, 0, 0, 0); }
            if (j == 0) {
#pragma unroll
                for (int i = 0; i < 16; ++i) if (crow(i, hi) < r32) a[i] = NEG; }
            if (j == 4) {
#pragma unroll
                for (int i = 0; i < 16; ++i) if (crow(i, hi) > r32) a[i] = NEG; }
#pragma unroll
            for (int i = 0; i < 16; ++i) mt = fmaxf(mt, a[i]);
            st[j] = a;
        } else st[j] = f32x16{};
    }
    mt = xor_max<32>(mt);
    const size_t sidx = (size_t)rowq * 8 + head;
    float m_old = NEG, l_old = 0.f;
    if (PASS > 0) { m_old = mst[sidx]; l_old = lst[sidx]; }
    const float m_new = fmaxf(m_old, mt), sc = __builtin_amdgcn_exp2f(m_old - m_new);
    float ls = 0.f;
#pragma unroll
    for (int j = 0; j < 5; ++j) if (j >= j0) {
#pragma unroll
        for (int i = 0; i < 16; ++i) { const float e = __builtin_amdgcn_exp2f(st[j][i] - m_new); st[j][i] = e; ls += e; } }
    ls = xor_add<32>(ls);
    const float l_new = l_old * sc + ls;
    f32x16 O[2]; float* ap = accst + sidx * 64 + 4 * hi;
    if (PASS > 0) {
#pragma unroll
        for (int dt = 0; dt < 2; ++dt)
#pragma unroll
            for (int i4 = 0; i4 < 4; ++i4) { const f32x4 v = *(const f32x4*)(ap + 32 * dt + 8 * i4);
#pragma unroll
                for (int e = 0; e < 4; ++e) O[dt][4 * i4 + e] = v[e] * sc; }
    } else { O[0] = f32x16{}; O[1] = f32x16{}; }
#pragma unroll
    for (int j = 0; j < 5; ++j) if (j >= j0) {
        const long rowk = (long)b * S + (long)(32 * qblk - 128 + 32 * j + r32) * dilv + r;
        const bf16_t* vp = proj + 5 * TSQ + rowk * 512 + head * 64 + 8 * hi;
#pragma unroll
        for (int d0 = 0; d0 < 4; ++d0) { const bf16x8 vv = *(const bf16x8*)(vp + 16 * d0);
#pragma unroll
            for (int e = 0; e < 8; ++e) vts[(16 * d0 + 8 * hi + e) * 36 + r32] = vv[e]; }
        WAVE_LDS_SYNC();
#pragma unroll
        for (int cc = 0; cc < 2; ++cc) {
            u32x4 pw; pw.x = pk2(st[j][8 * cc + 0], st[j][8 * cc + 1]); pw.y = pk2(st[j][8 * cc + 2], st[j][8 * cc + 3]); pw.z = pk2(st[j][8 * cc + 4], st[j][8 * cc + 5]); pw.w = pk2(st[j][8 * cc + 6], st[j][8 * cc + 7]);
            const bf16x8 pf = __builtin_bit_cast(bf16x8, pw);
#pragma unroll
            for (int dt = 0; dt < 2; ++dt) { const short* vr = vts + (r32 + 32 * dt) * 36 + 16 * cc + 4 * hi;
                const s16x4 lo = *(const s16x4*)vr, h4 = *(const s16x4*)(vr + 8);
                const bf16x8 vf = (bf16x8){lo[0], lo[1], lo[2], lo[3], h4[0], h4[1], h4[2], h4[3]};
                O[dt] = __builtin_amdgcn_mfma_f32_32x32x16_bf16(vf, pf, O[dt], 0, 0, 0); }
        }
        WAVE_LDS_SYNC();
    }
    if (PASS < 2) {
#pragma unroll
        for (int dt = 0; dt < 2; ++dt)
#pragma unroll
            for (int i4 = 0; i4 < 4; ++i4) *(f32x4*)(ap + 32 * dt + 8 * i4) = (f32x4){O[dt][4 * i4], O[dt][4 * i4 + 1], O[dt][4 * i4 + 2], O[dt][4 * i4 + 3]};
        if (hi == 0) { mst[sidx] = m_new; lst[sidx] = l_new; }
    } else {
        const float inv = 1.0f / l_new; bf16_t* yp = ymix + (size_t)rowq * 1024 + 512 + head * 64 + 4 * hi;
#pragma unroll
        for (int dt = 0; dt < 2; ++dt)
#pragma unroll
            for (int i4 = 0; i4 < 4; ++i4) { u32x2 w; w.x = pk2(O[dt][4 * i4] * inv, O[dt][4 * i4 + 1] * inv); w.y = pk2(O[dt][4 * i4 + 2] * inv, O[dt][4 * i4 + 3] * inv); *(u32x2*)(yp + 32 * dt + 8 * i4) = w; }
    }
}
template <int PASS> __device__ __forceinline__ void dil_pass(int dilv, const bf16_t* proj, float* accst, float* mst, float* lst, bf16_t* ymix, unsigned char* lds, int wid, int lane, int gw, int ngw) {
    short* vts = (short*)(lds + wid * 4608);
    for (int u = gw; u < 8192; u += ngw) dil_unit<PASS>(u, dilv, proj, accst, mst, lst, ymix, vts, lane);
}

__device__ __forceinline__ void s5_coef(float lr, float li, float dt, float& ar, float& ai, float& cr, float& ci) {
    const float mag = expf(lr * dt); const float th = li * dt; const float kq = rintf(th * 0.15915494309189535f);
    float rr = fmaf(-kq, 6.2831854820251465f, th); rr = fmaf(-kq, -1.7484556000744883e-07f, rr);
    const float sn = __sinf(rr), cs = __cosf(rr); ar = mag * cs; ai = mag * sn;
    const float den = lr * lr + li * li, nr = ar - 1.f, ni = ai; cr = (nr * lr + ni * li) / den; ci = (ni * lr - nr * li) / den;
}
__device__ __forceinline__ float gelu_tanh(float x) { const float z = 1.5957691216057308f * (x + 0.044715f * x * x * x); return x * __builtin_amdgcn_rcpf(1.0f + __expf(-z)); }

}
#ifndef RP_ATTN
#define RP_ATTN 1
#define RP_DIL 1
#define RP_S5 1
#define RP_BAR 1
#define RP_UP 1
#define RP_PRO 1
#define RP_INP 1
#define RP_PP 1
#define RP_ELT 1
#define RP_OUT 1
#define RP_DOWN 1
#define RP_PLE 1
#define RP_GLU 1
#endif
namespace mk {
#define GAS __attribute__((address_space(1)))
struct DParams { GAS const float* in[29]; GAS float* out; GAS unsigned char* ws; };
typedef const __attribute__((address_space(4))) DParams* KArgs;
__device__ __forceinline__ void s5_phase(KArgs p, int o, const bf16_t* proj, bf16_t* yg, unsigned char* lds, int tid, int lane, int wid, int G, int bid) {
    constexpr int TC = 64, NCH = S / TC, BUP = 132, XP = 136;
    float* Bu = (float*)lds;
    bf16_t* Xs = (bf16_t*)(lds + 2 * TC * BUP * 4);
    const int r32 = lane & 31, hi = lane >> 5, l16 = lane & 15, kq = lane >> 4;
    for (int bg = bid; bg < 256; bg += G) {
        const int b = bg >> 5, g = bg & 31, og = o * 32 + g;
        const float* lam_re = (const float*)p->in[18] + og * 64; const float* lam_im = (const float*)p->in[19] + og * 64; const float dt = expf(p->in[20][og]);
        const float* b_re = (const float*)p->in[21] + (size_t)og * 1024; const float* b_im = (const float*)p->in[22] + (size_t)og * 1024;
        const float* c_re = (const float*)p->in[23] + (size_t)og * 1024; const float* c_im = (const float*)p->in[24] + (size_t)og * 1024; const float* dsk = (const float*)p->in[25] + og * 16;
        const bf16_t* ub = proj + (size_t)b * S * 2048 + g * 16;
        float ar = 0.f, ai = 0.f, xr = 0.f, xi = 0.f;
        bf16x8 Bf[4], Cf[4]; float dsc = 0.f;
        if (wid == 0) { float cr, ci; s5_coef(lam_re[lane], lam_im[lane], dt, ar, ai, cr, ci); }
        else {
#pragma unroll
            for (int nt = 0; nt < 4; ++nt) { const int pp = 16 * nt + (r32 >> 1); float a0, a1, cr, ci; s5_coef(lam_re[pp], lam_im[pp], dt, a0, a1, cr, ci);
                const f32x4 br0 = *(const f32x4*)(b_re + pp * 16 + 8 * hi), br1 = *(const f32x4*)(b_re + pp * 16 + 8 * hi + 4);
                const f32x4 bi0 = *(const f32x4*)(b_im + pp * 16 + 8 * hi), bi1 = *(const f32x4*)(b_im + pp * 16 + 8 * hi + 4);
                f32x4 v0, v1; if (r32 & 1) { v0 = cr * bi0 + ci * br0; v1 = cr * bi1 + ci * br1; } else { v0 = cr * br0 - ci * bi0; v1 = cr * br1 - ci * bi1; }
                u32x4 w; w.x = pk2(v0[0], v0[1]); w.y = pk2(v0[2], v0[3]); w.z = pk2(v1[0], v1[1]); w.w = pk2(v1[2], v1[3]); Bf[nt] = __builtin_bit_cast(bf16x8, w); }
#pragma unroll
            for (int ks = 0; ks < 4; ++ks) { const int p0 = 16 * ks + 4 * kq; const f32x4 cr4 = *(const f32x4*)(c_re + l16 * 64 + p0), ci4 = *(const f32x4*)(c_im + l16 * 64 + p0);
                u32x4 w; w.x = pk2(cr4[0], -ci4[0]); w.y = pk2(cr4[1], -ci4[1]); w.z = pk2(cr4[2], -ci4[2]); w.w = pk2(cr4[3], -ci4[3]); Cf[ks] = __builtin_bit_cast(bf16x8, w); }
            dsc = dsk[l16];
        }
#define S5_LDU(k, tt) (*(const bf16x8*)(ub + (size_t)(((k) < NCH ? (k) : NCH - 1) * TC + 32 * (tt) + r32) * 2048 + 8 * hi))
#define S5_BU(k) do { float* Bb = Bu + ((k) & 1) * TC * BUP; \
        { const int tile = wid - 1, tt = tile >> 2, nt = tile & 3; \
            const f32x16 a = __builtin_amdgcn_mfma_f32_32x32x16_bf16(ufa, nt == 0 ? Bf[0] : nt == 1 ? Bf[1] : nt == 2 ? Bf[2] : Bf[3], f32x16{}, 0, 0, 0); \
            _Pragma("unroll") for (int i = 0; i < 16; ++i) Bb[(32 * tt + crow(i, hi)) * BUP + 32 * nt + r32] = a[i]; } \
        if (wid == 1) { const f32x16 a = __builtin_amdgcn_mfma_f32_32x32x16_bf16(ufb, Bf[3], f32x16{}, 0, 0, 0); \
            _Pragma("unroll") for (int i = 0; i < 16; ++i) Bb[(32 + crow(i, hi)) * BUP + 96 + r32] = a[i]; } \
        ufa = S5_LDU((k) + 1, (wid - 1) >> 2); if (wid == 1) ufb = S5_LDU((k) + 1, 1); } while (0)
#define S5_LDUU(k) do { if (wid <= 4) { _Pragma("unroll") for (int j = 0; j < 4; ++j) uun[j] = proj[((size_t)b * S + ((k) < NCH ? (k) : NCH - 1) * TC + 16 * (wid - 1) + 4 * kq + j) * 2048 + g * 16 + l16]; } } while (0)
#define S5_CP(k) do { const bf16_t* Xb = Xs + ((k) & 1) * TC * XP; \
        if (wid <= 4) { const int tile = wid - 1; f32x4 a = (f32x4){0.f, 0.f, 0.f, 0.f}; \
            _Pragma("unroll") for (int ks = 0; ks < 4; ++ks) { const bf16x8 xf = *(const bf16x8*)(Xb + (16 * tile + l16) * XP + 32 * ks + 8 * kq); \
                a = __builtin_amdgcn_mfma_f32_16x16x32_bf16(xf, Cf[ks], a, 0, 0, 0); } \
            _Pragma("unroll") for (int j = 0; j < 4; ++j) { const size_t tok = (size_t)b * S + (k) * TC + 16 * tile + 4 * kq + j; \
                const float y = gelu_tanh(a[j] + dsc * bf1(uun[j])); \
                yg[tok * 512 + g * 16 + l16] = (bf16_t)(pk2(y, 0.f) & 0xffffu); } } \
        S5_LDUU((k) + 1); } while (0)
        bf16x8 ufa = bf16x8{}, ufb = bf16x8{}; bf16_t uun[4] = {0, 0, 0, 0};
        if (wid > 0) { ufa = S5_LDU(0, (wid - 1) >> 2); if (wid == 1) ufb = S5_LDU(0, 1); S5_LDUU(0); S5_BU(0); }
        __syncthreads();
        for (int k = 0; k < NCH; ++k) {
            if (wid == 0) {
                const float* Bb = Bu + (k & 1) * TC * BUP; bf16_t* Xb = Xs + (k & 1) * TC * XP;
                for (int t0 = 0; t0 < TC; t0 += 16) { f32x2_t bv[16];
#pragma unroll
                    for (int j = 0; j < 16; ++j) bv[j] = *(const f32x2_t*)(Bb + (t0 + j) * BUP + 2 * lane);
#pragma unroll
                    for (int j = 0; j < 16; ++j) { const float nr = fmaf(ar, xr, fmaf(-ai, xi, bv[j].x)), ni = fmaf(ar, xi, fmaf(ai, xr, bv[j].y)); xr = nr; xi = ni;
                        *(unsigned*)(Xb + (t0 + j) * XP + 2 * lane) = pk2(xr, xi); } }
            } else {
                if (k + 1 < NCH) S5_BU(k + 1);
                if (k >= 1) S5_CP(k - 1);
            }
            __syncthreads();
        }
        if (wid > 0) S5_CP(NCH - 1);
        __syncthreads();
#undef S5_BU
#undef S5_LDU
#undef S5_LDUU
#undef S5_CP
    }
}
__device__ __forceinline__ void conv_phase(const float* cw, const bf16_t* proj, bf16_t* ymix, int gtid, int nthr) {
    for (int idx = gtid; idx < T * 64; idx += nthr) { const int t = idx >> 6, c8 = (idx & 63) * 8, s = t & (S - 1);
        const bf16_t* row = proj + (size_t)t * 2048;
        float y[8];
#pragma unroll
        for (int e = 0; e < 8; ++e) y[e] = 0.f;
#pragma unroll
        for (int j = 0; j < 3; ++j) if (s - j >= 0) { const u32x4 gc = *(const u32x4*)(row - (size_t)j * 2048 + 1024 + c8), xt = *(const u32x4*)(row - (size_t)j * 2048 + 1536 + c8);
            const f32x4 w0 = *(const f32x4*)(cw + j * 512 + c8), w1 = *(const f32x4*)(cw + j * 512 + c8 + 4);
            y[0] += w0[0] * bflo(gc.x) * bflo(xt.x); y[1] += w0[1] * bfhi(gc.x) * bfhi(xt.x); y[2] += w0[2] * bflo(gc.y) * bflo(xt.y); y[3] += w0[3] * bfhi(gc.y) * bfhi(xt.y);
            y[4] += w1[0] * bflo(gc.z) * bflo(xt.z); y[5] += w1[1] * bfhi(gc.z) * bfhi(xt.z); y[6] += w1[2] * bflo(gc.w) * bflo(xt.w); y[7] += w1[3] * bfhi(gc.w) * bfhi(xt.w); }
        const u32x4 gb = *(const u32x4*)(row + 512 + c8); u32x4 o;
        o.x = pk2(y[0] * bflo(gb.x), y[1] * bfhi(gb.x)); o.y = pk2(y[2] * bflo(gb.y), y[3] * bfhi(gb.y)); o.z = pk2(y[4] * bflo(gb.z), y[5] * bfhi(gb.z)); o.w = pk2(y[6] * bflo(gb.w), y[7] * bfhi(gb.w));
        *(u32x4*)(ymix + (size_t)t * 1024 + 512 + c8) = o; }
}
__device__ __forceinline__ void diff_post(KArgs p, int e, float lam_init, const bf16_t* O16, bf16_t* ymix, int lane, int gtid, int nthr) {
    float a = p->in[11][e * 64 + lane] * p->in[12][e * 64 + lane], bb = p->in[13][e * 64 + lane] * p->in[14][e * 64 + lane];
    a = wave_sum(a); bb = wave_sum(bb);
    const float lam = expf(a) - expf(bb) + lam_init; const float* gain = (const float*)p->in[15] + e * 128;
    const int j = gtid & 15, vhalf = j >> 3, dd = (j & 7) * 8;
    const f32x4 g0 = *(const f32x4*)(gain + 8 * j), g1 = *(const f32x4*)(gain + 8 * j + 4);
    for (int grp = gtid >> 4; grp < T * 4; grp += nthr >> 4) { const int t = grp >> 2, h = grp & 3;
        const u32x4 o1 = *(const u32x4*)(O16 + (size_t)t * 1024 + ((h * 2 + 0) * 2 + vhalf) * 64 + dd), o2 = *(const u32x4*)(O16 + (size_t)t * 1024 + ((h * 2 + 1) * 2 + vhalf) * 64 + dd);
        float v[8];
        v[0] = bflo(o1.x) - lam * bflo(o2.x); v[1] = bfhi(o1.x) - lam * bfhi(o2.x); v[2] = bflo(o1.y) - lam * bflo(o2.y); v[3] = bfhi(o1.y) - lam * bfhi(o2.y);
        v[4] = bflo(o1.z) - lam * bflo(o2.z); v[5] = bfhi(o1.z) - lam * bfhi(o2.z); v[6] = bflo(o1.w) - lam * bflo(o2.w); v[7] = bfhi(o1.w) - lam * bfhi(o2.w);
        float ss = 0.f;
#pragma unroll
        for (int q = 0; q < 8; ++q) ss += v[q] * v[q];
        ss = xor_add<1>(ss); ss = xor_add<2>(ss); ss = xor_add<4>(ss); ss = xor_add<8>(ss);
        const float rs = rsqrtf(ss * (1.0f / 128.0f) + 1e-5f) * (1.0f - lam_init);
        u32x4 o; o.x = pk2(v[0] * rs * g0[0], v[1] * rs * g0[1]); o.y = pk2(v[2] * rs * g0[2], v[3] * rs * g0[3]); o.z = pk2(v[4] * rs * g1[0], v[5] * rs * g1[1]); o.w = pk2(v[6] * rs * g1[2], v[7] * rs * g1[3]);
        *(u32x4*)(ymix + (size_t)t * 1024 + h * 128 + 8 * j) = o; }
}

__device__ __forceinline__ KArgs kargs() { KArgs k = (KArgs)__builtin_amdgcn_kernarg_segment_ptr(); asm volatile("" : "+s"(k)); return k; }
constexpr size_t WS_BAR = WS_WM + 8 * MiB + 6 * MiB + MiB / 2;
constexpr int LDS_XB = 131072 + 1024;
#define LAS __attribute__((address_space(3)))
#define XB_TMO      128
#define XB_XCNT(j)  (256  + 64 * (j))
#define XB_XSUB(j)  (1280 + 64 * (j))
#define XB_XGEN(j)  (2304 + 64 * (j))
#define XB_TOP      3328
#define XB_TOPGEN   3392
#define XCD_BAR_WORDS 3456
#define XB_SPIN_CAP (1u << 18)

__device__ __forceinline__ unsigned xb_ld(unsigned* p)              { return __hip_atomic_load(p, __ATOMIC_RELAXED, __HIP_MEMORY_SCOPE_AGENT); }
__device__ __forceinline__ unsigned xb_add(unsigned* p, unsigned v) { return __hip_atomic_fetch_add(p, v, __ATOMIC_RELAXED, __HIP_MEMORY_SCOPE_AGENT); }
__device__ __forceinline__ unsigned xb_xcc_id() { return (unsigned)__builtin_amdgcn_s_getreg((3 << 11) | 20) & 0xFu; }
#define XB_SPIN(cond, bar) do { unsigned _sp = 0; while (cond) { __builtin_amdgcn_s_sleep(1); \
    if ((++_sp & 255u) == 0u) { if (xb_ld(&(bar)[XB_TMO])) break; if (_sp > XB_SPIN_CAP) { atomicAdd(&(bar)[XB_TMO], 1u); break; } } } } while (0)

struct XcdBarrier {
    unsigned* bar; unsigned x;
    volatile LAS unsigned* st;
};

__device__ __forceinline__ XcdBarrier xcd_barrier_post(unsigned* bar, volatile LAS unsigned* st) {
    XcdBarrier b; b.bar = bar; b.x = xb_xcc_id(); b.st = st;
    if (threadIdx.x == 0) (void)xb_add(&bar[XB_XCNT(b.x)], 1u);
    return b;
}
__device__ __forceinline__ void xcd_barrier_complete(unsigned* bar, unsigned x, unsigned& nloc, unsigned& nx) {
    const unsigned G = gridDim.x * gridDim.y * gridDim.z;
    unsigned sum, cnt, mine, sp = 0u;
    for (;;) {
        sum = 0u; cnt = 0u; mine = 0u;
#pragma unroll
        for (unsigned j = 0; j < 16; ++j) { const unsigned c = xb_ld(&bar[XB_XCNT(j)]); sum += c; cnt += (c > 0u) ? 1u : 0u; mine = (j == x) ? c : mine; }
        if (sum == G) break;
        __builtin_amdgcn_s_sleep(1);
        if ((++sp & 255u) == 0u) { if (xb_ld(&bar[XB_TMO])) break; if (sp > XB_SPIN_CAP) { atomicAdd(&bar[XB_TMO], 1u); break; } }
    }
    nloc = mine > 0u ? mine : 1u; nx = cnt > 0u ? cnt : 1u;
}

__device__ __forceinline__ void xcd_barrier(const XcdBarrier& b) {
    asm volatile("s_waitcnt vmcnt(0)" ::: "memory");
    __syncthreads();
    if (threadIdx.x == 0) {
        unsigned* bar = b.bar;
        __builtin_amdgcn_s_waitcnt(0);
        unsigned nloc = b.st[0], nx = b.st[1];
        if (nloc == 0u) { xcd_barrier_complete(bar, b.x, nloc, nx); b.st[0] = nloc; b.st[1] = nx; }
        const unsigned old = xb_add(&bar[XB_XSUB(b.x)], 1u);
        const unsigned gen = old / nloc;
        if (old + 1u == (gen + 1u) * nloc) {
            __builtin_amdgcn_fence(__ATOMIC_RELEASE, "agent");
            asm volatile("s_waitcnt vmcnt(0)" ::: "memory");
            const unsigned og = xb_add(&bar[XB_TOP], 1u);
            const unsigned tg = og / nx;
            if (og + 1u == (tg + 1u) * nx) xb_add(&bar[XB_TOPGEN], 1u);
            else XB_SPIN(xb_ld(&bar[XB_TOPGEN]) == tg, bar);
            __builtin_amdgcn_fence(__ATOMIC_ACQUIRE, "agent");
            xb_add(&bar[XB_XGEN(b.x)], 1u);
            asm volatile("s_waitcnt vmcnt(0)" ::: "memory");
        } else {
            XB_SPIN(xb_ld(&bar[XB_XGEN(b.x)]) == gen, bar);
            __builtin_amdgcn_fence(__ATOMIC_ACQUIRE, "agent");
            asm volatile("s_waitcnt vmcnt(0)" ::: "memory");
        }
    }
    __syncthreads();
}

__device__ __forceinline__ void grid_bar1(unsigned) {
    XcdBarrier xbv; xbv.bar = (unsigned*)((unsigned char*)kargs()->ws + WS_BAR); xbv.x = xb_xcc_id(); xbv.st = (volatile LAS unsigned*)(LDS_XB);
    xcd_barrier(xbv);
}
__device__ __forceinline__ void grid_bar(unsigned epoch) { for (int rp = 0; rp < RP_BAR; ++rp) grid_bar1(epoch); }
#define PH_BEGIN KArgs ka = kargs(); unsigned char* ws = (unsigned char*)ka->ws; int tid = threadIdx.x; asm volatile("" : "+v"(tid)); int bid = blockIdx.x; asm volatile("" : "+s"(bid)); const int lane = tid & 63, wid = __builtin_amdgcn_readfirstlane(tid >> 6), G = gridDim.x; \
    const int gw = bid * 8 + wid, ngw = G * 8, gtid = bid * 512 + tid, nthr = G * 512; (void)lane; (void)gw; (void)ngw; (void)gtid; (void)nthr; (void)ws;
#define WL(i) (ws + WS_W + (size_t)(i) * WS_WL)
#define WM(i) (ws + WS_WM + (size_t)(i) * 8 * MiB)
#define SBUF(j) ((bf16_t*)ka->out + (size_t)((j) & 1) * T * 1024)
#define SSQ(k) ((float*)(ws + WS_SSQ + (size_t)((k) & 1) * 2 * MiB))
template <int i> __device__ __forceinline__ void layer_body(unsigned char* lds, PG8_LAS unsigned char* ldsp) {
    unsigned ep = (i == 0 ? 0u : i == 1 ? 8u : i == 2 ? 15u : 23u);
        for (int rp = 0; rp < RP_INP; ++rp) { PH_BEGIN const bool odd = (i & 1) != 0; const int N = odd ? 2048 : 3072;
            pg8::Gemm g{SBUF(i), (const bf16_t*)WM(i), T, N, 1024};     pg8::StaticOrder SO; SO.init(T, N, G, bid);
            pg8::EpiRow<0> E{(bf16_t*)(ws + WS_BIG), odd ? 2048 : 512, SSQ(3 * i), odd ? 0u : 0xC3u, C2, odd ? 0 : 512, TSQ};
            pg8::gemm_phase<pg8::EpiRow<0>, pg8::StaticOrder, true, true>(ldsp, g, SO, E); }
        grid_bar(++ep);
        if ((i & 1) == 0) {
            { PH_BEGIN const int vcu0 = (G % 8 == 0) ? (bid % 8) * (G / 8) + (bid / 8) : bid;
                for (int rp = 0; rp < RP_ATTN; ++rp) for (int vcu = vcu0; vcu < 256; vcu += G) { const int pair = vcu >> 1, s = vcu & 1, b = pair >> 4, vh = pair & 15, h = vh >> 2, c = (vh >> 1) & 1, vhalf = vh & 1;
                    for (int it = 0; it < 8; ++it) { const int j = s + 2 * (it >> 1), qb = (it & 1) ? 15 - j : j;
                        const attn_body::bf16* P = (const attn_body::bf16*)((unsigned char*)kargs()->ws + WS_BIG);
                        attn_body::attn_unit<8>(b, 0, qb, P + h * 128 + c * 64, P + TSQ + h * 128 + c * 64, P + 2 * TSQ + h * 128 + vhalf * 64, (attn_body::bf16*)((unsigned char*)kargs()->ws + WS_O16) + vh * 64, (char*)lds); } } }
            __syncthreads();
            { PH_BEGIN float* dm = (float*)(ws + WS_DML);
                for (int rp = 0; rp < RP_DIL; ++rp) dil_pass<0>(1, (const bf16_t*)(ws + WS_BIG), (float*)(ws + WS_HB), dm, dm + (size_t)T * 8, (bf16_t*)(ws + WS_YMIX), lds, wid, lane, gw, ngw);
                convert_p((const float*)ka->in[1] + (size_t)i * T * 256, (bf16_t*)(ws + WS_PB), gtid, nthr); }
            grid_bar(++ep);
            { PH_BEGIN float* dm = (float*)(ws + WS_DML);
                dil_pass<1>(4, (const bf16_t*)(ws + WS_BIG), (float*)(ws + WS_HB), dm, dm + (size_t)T * 8, (bf16_t*)(ws + WS_YMIX), lds, wid, lane, gw, ngw); }
            grid_bar(++ep);
            { PH_BEGIN float* dm = (float*)(ws + WS_DML);
                dil_pass<2>(16, (const bf16_t*)(ws + WS_BIG), (float*)(ws + WS_HB), dm, dm + (size_t)T * 8, (bf16_t*)(ws + WS_YMIX), lds, wid, lane, gw, ngw); }
            { PH_BEGIN const float lam_init = 0.8f - 0.6f * expf(-0.3f * (float)i);
                for (int rp = 0; rp < RP_ELT; ++rp) diff_post(ka, i >> 1, lam_init, (const bf16_t*)(ws + WS_O16), (bf16_t*)(ws + WS_YMIX), lane, gtid, nthr); }
            grid_bar(++ep);
        } else {
            for (int rp = 0; rp < RP_S5; ++rp) { PH_BEGIN s5_phase(ka, i >> 1, (const bf16_t*)(ws + WS_BIG), (bf16_t*)(ws + WS_HB), lds, tid, lane, wid, G, bid); }
            for (int rp = 0; rp < RP_ELT; ++rp) { PH_BEGIN conv_phase((const float*)ka->in[27] + (i >> 1) * 3 * 512, (const bf16_t*)(ws + WS_BIG), (bf16_t*)(ws + WS_YMIX), gtid, nthr);
                convert_p((const float*)ka->in[1] + (size_t)i * T * 256, (bf16_t*)(ws + WS_PB), gtid, nthr); }
            grid_bar(++ep);
            for (int rp = 0; rp < RP_GLU; ++rp) { PH_BEGIN pg8::Gemm g{(const bf16_t*)(ws + WS_HB), (const bf16_t*)(WM(i) + 6 * MiB), T, 512, 512}; pg8::StaticOrder SO; SO.init(T, 512, G, bid);
                pg8::EpiGlu E{(bf16_t*)(ws + WS_YMIX), (const bf16_t*)(ws + WS_HB)};
                pg8::gemm_phase<pg8::EpiGlu, pg8::StaticOrder, true, true>(ldsp, g, SO, E); }
            grid_bar(++ep);
        }
        for (int rp = 0; rp < RP_OUT; ++rp) { PH_BEGIN const bool odd = (i & 1) != 0;
            pg8::Gemm g{(const bf16_t*)(ws + WS_YMIX), (const bf16_t*)(WM(i) + (odd ? 4 : 6) * MiB), T, 1024, 1024}; pg8::StaticOrder SO; SO.init(T, 1024, G, bid);
            pg8::EpiRes<0> E{SBUF(i), (rp < RP_OUT - 1) ? (bf16_t*)(ws + WS_HB) : SBUF(i), SSQ(3 * i + 1), nullptr, nullptr};
            pg8::gemm_phase<pg8::EpiRes<0>, pg8::StaticOrder, true, true>(ldsp, g, SO, E); }
        grid_bar(++ep);
        for (int rp = 0; rp < RP_UP; ++rp) { PH_BEGIN pg8::Gemm g{SBUF(i), (const bf16_t*)WL(i), T, 4096, 1024}; pg8::StaticOrder SO; SO.init(T, 4096, G, bid);
            pg8::EpiRow<1> E{(bf16_t*)(ws + WS_BIG), 4096, SSQ(3 * i + 1), 0u, 1.f, 0, 0};
            pg8::gemm_phase<pg8::EpiRow<1>, pg8::StaticOrder, true, true>(ldsp, g, SO, E); }
        for (int rp = 0; rp < RP_PP; ++rp) { PH_BEGIN pg8::Gemm g{(const bf16_t*)(ws + WS_PB), (const bf16_t*)(WL(i) + 18 * MiB), T, 1024, 256}; pg8::StaticOrder SO; SO.init(T, 1024, G, bid);
            pg8::EpiPP E{(bf16_t*)(ws + WS_YMIX)};
            pg8::gemm_phase<pg8::EpiPP, pg8::StaticOrder, true, true>(ldsp, g, SO, E); }
        grid_bar(++ep);
        for (int rp = 0; rp < RP_DOWN; ++rp) { PH_BEGIN pg8::Gemm g{(const bf16_t*)(ws + WS_BIG), (const bf16_t*)(WL(i) + 8 * MiB), T, 1024, 4096}; pg8::StaticOrder SO; SO.init(T, 1024, G, bid);
            pg8::EpiRes<0> E{SBUF(i), (rp < RP_DOWN - 1) ? (bf16_t*)(ws + WS_HB) : SBUF(i), SSQ(3 * i + 2), nullptr, nullptr};
            pg8::gemm_phase<pg8::EpiRes<0>, pg8::StaticOrder, true, true>(ldsp, g, SO, E); }
        grid_bar(++ep);
        for (int rp = 0; rp < RP_PLE; ++rp) { PH_BEGIN pg8::Gemm g{SBUF(i), (const bf16_t*)(WL(i) + 16 * MiB), T, 1024, 1024}; pg8::StaticOrder SO; SO.init(T, 1024, G, bid);
            pg8::EpiRes<1> E{SBUF(i), (rp < RP_PLE - 1) ? (bf16_t*)(ws + WS_BIG) : (i == 3) ? (bf16_t*)(ws + WS_HB) : SBUF(i + 1), SSQ(3 * i + 3), SSQ(3 * i + 2), (const bf16_t*)(ws + WS_YMIX)};
            pg8::gemm_phase<pg8::EpiRes<1>, pg8::StaticOrder, true, true>(ldsp, g, SO, E); }
        grid_bar(++ep);
}
__global__ void __launch_bounds__(512, 2) fwd(Params p_unused) {
    extern __shared__ __attribute__((aligned(16))) unsigned char lds[];
    PG8_LAS unsigned char* ldsp = (PG8_LAS unsigned char*)lds;
    for (int rp = 0; rp < RP_PRO; ++rp) {
    { PH_BEGIN
        float* ssq = SSQ(0); bf16_t* hb = SBUF(0); const float* x = (const float*)ka->in[0];
        { f32x4 vn[4]; int m = gw;
            if (m < T) { const f32x4* xr = (const f32x4*)(x + (size_t)m * 1024) + lane;
#pragma unroll
                for (int j = 0; j < 4; ++j) vn[j] = xr[64 * j]; }
            for (; m < T; m += ngw) { f32x4 v[4]; float s = 0.f;
#pragma unroll
                for (int j = 0; j < 4; ++j) v[j] = vn[j];
                if (m + ngw < T) { const f32x4* xn = (const f32x4*)(x + (size_t)(m + ngw) * 1024) + lane;
#pragma unroll
                    for (int j = 0; j < 4; ++j) vn[j] = xn[64 * j]; }
#pragma unroll
                for (int j = 0; j < 4; ++j) s += (v[j][0] * v[j][0] + v[j][1] * v[j][1]) + (v[j][2] * v[j][2] + v[j][3] * v[j][3]);
                s = wave_sum(s); if (lane < 16) ssq[(size_t)m * 16 + lane] = (lane == 0) ? s : 0.f;
                u32x2* o8 = (u32x2*)(hb + (size_t)m * 1024) + lane;
#pragma unroll
                for (int j = 0; j < 4; ++j) { u32x2 w; w.x = pk2(v[j][0], v[j][1]); w.y = pk2(v[j][2], v[j][3]); o8[64 * j] = w; } } } }
    for (int i = 0; i < 4; ++i) { PH_BEGIN
        float* scr = (float*)(lds + wid * 8448); unsigned char* wl = WL(i); unsigned char* wm = WM(i); const int e = i >> 1;
        transpose_items((const float*)ka->in[5] + (size_t)i * 1024 * 4096, 1024, 4096, (const float*)ka->in[3] + i * 1024, (bf16_t*)wl, scr, gw, ngw, lane);
        transpose_items((const float*)ka->in[6] + (size_t)i * 1024 * 4096, 4096, 1024, nullptr, (bf16_t*)(wl + 8 * MiB), scr, gw, ngw, lane);
        transpose_items((const float*)ka->in[8] + (size_t)i * 1024 * 1024, 1024, 1024, (const float*)ka->in[4] + i * 1024, (bf16_t*)(wl + 16 * MiB), scr, gw, ngw, lane);
        transpose_items((const float*)ka->in[7] + (size_t)i * 256 * 1024, 256, 1024, nullptr, (bf16_t*)(wl + 18 * MiB), scr, gw, ngw, lane);
        if ((i & 1) == 0) {
            transpose_items((const float*)ka->in[9] + (size_t)e * 1024 * 3072, 1024, 3072, (const float*)ka->in[2] + i * 1024, (bf16_t*)wm, scr, gw, ngw, lane);
            transpose_items((const float*)ka->in[10] + (size_t)e * 1024 * 1024, 1024, 1024, nullptr, (bf16_t*)(wm + 6 * MiB), scr, gw, ngw, lane);
        } else {
            transpose_items((const float*)ka->in[16] + (size_t)e * 1024 * 2048, 1024, 2048, (const float*)ka->in[2] + i * 1024, (bf16_t*)wm, scr, gw, ngw, lane);
            transpose_items((const float*)ka->in[17] + (size_t)e * 1024 * 1024, 1024, 1024, nullptr, (bf16_t*)(wm + 4 * MiB), scr, gw, ngw, lane);
            transpose_items((const float*)ka->in[26] + (size_t)e * 512 * 512, 512, 512, nullptr, (bf16_t*)(wm + 6 * MiB), scr, gw, ngw, lane);
        } }
    }
    { KArgs ka0 = kargs(); unsigned* bw = (unsigned*)((unsigned char*)ka0->ws + WS_BAR);
        if (blockIdx.x == 0) for (int w = threadIdx.x; w < XCD_BAR_WORDS; w += 512) __hip_atomic_store(bw + w, 0u, __ATOMIC_RELAXED, __HIP_MEMORY_SCOPE_AGENT);
        if (threadIdx.x < 2) ((volatile LAS unsigned*)(LDS_XB))[threadIdx.x] = 0u; }
    cg::this_grid().sync();
    { KArgs ka0 = kargs(); (void)xcd_barrier_post((unsigned*)((unsigned char*)ka0->ws + WS_BAR), (volatile LAS unsigned*)(LDS_XB)); }
    layer_body<0>(lds, ldsp); layer_body<1>(lds, ldsp); layer_body<2>(lds, ldsp); layer_body<3>(lds, ldsp);
    { PH_BEGIN const float* gf = (const float*)ka->in[28]; const float* sq = SSQ(12); float* hf = (float*)ka->out; const bf16_t* hs = (const bf16_t*)(ws + WS_HB);
        for (int m = gw; m < T; m += ngw) { f32x4* xr = (f32x4*)(hf + (size_t)m * 1024) + lane; const u32x2* hr = (const u32x2*)(hs + (size_t)m * 1024) + lane; const float rs = rsqrtf(pg8::ssq16(sq, m) * (1.0f / 1024.0f) + 1e-6f);
#pragma unroll
            for (int j = 0; j < 4; ++j) { const f32x4 gv = ((const f32x4*)gf)[lane + 64 * j]; const u32x2 hv = hr[64 * j]; xr[64 * j] = (f32x4){bflo(hv.x), bfhi(hv.x), bflo(hv.y), bfhi(hv.y)} * rs * gv; } } }
}
}

extern "C" void kernel_launch(void* const* d_in, const int* in_sizes, int n_in, void* d_out, int out_size, void* d_ws, size_t ws_size, hipStream_t stream) {
    static int grid_blocks = 0;
    if (!grid_blocks) {
        int dev = 0, cus = 0, per_cu = 0;
        (void)hipGetDevice(&dev);
        (void)hipDeviceGetAttribute(&cus, hipDeviceAttributeMultiprocessorCount, dev);
        (void)hipFuncSetAttribute((const void*)mk::fwd, hipFuncAttributeMaxDynamicSharedMemorySize, mk::LDS_BYTES);
        (void)hipOccupancyMaxActiveBlocksPerMultiprocessor(&per_cu, (const void*)mk::fwd, 512, mk::LDS_BYTES);
        (void)hipGetLastError();
        grid_blocks = cus > 0 ? cus : 256;
        if (ws_size < mk::WS_END || n_in != 29) { fprintf(stderr, "kernel_launch: workspace %zu < %zu or n_in %d != 29\n", ws_size, (size_t)mk::WS_END, n_in); }
    }
    (void)hipMemsetAsync((unsigned char*)d_ws + mk::WS_BAR, 0, 256, stream);
    mk::Params p{};
    for (int i = 0; i < 29; ++i) p.in[i] = (const float*)d_in[i];
    p.out = (float*)d_out; p.ws = (unsigned char*)d_ws;
    void* args[] = {&p};
    hipError_t e = hipLaunchCooperativeKernel((const void*)mk::fwd, dim3(grid_blocks), dim3(512), args, mk::LDS_BYTES, stream);
    if (e != hipSuccess) fprintf(stderr, "cooperative launch failed: %s (grid %d)\n", hipGetErrorString(e), grid_blocks);
}
```

```cpp
#include <hip/hip_runtime.h>
#include <cstdio>
#include <cstdint>

template <int K> __device__ __forceinline__ float xor_add(float v) {
    if constexpr (K < 32) return v + __int_as_float(__builtin_amdgcn_ds_swizzle(__float_as_int(v), (K << 10) | 0x1f));
    else { auto rr = __builtin_amdgcn_permlane32_swap(__float_as_uint(v), __float_as_uint(v), false, false); return __uint_as_float(rr[0]) + __uint_as_float(rr[1]); }
}
template <int K> __device__ __forceinline__ float xor_max(float v) {
    if constexpr (K < 32) return fmaxf(v, __int_as_float(__builtin_amdgcn_ds_swizzle(__float_as_int(v), (K << 10) | 0x1f)));
    else { auto rr = __builtin_amdgcn_permlane32_swap(__float_as_uint(v), __float_as_uint(v), false, false); return fmaxf(__uint_as_float(rr[0]), __uint_as_float(rr[1])); }
}
namespace pg8 {
#define PG8_LAS __attribute__((address_space(3)))
typedef unsigned short bf16_t;
typedef short bf16x8 __attribute__((ext_vector_type(8)));
typedef float f32x4 __attribute__((ext_vector_type(4)));
typedef unsigned u32x4 __attribute__((ext_vector_type(4)));
constexpr int BM = 256, BK = 64, HALF = 128, HTB = HALF * BK * 2  , STAGE_BYTES = 8 * HTB, NXCD = 8, WGM = 8;

__host__ __device__ __forceinline__ int lds_byte(int r, int c) { const int st = (r >> 4) * 2 + (c >> 5), rr = r & 15, cc = c & 31, ob = rr * 64 + cc * 2; return st * 1024 + (ob ^ (((ob >> 9) & 1) << 5)); }
__host__ __device__ __forceinline__ void stage_rc(int b, int& R, int& C) { const int st = b / 1024, sb = b % 1024, swz = sb ^ (((sb >> 9) & 1) << 5); R = (st >> 1) * 16 + swz / 64; C = (st & 1) * 32 + (swz % 64) / 2; }
__host__ __device__ __forceinline__ int perm32(int rho) { const int n = rho >> 4, i = rho & 15; return 8 * (i >> 2) + 4 * n + (i & 3); }

struct Unit { int pm, pn; };
struct Gemm { const bf16_t* A; const bf16_t* Bt; int M, N, K; };

struct StaticOrder {
    int nM, nN, nwg, G, c;
    __host__ __device__ void init(int M, int N, int G_, int c_) { nM = M / BM; nN = N / BM; nwg = nM * nN; G = G_; c = c_; }
    __host__ __device__ bool next(int i, Unit& u) const {
        const long L = (long)i * G + c; if (L >= nwg) return false;
        int wgid = (int)L; { const int q = nwg / NXCD, r = nwg % NXCD, xcd = wgid % NXCD, off = wgid / NXCD; wgid = (xcd < r ? xcd * (q + 1) : r * (q + 1) + (xcd - r) * q) + off; }
        const int nig = WGM * nN, gid = wgid / nig, fm = gid * WGM, gsz = (nM - fm) < WGM ? (nM - fm) : WGM;
        u.pm = fm + ((wgid % nig) % gsz); u.pn = (wgid % nig) / gsz; return true;
    }
    __device__ __forceinline__ void a_ready(const Unit&) const {}
    __device__ __forceinline__ void done(const Unit&) const {}
};

__device__ __forceinline__ unsigned cvt_pk_bf16(float lo, float hi) { unsigned r; asm volatile("v_cvt_pk_bf16_f32 %0, %1, %2" : "=v"(r) : "v"(lo), "v"(hi)); return r; }
typedef float f32x2 __attribute__((ext_vector_type(2)));
constexpr float RMS_EPS = 1e-6f;
typedef unsigned u32x2 __attribute__((ext_vector_type(2)));
__device__ __forceinline__ float sigm(float x) { return __builtin_amdgcn_rcpf(1.0f + __expf(-x)); }
__device__ __forceinline__ float bflo(unsigned w) { return __uint_as_float(w << 16); }
__device__ __forceinline__ float bfhi(unsigned w) { return __uint_as_float(w & 0xffff0000u); }
__device__ __forceinline__ float ssq16(const float* s, int r) { const f32x4* q = (const f32x4*)(s + (size_t)r * 16); const f32x4 a = q[0] + q[1], b = q[2] + q[3], c = a + b; return (c[0] + c[1]) + (c[2] + c[3]); }
template <int ACT> struct EpiRow {
    static constexpr bool PERM = true, AFTER_DRAIN = false;
    bf16_t* O; int ldc; const float* ssq; unsigned qmask; float qscale; int split_cols; size_t split_stride;
    __device__ __forceinline__ void operator()(const f32x4 (&acc)[2][2][4][2], const Unit& u, int wr, int wc, int fr, int fq) const {
        int colt = u.pn * BM; bf16_t* Ob = O; if (split_cols) { const int t = colt / split_cols; Ob += (size_t)t * split_stride; colt -= t * split_cols; }
        const int row0 = u.pm * BM + wr * 64 + fr, col0 = colt + wc * 32 + 8 * fq;
        const float cs = ((qmask >> u.pn) & 1u) ? qscale : 1.f;
#pragma unroll
        for (int ai = 0; ai < 2; ++ai)
#pragma unroll
            for (int m = 0; m < 4; ++m) { const int r = row0 + ai * HALF + m * 16; const float rs = rsqrtf(ssq16(ssq, r) * (1.0f / 1024.0f) + RMS_EPS) * cs;
                bf16_t* rowp = Ob + (size_t)r * ldc + col0;
#pragma unroll
                for (int bj = 0; bj < 2; ++bj) { f32x4 v0 = acc[ai][bj][m][0] * rs, v1 = acc[ai][bj][m][1] * rs;
                    if (ACT == 1) {
#pragma unroll
                        for (int e = 0; e < 4; ++e) { const float a = fmaxf(v0[e], 0.f), b = fmaxf(v1[e], 0.f); v0[e] = a * a; v1[e] = b * b; } }
                    u32x4 w; w.x = cvt_pk_bf16(v0[0], v0[1]); w.y = cvt_pk_bf16(v0[2], v0[3]); w.z = cvt_pk_bf16(v1[0], v1[1]); w.w = cvt_pk_bf16(v1[2], v1[3]);
                    *(u32x4*)(rowp + bj * HALF) = w; } }
    }
};
template <int MODE> struct EpiRes {
    static constexpr bool PERM = false, AFTER_DRAIN = false;
    const bf16_t* base; bf16_t* outb; float* ssq_next; const float* ssq_cur; const bf16_t* pp;
    __device__ __forceinline__ void operator()(const f32x4 (&acc)[2][2][4][2], const Unit& u, int wr, int wc, int fr, int fq) const {
        const int row0 = u.pm * BM + wr * 64 + fr, col0 = u.pn * BM + wc * 32 + 4 * fq;
#pragma unroll
        for (int ai = 0; ai < 2; ++ai)
#pragma unroll
            for (int m = 0; m < 4; ++m) { const int r = row0 + ai * HALF + m * 16; const size_t off = (size_t)r * 1024 + col0; float sq = 0.f;
                float rs = 0.f; if (MODE == 1) rs = rsqrtf(ssq16(ssq_cur, r) * (1.0f / 1024.0f) + RMS_EPS);
#pragma unroll
                for (int bj = 0; bj < 2; ++bj)
#pragma unroll
                    for (int n = 0; n < 2; ++n) { const size_t o = off + bj * HALF + n * 16; f32x4 a = acc[ai][bj][m][n];
                        if (MODE == 1) { const u32x2 g = *(const u32x2*)(pp + o);
                            a[0] = bflo(g.x) * sigm(a[0] * rs); a[1] = bfhi(g.x) * sigm(a[1] * rs); a[2] = bflo(g.y) * sigm(a[2] * rs); a[3] = bfhi(g.y) * sigm(a[3] * rs); }
                        const u32x2 bv = *(const u32x2*)(base + o);
                        const f32x4 hv = (f32x4){bflo(bv.x), bfhi(bv.x), bflo(bv.y), bfhi(bv.y)} + a;
                        u32x2 w; w.x = cvt_pk_bf16(hv[0], hv[1]); w.y = cvt_pk_bf16(hv[2], hv[3]); *(u32x2*)(outb + o) = w;
                        sq += (hv[0] * hv[0] + hv[1] * hv[1]) + (hv[2] * hv[2] + hv[3] * hv[3]); }
                sq = xor_add<16>(sq); sq = xor_add<32>(sq);
                if (fq == 0) ssq_next[(size_t)r * 16 + u.pn * 4 + wc] = sq; }
    }
};
struct EpiPP {
    static constexpr bool PERM = false, AFTER_DRAIN = false;
    bf16_t* O;
    __device__ __forceinline__ void operator()(const f32x4 (&acc)[2][2][4][2], const Unit& u, int wr, int wc, int fr, int fq) const {
        const int row0 = u.pm * BM + wr * 64 + fr, col0 = u.pn * BM + wc * 32 + 4 * fq;
#pragma unroll
        for (int ai = 0; ai < 2; ++ai)
#pragma unroll
            for (int m = 0; m < 4; ++m) { const size_t off = (size_t)(row0 + ai * HALF + m * 16) * 1024 + col0;
#pragma unroll
                for (int bj = 0; bj < 2; ++bj)
#pragma unroll
                    for (int n = 0; n < 2; ++n) { const f32x4 a = acc[ai][bj][m][n]; u32x2 w; w.x = cvt_pk_bf16(a[0], a[1]); w.y = cvt_pk_bf16(a[2], a[3]); *(u32x2*)(O + off + bj * HALF + n * 16) = w; } }
    }
};
struct EpiGlu {
    static constexpr bool PERM = true, AFTER_DRAIN = false;
    bf16_t* O; const bf16_t* yg;
    __device__ __forceinline__ void operator()(const f32x4 (&acc)[2][2][4][2], const Unit& u, int wr, int wc, int fr, int fq) const {
        const int row0 = u.pm * BM + wr * 64 + fr, col0 = u.pn * BM + wc * 32 + 8 * fq;
#pragma unroll
        for (int ai = 0; ai < 2; ++ai)
#pragma unroll
            for (int m = 0; m < 4; ++m) { const int r = row0 + ai * HALF + m * 16;
#pragma unroll
                for (int bj = 0; bj < 2; ++bj) { const int c = col0 + bj * HALF; const u32x4 y = *(const u32x4*)(yg + (size_t)r * 512 + c);
                    const f32x4 v0 = acc[ai][bj][m][0], v1 = acc[ai][bj][m][1]; u32x4 w;
                    w.x = cvt_pk_bf16(bflo(y.x) * sigm(v0[0]), bfhi(y.x) * sigm(v0[1])); w.y = cvt_pk_bf16(bflo(y.y) * sigm(v0[2]), bfhi(y.y) * sigm(v0[3]));
                    w.z = cvt_pk_bf16(bflo(y.z) * sigm(v1[0]), bfhi(y.z) * sigm(v1[1])); w.w = cvt_pk_bf16(bflo(y.w) * sigm(v1[2]), bfhi(y.w) * sigm(v1[3]));
                    *(u32x4*)(O + (size_t)r * 1024 + c) = w; } }
    }
};
template <class Epi, class Sched, bool ALIGN_EPI = false, bool SP2 = false>
__device__ __forceinline__ void gemm_phase(PG8_LAS unsigned char* lds, const Gemm g, const Sched& S, const Epi& E) {
    int tid = threadIdx.x; asm volatile("" : "+v"(tid)); const int wid = __builtin_amdgcn_readfirstlane(tid >> 6), lane = tid & 63, wr = wid >> 2, wc = wid & 3, fr = lane & 15, fq = lane >> 4;
    const int K = g.K, nt = K / BK;
    unsigned voffA[2], voffB[2];
#pragma unroll
    for (int i = 0; i < 2; ++i) { int R, C; stage_rc(tid * 16 + i * 8192, R, C); const int Rb = Epi::PERM ? ((R & ~31) + perm32(R & 31)) : R;
        voffA[i] = (unsigned)(R * K + C) * 2u; voffB[i] = (unsigned)(Rb * K + C) * 2u; }
    const size_t kstep = (size_t)(BK * 2);
    const size_t hstep = (size_t)HALF * K * 2;
    const size_t tstep = 2 * hstep;
    const unsigned ldsw = (unsigned)wid * 1024u;
    const int aoff = lds_byte(wr * 64 + fr, fq * 8), boff = lds_byte(wc * 32 + fr, fq * 8);
#define PG8_SA(b, h) (((b) * 2 + (h)) * HTB)
#define PG8_SB(b, h) ((4 + (b) * 2 + (h)) * HTB)
#define PG8_STAGE(bufoff, gbase, voff) do { _Pragma("unroll") for (int _i = 0; _i < 2; ++_i) \
        __builtin_amdgcn_global_load_lds((const unsigned*)((const char*)(gbase) + (voff)[_i]), (PG8_LAS unsigned*)(lds + (bufoff) + ldsw + _i * 8192), 16, 0, 0); } while (0)
#define PG8_LDA(dst, b, h) do { _Pragma("unroll") for (int m = 0; m < 4; ++m) _Pragma("unroll") for (int k = 0; k < 2; ++k) dst[m][k] = *(const PG8_LAS bf16x8*)(lds + PG8_SA(b, h) + aoff + m * 2048 + k * 1024); } while (0)
#define PG8_LDB(dst, b, h) do { _Pragma("unroll") for (int n = 0; n < 2; ++n) _Pragma("unroll") for (int k = 0; k < 2; ++k) dst[n][k] = *(const PG8_LAS bf16x8*)(lds + PG8_SB(b, h) + boff + n * 2048 + k * 1024); } while (0)
#define PG8_MMA(ai, bj, At, Bt) do { __builtin_amdgcn_s_setprio(1); _Pragma("unroll") for (int m = 0; m < 4; ++m) _Pragma("unroll") for (int n = 0; n < 2; ++n) _Pragma("unroll") for (int k = 0; k < 2; ++k) \
        acc[ai][bj][m][n] = __builtin_amdgcn_mfma_f32_16x16x32_bf16(Bt[n][k], At[m][k], acc[ai][bj][m][n], 0, 0, 0); __builtin_amdgcn_s_setprio(0); } while (0)
#define PG8_WAIT_V(n) asm volatile("s_waitcnt vmcnt(" #n ")" ::: "memory")
#define PG8_WAIT_L(n) asm volatile("s_waitcnt lgkmcnt(" #n ")" ::: "memory")
#define PG8_BAR __builtin_amdgcn_s_barrier()
#define PG8_SCHED __builtin_amdgcn_sched_barrier(0)
    Unit cur, nxt; int ui = 0;
    if (!S.next(0, cur)) return;
    f32x4 acc[2][2][4][2];
#pragma unroll
    for (int a = 0; a < 2; ++a)
#pragma unroll
        for (int b = 0; b < 2; ++b)
#pragma unroll
            for (int m = 0; m < 4; ++m)
#pragma unroll
                for (int n = 0; n < 2; ++n) acc[a][b][m][n] = (f32x4){0.f, 0.f, 0.f, 0.f};
    bf16x8 At[4][2], B0[2][2], B1[2][2];
    const char* cA = (const char*)g.A + (size_t)cur.pm * tstep; const char* cB = (const char*)g.Bt + (size_t)cur.pn * tstep;
    S.a_ready(cur);
    if constexpr (SP2) {
        PG8_STAGE(PG8_SB(0, 0), cB, voffB); PG8_STAGE(PG8_SB(0, 1), cB + hstep, voffB); PG8_STAGE(PG8_SA(0, 0), cA, voffA); PG8_STAGE(PG8_SA(0, 1), cA + hstep, voffA);
        if (wr == 1) PG8_BAR;
        PG8_WAIT_V(2); PG8_BAR;
        PG8_STAGE(PG8_SB(1, 0), cB + kstep, voffB); PG8_STAGE(PG8_SA(1, 0), cA + kstep, voffA); PG8_STAGE(PG8_SB(1, 1), cB + hstep + kstep, voffB);
        PG8_WAIT_V(6); PG8_BAR;
    } else {
        PG8_STAGE(PG8_SB(0, 0), cB, voffB); PG8_STAGE(PG8_SA(0, 0), cA, voffA); PG8_STAGE(PG8_SB(0, 1), cB + hstep, voffB); PG8_STAGE(PG8_SA(0, 1), cA + hstep, voffA);
        if (wr == 1) PG8_BAR;
        PG8_WAIT_V(4); PG8_BAR;
        PG8_STAGE(PG8_SB(1, 0), cB + kstep, voffB); PG8_STAGE(PG8_SA(1, 0), cA + kstep, voffA); PG8_STAGE(PG8_SB(1, 1), cB + hstep + kstep, voffB);
        PG8_WAIT_V(6); PG8_BAR;
    }
    for (;;) {
        const bool has_next = S.next(ui + 1, nxt);
        const char* nA = has_next ? (const char*)g.A + (size_t)nxt.pm * tstep : cA; const char* nB = has_next ? (const char*)g.Bt + (size_t)nxt.pn * tstep : cB;
        for (int t = 0; t < nt; t += 2) {
            const bool last = (t == nt - 2);
            const char* a1 = cA + (size_t)(t + 1) * kstep;
            const char* a2 = last ? nA : cA + (size_t)(t + 2) * kstep; const char* b2 = last ? nB : cB + (size_t)(t + 2) * kstep;
            const char* a3 = a2 + kstep; const char* b3 = b2 + kstep;
            if (last && has_next) S.a_ready(nxt);
            if constexpr (SP2) {
            PG8_LDB(B0, 0, 0); PG8_LDB(B1, 0, 1); PG8_SCHED; PG8_LDA(At, 0, 0); PG8_STAGE(PG8_SA(1, 1), a1 + hstep, voffA);
            PG8_WAIT_V(8); PG8_WAIT_L(0); PG8_BAR; PG8_MMA(0, 0, At, B0); PG8_MMA(0, 1, At, B1); PG8_BAR; PG8_SCHED;
            PG8_LDA(At, 0, 1); PG8_STAGE(PG8_SB(0, 0), b2, voffB); PG8_STAGE(PG8_SB(0, 1), b2 + hstep, voffB); PG8_STAGE(PG8_SA(0, 0), a2, voffA);
            PG8_WAIT_V(8); PG8_WAIT_L(0); PG8_BAR; PG8_MMA(1, 0, At, B0); PG8_MMA(1, 1, At, B1); PG8_BAR; PG8_SCHED;
            PG8_LDB(B0, 1, 0); PG8_LDB(B1, 1, 1); PG8_SCHED; PG8_LDA(At, 1, 0); PG8_STAGE(PG8_SA(0, 1), a2 + hstep, voffA);
            PG8_WAIT_V(8); PG8_WAIT_L(0); PG8_BAR; PG8_MMA(0, 0, At, B0); PG8_MMA(0, 1, At, B1); PG8_BAR; PG8_SCHED;
            PG8_LDA(At, 1, 1); PG8_STAGE(PG8_SB(1, 0), b3, voffB); PG8_STAGE(PG8_SB(1, 1), b3 + hstep, voffB); PG8_STAGE(PG8_SA(1, 0), a3, voffA);
            PG8_WAIT_V(8); PG8_WAIT_L(0); PG8_BAR; PG8_MMA(1, 0, At, B0); PG8_MMA(1, 1, At, B1); PG8_BAR; PG8_SCHED;
            } else {
            PG8_LDB(B0, 0, 0); PG8_SCHED; PG8_LDA(At, 0, 0); PG8_STAGE(PG8_SA(1, 1), a1 + hstep, voffA);
            PG8_WAIT_L(8); PG8_BAR; PG8_WAIT_L(0); PG8_MMA(0, 0, At, B0); PG8_BAR; PG8_SCHED;
            PG8_LDB(B1, 0, 1); PG8_STAGE(PG8_SB(0, 0), b2, voffB);
            PG8_BAR; PG8_WAIT_L(0); PG8_MMA(0, 1, At, B1); PG8_BAR;
            PG8_LDA(At, 0, 1); PG8_STAGE(PG8_SA(0, 0), a2, voffA);
            PG8_BAR; PG8_WAIT_L(0); PG8_MMA(1, 0, At, B0); PG8_BAR; PG8_SCHED;
            PG8_STAGE(PG8_SB(0, 1), b2 + hstep, voffB);
            PG8_WAIT_V(6); PG8_BAR; PG8_MMA(1, 1, At, B1); PG8_BAR;
            PG8_LDB(B0, 1, 0); PG8_SCHED; PG8_LDA(At, 1, 0); PG8_STAGE(PG8_SA(0, 1), a2 + hstep, voffA);
            PG8_WAIT_L(8); PG8_BAR; PG8_WAIT_L(0); PG8_MMA(0, 0, At, B0); PG8_BAR; PG8_SCHED;
            PG8_LDB(B1, 1, 1); PG8_STAGE(PG8_SB(1, 0), b3, voffB);
            PG8_BAR; PG8_WAIT_L(0); PG8_MMA(0, 1, At, B1); PG8_BAR;
            PG8_LDA(At, 1, 1); PG8_STAGE(PG8_SA(1, 0), a3, voffA);
            PG8_BAR; PG8_WAIT_L(0); PG8_MMA(1, 0, At, B0); PG8_BAR; PG8_SCHED;
            PG8_STAGE(PG8_SB(1, 1), b3 + hstep, voffB);
            PG8_WAIT_V(6); PG8_BAR; PG8_MMA(1, 1, At, B1); PG8_BAR;
            }
        }
        if constexpr (ALIGN_EPI) { if (wr == 0) PG8_BAR; }
        if constexpr (!Epi::AFTER_DRAIN) { E(acc, cur, wr, wc, fr, fq); S.done(cur); }
        if (!has_next) break;
#pragma unroll
        for (int a = 0; a < 2; ++a)
#pragma unroll
            for (int b = 0; b < 2; ++b)
#pragma unroll
                for (int m = 0; m < 4; ++m)
#pragma unroll
                    for (int n = 0; n < 2; ++n) acc[a][b][m][n] = (f32x4){0.f, 0.f, 0.f, 0.f};
        cur = nxt; cA = nA; cB = nB; ++ui;
        if constexpr (ALIGN_EPI) { if (wr == 1) PG8_BAR; }
    }
    PG8_WAIT_V(0);
    if constexpr (!ALIGN_EPI) { if (wr == 0) PG8_BAR; }
    PG8_BAR;
    if constexpr (Epi::AFTER_DRAIN) { E.fused(acc, cur, wr, wc, fr, fq, lds, wid, lane); S.done(cur); }
#undef PG8_SA
#undef PG8_SB
#undef PG8_STAGE
#undef PG8_LDA
#undef PG8_LDB
#undef PG8_MMA
#undef PG8_WAIT_V
#undef PG8_WAIT_L
#undef PG8_BAR
#undef PG8_SCHED
}
}
#include <hip/hip_bf16.h>
#include <cmath>
namespace attn_body {
using bf16=__hip_bfloat16;
using bf16x8=__attribute__((ext_vector_type(8)))short;
using s16x4=__attribute__((ext_vector_type(4)))short;
using f32x16=__attribute__((ext_vector_type(16)))float;
using u32x4=__attribute__((ext_vector_type(4)))unsigned;
constexpr int SEQ=4096,D=64,PQ=512,PO=1024;
constexpr int NW=8,QBLK=32,QB=QBLK*NW,KVBLK=64,NQB=SEQ/QB;

__device__ __forceinline__ int crow(int r,int hi){return (r&3)+8*(r>>2)+4*hi;}
#define SBAR() __builtin_amdgcn_sched_barrier(0)
__device__ __forceinline__ void cmask(f32x16&p0,f32x16&p1,int jb,int qrel,int hi){
  const float NEG=-INFINITY; int kb=64*jb+4*hi;
  #pragma unroll
  for(int r=0;r<16;++r){int kv=kb+(r&3)+8*(r>>2); if(kv>qrel)p0[r]=NEG; if(kv+32>qrel)p1[r]=NEG;}
}

constexpr int NSLOT=3, SLOTB=8192;
constexpr int LDS_K=0, LDS_V=NSLOT*SLOTB, LDS_WS=2*NSLOT*SLOTB, LDS_OST=LDS_WS+NW*64*4, LDS_BYTES=LDS_OST+NW*4096;
constexpr float C2=0.125f*1.4426950408889634f;
__device__ __forceinline__ void glds16(const void*gsrc,unsigned lds_dst){unsigned keep;
  asm volatile("s_mov_b32 %0, m0\n\ts_mov_b32 m0, %2\n\ts_nop 0\n\tglobal_load_lds_dwordx4 %1, off\n\ts_mov_b32 m0, %0":"=&s"(keep):"v"(gsrc),"s"(lds_dst):"memory");}
__device__ __forceinline__ float max3f(float a,float b,float c){float r;asm("v_max3_f32 %0, %1, %2, %3":"=v"(r):"v"(a),"v"(b),"v"(c));return r;}
__device__ __forceinline__ float max2f(float a,float b){float r;asm("v_max_f32_e32 %0, %1, %2":"=v"(r):"v"(a),"v"(b));return r;}
__device__ __forceinline__ float fadd_s(float a,float b){float r;asm("v_add_f32_e32 %0, %1, %2":"=v"(r):"v"(a),"v"(b));return r;}
__device__ __forceinline__ float fsub_s(float a,float b){float r;asm("v_sub_f32_e32 %0, %1, %2":"=v"(r):"v"(a),"v"(b));return r;}
typedef float f32x2_t __attribute__((ext_vector_type(2))); typedef __bf16 bf16x2_t __attribute__((ext_vector_type(2)));
__device__ __forceinline__ unsigned cvtpk_s(float lo,float hi){f32x2_t v={lo,hi};bf16x2_t b=__builtin_convertvector(v,bf16x2_t);return __builtin_bit_cast(unsigned,b);}
#define WAIT_BAR(N) asm volatile("s_waitcnt vmcnt(" #N ") lgkmcnt(0)\n\ts_barrier":::"memory")

__device__ __forceinline__ void qkt(f32x16&p0,f32x16&p1,const char*Kslot,const bf16x8*qr,const f32x16&negm,int r32,int hi){
  const char*kb=Kslot+hi*1024+r32*16;
  #pragma unroll
  for(int d0=0;d0<4;++d0){
    const bf16x8 b0=*reinterpret_cast<const bf16x8*>(kb+d0*2048);
    const bf16x8 b1=*reinterpret_cast<const bf16x8*>(kb+d0*2048+512);
    if(d0==0){p0=__builtin_amdgcn_mfma_f32_32x32x16_bf16(b0,qr[0],negm,0,0,0);p1=__builtin_amdgcn_mfma_f32_32x32x16_bf16(b1,qr[0],negm,0,0,0);}
    else{p0=__builtin_amdgcn_mfma_f32_32x32x16_bf16(b0,qr[d0],p0,0,0,0);p1=__builtin_amdgcn_mfma_f32_32x32x16_bf16(b1,qr[d0],p1,0,0,0);}}
}
typedef __attribute__((address_space(3))) const char* lds_cptr;
typedef short v4i16_t __attribute__((ext_vector_type(4)));
__device__ __forceinline__ void kload8(bf16x8*kf,lds_cptr kp){
  kf[0]=*(const __attribute__((address_space(3))) bf16x8*)(kp);      kf[1]=*(const __attribute__((address_space(3))) bf16x8*)(kp+512);
  kf[2]=*(const __attribute__((address_space(3))) bf16x8*)(kp+2048); kf[3]=*(const __attribute__((address_space(3))) bf16x8*)(kp+2560);
  kf[4]=*(const __attribute__((address_space(3))) bf16x8*)(kp+4096); kf[5]=*(const __attribute__((address_space(3))) bf16x8*)(kp+4608);
  kf[6]=*(const __attribute__((address_space(3))) bf16x8*)(kp+6144); kf[7]=*(const __attribute__((address_space(3))) bf16x8*)(kp+6656);
}
__device__ __forceinline__ void kload2(bf16x8*kf,lds_cptr kp,int j){ kf[2*j]=*(const __attribute__((address_space(3))) bf16x8*)(kp+j*2048); kf[2*j+1]=*(const __attribute__((address_space(3))) bf16x8*)(kp+j*2048+512); }
__device__ __forceinline__ s16x4 vtr(lds_cptr p){ return __builtin_bit_cast(s16x4,__builtin_amdgcn_ds_read_tr16_b64_v4i16((__attribute__((address_space(3))) v4i16_t*)p)); }
__device__ __forceinline__ float rowmax(const f32x16&p0,const f32x16&p1){
  float a=max3f(p0[0],p0[1],p1[0]),b=max3f(p0[2],p0[3],p1[1]);a=max3f(a,p1[2],p1[3]);
  #pragma unroll
  for(int r=4;r<16;r+=4){a=max3f(a,p0[r],p0[r+1]);b=max3f(b,p0[r+2],p0[r+3]);a=max3f(a,p1[r],p1[r+1]);b=max3f(b,p1[r+2],p1[r+3]);}
  const float m=max2f(a,b);
  auto rr=__builtin_amdgcn_permlane32_swap(__float_as_uint(m),__float_as_uint(m),false,false);
  return max2f(__uint_as_float(rr[0]),__uint_as_float(rr[1]));
}
__device__ __forceinline__ void pv(f32x16*o,int vb,bf16x8 pa0,bf16x8 pa1,bf16x8 pa2,bf16x8 pa3){
  #pragma unroll
  for(int d0=0;d0<2;++d0){s16x4 lo[4],hi[4];
    #pragma unroll
    for(int ks=0;ks<4;++ks){
      asm volatile("ds_read_b64_tr_b16 %0,%1 offset:%c2":"=&v"(lo[ks]):"v"(vb),"i"(d0*4096+ks*1024):"memory");
      asm volatile("ds_read_b64_tr_b16 %0,%1 offset:%c2":"=&v"(hi[ks]):"v"(vb),"i"(d0*4096+ks*1024+512):"memory");}
    asm volatile("s_waitcnt lgkmcnt(0)":::"memory");SBAR();
    #define PK(k) (bf16x8){lo[k][0],lo[k][1],lo[k][2],lo[k][3],hi[k][0],hi[k][1],hi[k][2],hi[k][3]}
    o[d0]=__builtin_amdgcn_mfma_f32_32x32x16_bf16(pa0,PK(0),o[d0],0,0,0);
    o[d0]=__builtin_amdgcn_mfma_f32_32x32x16_bf16(pa1,PK(1),o[d0],0,0,0);
    o[d0]=__builtin_amdgcn_mfma_f32_32x32x16_bf16(pa2,PK(2),o[d0],0,0,0);
    o[d0]=__builtin_amdgcn_mfma_f32_32x32x16_bf16(pa3,PK(3),o[d0],0,0,0);
    #undef PK
  }
}

#ifndef ATTN_STORE16
#define ATTN_STORE16(p,v) (*(u32x4*)(p)=(v))
#endif
template<int THRL> __device__ __forceinline__ void attn_unit(int b,int h,int qb,const bf16*Q,const bf16*__restrict__ K,const bf16*__restrict__ V,bf16*O,char*shm){
  int tid=threadIdx.x; asm volatile("":"+v"(tid)); const int lane=tid&63,r32=lane&31,hi=lane>>5; const int wid=__builtin_amdgcn_readfirstlane(tid>>6);
  const long rowbase=(long)b*SEQ; const int q0=qb*QB;
  const bf16*Qw=Q+(rowbase+q0+wid*QBLK)*PQ;
  const bf16*Kh=K+rowbase*PQ,*Vh=V+rowbase*PQ;
  const unsigned lds0=(unsigned)(uintptr_t)shm;
  float*wsf=(float*)(shm+LDS_WS)+wid*64;
  const bf16*ksrc=Kh+(long)lane*PQ+wid*8;
  const bf16*vsrc=Vh+(long)(16*(wid&3)+(lane>>2))*PQ+(wid>>2)*32+(lane&3)*8;
  const unsigned kdst=lds0+LDS_K+wid*1024, vdst=lds0+LDS_V+wid*1024;
  #define DMA_K(t,slot) glds16(ksrc+(long)(t)*KVBLK*PQ,(unsigned)__builtin_amdgcn_readfirstlane(kdst+(slot)))
  #define DMA_V(t,slot) glds16(vsrc+(long)(t)*KVBLK*PQ,(unsigned)__builtin_amdgcn_readfirstlane(vdst+(slot)))
  const int vb0=(int)(lds0+LDS_V)+((lane>>4)&1)*32+(lane&3)*8+(4*hi+((lane&15)>>2))*64;
  const char*Kbase=shm+LDS_K; bf16x8 kf[8];
  const lds_cptr shm3=(lds_cptr)shm; const lds_cptr kp0=shm3+LDS_K+hi*1024+r32*16; const lds_cptr vp0=shm3+LDS_V+((lane>>4)&1)*32+(lane&3)*8+(4*hi+((lane&15)>>2))*64;
  const int NT=(q0+QB)/KVBLK;
  DMA_K(0,0);DMA_V(0,0);DMA_K(1,SLOTB);
  bf16x8 qr[4];
  #pragma unroll
  for(int d0=0;d0<4;++d0)qr[d0]=*reinterpret_cast<const bf16x8*>(&Qw[(long)r32*PQ+d0*16+hi*8]);
  float mhat=0.f,l_reg=0.f;f32x16 o[2];o[0]=f32x16{};o[1]=f32x16{};float zz_=0.f;asm volatile("":"+v"(zz_));f32x16 negm;
  _Pragma("unroll") for(int r=0;r<16;++r)negm[r]=zz_;
  const int qrel=wid*QBLK+r32;
  #define CMASK(P0,P1,t) do{int jb_=(t)-(NT-4); if(jb_>=0)cmask(P0,P1,jb_,qrel,hi);}while(0)
  bool resc=false;
  #define START(P0,P1) do{ const float rm=rowmax(P0,P1); resc=false; \
    { const float dl=rm; mhat=fadd_s(mhat,dl); \
      _Pragma("unroll") for(int r=0;r<16;++r){P0[r]=fsub_s(P0[r],dl);P1[r]=fsub_s(P1[r],dl);} \
      _Pragma("unroll") for(int r=0;r<16;++r)negm[r]=-mhat; asm volatile("":"+v"(negm)); } \
    _Pragma("unroll") for(int r=0;r<16;++r)P0[r]=__builtin_amdgcn_exp2f(P0[r]); }while(0)
  #define RESC() do{ if(resc){ asm volatile("s_waitcnt lgkmcnt(0)":::"memory"); \
      _Pragma("unroll") for(int d_=0;d_<2;++d_) _Pragma("unroll") for(int r=0;r<16;++r)o[d_][r]*=wsf[crow(r,hi)]; } }while(0)
  f32x16 pA0,pA1,pB0,pB1;
  int sl_prev=0,sl_cur=0,sl_next=SLOTB;
  #define ROT() do{sl_prev=sl_cur;sl_cur=sl_next;sl_next=(sl_next==(NSLOT-1)*SLOTB)?0:sl_next+SLOTB;}while(0)
  DMA_K(2,2*SLOTB);
  WAIT_BAR(3);
  qkt(pA0,pA1,Kbase,qr,negm,r32,hi);asm volatile("s_nop 15\n\ts_nop 7":"+v"(pA0),"+v"(pA1));CMASK(pA0,pA1,0);
  START(pA0,pA1);
  _Pragma("unroll") for(int r=0;r<16;++r)pA1[r]=__builtin_amdgcn_exp2f(pA1[r]);
  WAIT_BAR(0);
  DMA_K(3,0);DMA_V(1,SLOTB);
  ROT();
  kload8(kf,kp0+sl_cur);
  WAIT_BAR(2);
  s16x4 vlo[8],vhi[8]; u32x4 pw0,pw1,pw2,pw3;
  #define PKW(P,B) cvtpk_s(P[B],P[B+1])
  #define PAF(k) __builtin_bit_cast(bf16x8,pw##k)
  #define VFR(i) (bf16x8){vlo[i][0],vlo[i][1],vlo[i][2],vlo[i][3],vhi[i][0],vhi[i][1],vhi[i][2],vhi[i][3]}
  #define PIN(x) asm volatile("":"+v"(x))
  #define MX3(a,b,c) __builtin_fmaxf(__builtin_fmaxf((a),(b)),(c))
  #define GAPA(MF,A0,A1,A2,A3,W0,W1,PW) do{ MF; sacc+=A0; sacc+=A1; sacc+=A2; sacc+=A3; PIN(sacc); W0; W1; PIN(PW); SBAR(); }while(0)
  #define EX(v) __builtin_amdgcn_exp2f(v)
  #define GAPB(MF,X,B) do{ MF; X[B]=EX(X[B]); X[B+1]=EX(X[B+1]); X[B+2]=EX(X[B+2]); X[B+3]=EX(X[B+3]); PIN(X); SBAR(); }while(0)
  #define VRD(i) do{ vlo[i]=vtr(vp_+(((i)>>2)*4096+((i)&3)*1024)); vhi[i]=vtr(vp_+(((i)>>2)*4096+((i)&3)*1024+512)); }while(0)
  #define KRD(G,j) do{ if(G){ kload2(kf,kp0+sl_next,j); SBAR(); } }while(0)
  #define STEP(C0,C1,P0,P1,t,GK,GV,GL) do{ SBAR(); \
    const lds_cptr vp_=vp0+sl_prev; \
    VRD(0); SBAR(); float sacc=(P0[0]+P0[1]); \
    GAPA(C0=__builtin_amdgcn_mfma_f32_32x32x16_bf16(kf[0],qr[0],negm,0,0,0), P0[2],P0[3],P0[4],P0[5],     pw0[0]=PKW(P0,0), pw0[1]=PKW(P0,2), pw0); \
    VRD(4); SBAR(); GAPA(C1=__builtin_amdgcn_mfma_f32_32x32x16_bf16(kf[1],qr[0],negm,0,0,0), P0[6],P0[7],P0[8],P0[9],     pw0[2]=PKW(P0,4), pw0[3]=PKW(P0,6), pw0); \
    VRD(1); SBAR(); GAPA(C0=__builtin_amdgcn_mfma_f32_32x32x16_bf16(kf[2],qr[1],C0,0,0,0),   P0[10],P0[11],P0[12],P0[13], pw1[0]=PKW(P0,8), pw1[1]=PKW(P0,10), pw1); \
    VRD(5); SBAR(); GAPA(C1=__builtin_amdgcn_mfma_f32_32x32x16_bf16(kf[3],qr[1],C1,0,0,0),   P0[14],P0[15],P1[0],P1[1],   pw1[2]=PKW(P0,12),pw1[3]=PKW(P0,14), pw1); \
    VRD(2); SBAR(); GAPA(C0=__builtin_amdgcn_mfma_f32_32x32x16_bf16(kf[4],qr[2],C0,0,0,0),   P1[2],P1[3],P1[4],P1[5],     pw2[0]=PKW(P1,0), pw2[1]=PKW(P1,2), pw2); \
    VRD(6); SBAR(); GAPA(C1=__builtin_amdgcn_mfma_f32_32x32x16_bf16(kf[5],qr[2],C1,0,0,0),   P1[6],P1[7],P1[8],P1[9],     pw2[2]=PKW(P1,4), pw2[3]=PKW(P1,6), pw2); \
    VRD(3); SBAR(); GAPA(C0=__builtin_amdgcn_mfma_f32_32x32x16_bf16(kf[6],qr[3],C0,0,0,0),   P1[10],P1[11],P1[12],P1[13], pw3[0]=PKW(P1,8), pw3[1]=PKW(P1,10), pw3); \
    VRD(7); SBAR(); GAPA(C1=__builtin_amdgcn_mfma_f32_32x32x16_bf16(kf[7],qr[3],C1,0,0,0),   P1[14],P1[15],0.f,0.f,       pw3[2]=PKW(P1,12),pw3[3]=PKW(P1,14), pw3); \
    l_reg+=sacc; \
    if(GK){DMA_K((t)+3,sl_cur);} if(GV){DMA_V((t)+1,sl_next);} \
    CMASK(C0,C1,t); \
    { float a=MX3(C0[0],C0[1],C1[0]),b=MX3(C0[2],C0[3],C1[1]); a=MX3(a,C1[2],C1[3]); \
      _Pragma("unroll") for(int r=4;r<16;r+=4){a=MX3(a,C0[r],C0[r+1]);b=MX3(b,C0[r+2],C0[r+3]);a=MX3(a,C1[r],C1[r+1]);b=MX3(b,C1[r+2],C1[r+3]);} \
      float rm=__builtin_fmaxf(a,b); { auto rr=__builtin_amdgcn_permlane32_swap(__float_as_uint(rm),__float_as_uint(rm),false,false); rm=__builtin_fmaxf(__uint_as_float(rr[0]),__uint_as_float(rr[1])); } \
      resc=false; \
      if(__builtin_expect(__any(rm>(float)THRL),0)){ const float dl=__builtin_fmaxf(rm,0.f); mhat+=dl; \
        _Pragma("unroll") for(int r=0;r<16;++r){C0[r]-=dl;C1[r]-=dl;} \
        _Pragma("unroll") for(int r=0;r<16;++r)negm[r]=-mhat; asm volatile("":"+v"(negm)); \
        const float f=__builtin_amdgcn_exp2f(-dl); l_reg*=f; if(hi==0)wsf[r32]=f; resc=true; } } \
    SBAR(); \
    GAPB(o[0]=__builtin_amdgcn_mfma_f32_32x32x16_bf16(PAF(0),VFR(0),o[0],0,0,0), C0,0); \
    GAPB(o[1]=__builtin_amdgcn_mfma_f32_32x32x16_bf16(PAF(0),VFR(4),o[1],0,0,0), C0,4); \
    KRD(GL,0); GAPB(o[0]=__builtin_amdgcn_mfma_f32_32x32x16_bf16(PAF(1),VFR(1),o[0],0,0,0), C0,8); \
    KRD(GL,1); GAPB(o[1]=__builtin_amdgcn_mfma_f32_32x32x16_bf16(PAF(1),VFR(5),o[1],0,0,0), C0,12); \
    KRD(GL,2); GAPB(o[0]=__builtin_amdgcn_mfma_f32_32x32x16_bf16(PAF(2),VFR(2),o[0],0,0,0), C1,0); \
    KRD(GL,3); GAPB(o[1]=__builtin_amdgcn_mfma_f32_32x32x16_bf16(PAF(2),VFR(6),o[1],0,0,0), C1,4); \
    GAPB(o[0]=__builtin_amdgcn_mfma_f32_32x32x16_bf16(PAF(3),VFR(3),o[0],0,0,0), C1,8); \
    GAPB(o[1]=__builtin_amdgcn_mfma_f32_32x32x16_bf16(PAF(3),VFR(7),o[1],0,0,0), C1,12); \
    }while(0)
  int t=1;
  #undef CMASK
  #define CMASK(P0,P1,t) do{}while(0)
  for(;t+5<NT;t+=2){
    STEP(pB0,pB1,pA0,pA1,t,true,true,true);     WAIT_BAR(2); RESC(); ROT();
    STEP(pA0,pA1,pB0,pB1,t+1,true,true,true);   WAIT_BAR(2); RESC(); ROT();
  }
  #undef CMASK
  #define CMASK(P0,P1,t) do{int jb_=(t)-(NT-4); if(jb_>=0)cmask(P0,P1,jb_,qrel,hi);}while(0)
  #define ENDW(tt) do{ if((tt)+3<NT){WAIT_BAR(2);} else if((tt)+2<NT){WAIT_BAR(1);} else {WAIT_BAR(0);} }while(0)
  for(;t+1<NT;t+=2){
    STEP(pB0,pB1,pA0,pA1,t,(t+3<NT),(t+1<NT),(t+1<NT));       ENDW(t);   RESC(); ROT();
    STEP(pA0,pA1,pB0,pB1,t+1,(t+4<NT),(t+2<NT),(t+2<NT));     ENDW(t+1); RESC(); ROT();
  }
  STEP(pB0,pB1,pA0,pA1,NT-1,false,false,false); RESC();
  { float sacc=pB0[0]+pB0[1]; _Pragma("unroll") for(int r=2;r<16;++r)sacc+=pB0[r]; _Pragma("unroll") for(int r=0;r<16;++r)sacc+=pB1[r]; l_reg+=sacc;
    pw0=(u32x4){PKW(pB0,0),PKW(pB0,2),PKW(pB0,4),PKW(pB0,6)};pw1=(u32x4){PKW(pB0,8),PKW(pB0,10),PKW(pB0,12),PKW(pB0,14)};pw2=(u32x4){PKW(pB1,0),PKW(pB1,2),PKW(pB1,4),PKW(pB1,6)};pw3=(u32x4){PKW(pB1,8),PKW(pB1,10),PKW(pB1,12),PKW(pB1,14)};
    SBAR(); pv(o,vb0+sl_cur,PAF(0),PAF(1),PAF(2),PAF(3)); }
  #undef PKW
  #undef PAF
  #undef VFR
  #undef PIN
  #undef MX3
  #undef GAPA
  #undef GAPB
  #undef EX
  #undef VRD
  #undef KRD
  #undef STEP
  #undef ENDW
  {auto rr=__builtin_amdgcn_permlane32_swap(__float_as_uint(l_reg),__float_as_uint(l_reg),false,false);l_reg=__uint_as_float(rr[0])+__uint_as_float(rr[1]);}
  if(hi==0)wsf[32+r32]=l_reg;asm volatile("s_waitcnt lgkmcnt(0)":::"memory");
  float rli[16];
  #pragma unroll
  for(int r=0;r<16;++r)rli[r]=__builtin_amdgcn_rcpf(wsf[32+crow(r,hi)]);
  bf16*Ow=O+(rowbase+q0+wid*QBLK)*PO;
  { bf16*stg=(bf16*)(shm+LDS_OST)+wid*2048;
    #pragma unroll
    for(int r=0;r<16;++r){const int orow=crow(r,hi);
      #pragma unroll
      for(int d0=0;d0<2;++d0)stg[orow*64+d0*32+r32]=__float2bfloat16(o[d0][r]*rli[r]);}
    asm volatile("s_waitcnt lgkmcnt(0)":::"memory");
    #pragma unroll
    for(int i=0;i<4;++i){const int row=i*8+(lane>>3),ch=lane&7; const u32x4 v=*(const u32x4*)(stg+row*64+ch*8); ATTN_STORE16(Ow+(long)row*PO+ch*8,v);} }
  asm volatile("s_waitcnt lgkmcnt(0)\n\ts_barrier":::"memory");
  #undef DMA_K
  #undef DMA_V
  #undef CMASK
  #undef START
  #undef RESC
  #undef ROT
}
constexpr int ATTN_LDS_BYTES=LDS_BYTES;
#undef SBAR
#undef WAIT_BAR
}
#include <hip/hip_cooperative_groups.h>
namespace cg = cooperative_groups;
namespace mk {
typedef unsigned short bf16_t;
typedef short bf16x8 __attribute__((ext_vector_type(8)));
typedef short s16x4 __attribute__((ext_vector_type(4)));
typedef float f32x4 __attribute__((ext_vector_type(4)));
typedef float f32x16 __attribute__((ext_vector_type(16)));
typedef unsigned u32x4 __attribute__((ext_vector_type(4)));
typedef unsigned u32x2 __attribute__((ext_vector_type(2)));
typedef float f32x2_t __attribute__((ext_vector_type(2))); typedef __bf16 bf16x2_t __attribute__((ext_vector_type(2)));
constexpr int T = 32768, S = 4096;
constexpr size_t TSQ = (size_t)T * 512;
constexpr size_t MiB = 1u << 20;
constexpr size_t WS_SSQ = 0, WS_DML = 4 * MiB, WS_W = 6 * MiB, WS_WL = 18 * MiB + MiB / 2, WS_WM = WS_W + 74 * MiB, WS_PB = 112 * MiB, WS_HB = 128 * MiB, WS_YMIX = 192 * MiB, WS_BIG = 256 * MiB, WS_O16 = WS_BIG + 192 * MiB, WS_END = 512 * MiB;
constexpr int LDS_BYTES = 147456;
constexpr float C2 = 0.125f * 1.4426950408889634f;
struct Params { const float* in[29]; float* out; unsigned char* ws; };

__device__ __forceinline__ unsigned pk2(float lo, float hi) { f32x2_t v = {lo, hi}; bf16x2_t b = __builtin_convertvector(v, bf16x2_t); return __builtin_bit_cast(unsigned, b); }
__device__ __forceinline__ float bflo(unsigned w) { return __uint_as_float(w << 16); }
__device__ __forceinline__ float bfhi(unsigned w) { return __uint_as_float(w & 0xffff0000u); }
__device__ __forceinline__ float bf1(bf16_t h) { return __uint_as_float((unsigned)h << 16); }
__device__ __forceinline__ float wave_sum(float v) {
v = xor_add<1>(v); v = xor_add<2>(v); v = xor_add<4>(v); v = xor_add<8>(v); v = xor_add<16>(v); v = xor_add<32>(v);
    return v;
}
#define WAVE_LDS_SYNC() asm volatile("s_waitcnt lgkmcnt(0)" ::: "memory")
__device__ __forceinline__ int crow(int r, int hi) { return (r & 3) + 8 * (r >> 2) + 4 * hi; }

__device__ __forceinline__ void transpose_items(const float* W, int K, int N, const float* gain, bf16_t* WT, float* scr, int gw, int ngw, int lane) {
    const int nblk = N / 32, nitems = (K / 64) * nblk;
    const int lr = lane >> 3, lc = (lane & 7) * 4;
    f32x4 r[8];
    int it = gw;
    if (it < nitems) { const int k0 = 64 * (it / nblk), n0 = 32 * (it % nblk);
#pragma unroll
        for (int i = 0; i < 8; ++i) r[i] = *(const f32x4*)(W + (size_t)(k0 + lr + 8 * i) * N + n0 + lc); }
    for (; it < nitems; it += ngw) {
        const int kb = it / nblk, nb = it % nblk, k0 = 64 * kb, n0 = 32 * nb;
#pragma unroll
        for (int i = 0; i < 8; ++i) { const int kk = lr + 8 * i; const float g = gain ? gain[k0 + kk] : 1.0f; float* d = scr + kk * 33 + lc;
            d[0] = r[i][0] * g; d[1] = r[i][1] * g; d[2] = r[i][2] * g; d[3] = r[i][3] * g; }
        WAVE_LDS_SYNC();
        const int itn = it + ngw;
        if (itn < nitems) { const int k1 = 64 * (itn / nblk), n1 = 32 * (itn % nblk);
#pragma unroll
            for (int i = 0; i < 8; ++i) r[i] = *(const f32x4*)(W + (size_t)(k1 + lr + 8 * i) * N + n1 + lc); }
        const int c = lane & 7;
#pragma unroll
        for (int j = 0; j < 4; ++j) { const int n = (lane >> 3) + 8 * j; const float* s = scr + (8 * c) * 33 + n;
            u32x4 o; o.x = pk2(s[0 * 33], s[1 * 33]); o.y = pk2(s[2 * 33], s[3 * 33]); o.z = pk2(s[4 * 33], s[5 * 33]); o.w = pk2(s[6 * 33], s[7 * 33]);
            *(u32x4*)(WT + (size_t)(n0 + n) * K + k0 + 8 * c) = o; }
        WAVE_LDS_SYNC();
    }
}
__device__ __forceinline__ void convert_p(const float* psrc, bf16_t* pb, int gtid, int nthr) {
    int i = gtid; f32x4 a = (f32x4){0.f, 0.f, 0.f, 0.f}, b = a;
    if (i < T * 256 / 8) { a = ((const f32x4*)psrc)[2 * i]; b = ((const f32x4*)psrc)[2 * i + 1]; }
    for (; i < T * 256 / 8; i += nthr) { const f32x4 ca = a, cb = b; const int in = i + nthr;
        if (in < T * 256 / 8) { a = ((const f32x4*)psrc)[2 * in]; b = ((const f32x4*)psrc)[2 * in + 1]; }
        u32x4 o; o.x = pk2(ca[0], ca[1]); o.y = pk2(ca[2], ca[3]); o.z = pk2(cb[0], cb[1]); o.w = pk2(cb[2], cb[3]); ((u32x4*)pb)[i] = o; }
}

template <int PASS> __device__ __forceinline__ void dil_unit(int u, int dilv, const bf16_t* proj, float* accst, float* mst, float* lst, bf16_t* ymix, short* vts, int lane) {
    const int r32 = lane & 31, hi = lane >> 5;
    const int LB = 128 / dilv, ql = u & 127, head = (u >> 7) & 7, b = u >> 10, r = ql / LB, qblk = ql % LB;
    const long rowq = (long)b * S + (long)(32 * qblk + r32) * dilv + r;
    const bf16_t* qp = proj + 3 * TSQ + rowq * 512 + head * 64 + 8 * hi;
    const int j0 = qblk < 4 ? 4 - qblk : 0;
    const float NEG = -1e30f;
#define DIL_ROW(j) ((long)b * S + (long)(32 * qblk - 128 + 32 * ((j) >= j0 ? (j) : j0) + r32) * dilv + r)
    bf16x8 qf[4], kn[4];
#pragma unroll
    for (int d0 = 0; d0 < 4; ++d0) qf[d0] = *(const bf16x8*)(qp + 16 * d0);
    { const bf16_t* kp = proj + 4 * TSQ + DIL_ROW(0) * 512 + head * 64 + 8 * hi;
#pragma unroll
        for (int d0 = 0; d0 < 4; ++d0) kn[d0] = *(const bf16x8*)(kp + 16 * d0); }
    const size_t sidx = (size_t)rowq * 8 + head;
    float m_old = NEG, l_old = 0.f;
    if (PASS > 0) { m_old = mst[sidx]; l_old = lst[sidx]; }
    f32x16 st[5]; float mt = NEG;
#pragma unroll
    for (int j = 0; j < 5; ++j) {
        bf16x8 kc[4];
#pragma unroll
        for (int d0 = 0; d0 < 4; ++d0) kc[d0] = kn[d0];
        if (j < 4) { const bf16_t* kp = proj + 4 * TSQ + DIL_ROW(j + 1) * 512 + head * 64 + 8 * hi;
#pragma unroll
            for (int d0 = 0; d0 < 4; ++d0) kn[d0] = *(const bf16x8*)(kp + 16 * d0); }
        if (j >= j0) {
            f32x16 a = f32x16{};
#pragma unroll
            for (int d0 = 0; d0 < 4; ++d0) a = __builtin_amdgcn_mfma_f32_32x32x16_bf16(kc[d0], qf[d0], a, 0, 0, 0);
            if (j == 0) {
#pragma unroll
                for (int i = 0; i < 16; ++i) if (crow(i, hi) < r32) a[i] = NEG; }
            if (j == 4) {
#pragma unroll
                for (int i = 0; i < 16; ++i) if (crow(i, hi) > r32) a[i] = NEG; }
#pragma unroll
            for (int i = 0; i < 16; ++i) mt = fmaxf(mt, a[i]);
            st[j] = a;
        } else st[j] = f32x16{};
    }
    bf16x8 vn[4];
    { const bf16_t* vp = proj + 5 * TSQ + DIL_ROW(0) * 512 + head * 64 + 8 * hi;
#pragma unroll
        for (int d0 = 0; d0 < 4; ++d0) vn[d0] = *(const bf16x8*)(vp + 16 * d0); }
    f32x16 O[2]; float* ap = accst + sidx * 64 + 4 * hi;
    if (PASS > 0) {
#pragma unroll
        for (int dt = 0; dt < 2; ++dt)
#pragma unroll
            for (int i4 = 0; i4 < 4; ++i4) { const f32x4 v = *(const f32x4*)(ap + 32 * dt + 8 * i4);
#pragma unroll
                for (int e = 0; e < 4; ++e) O[dt][4 * i4 + e] = v[e]; }
    } else { O[0] = f32x16{}; O[1] = f32x16{}; }
    mt = xor_max<32>(mt);
    const float m_new = fmaxf(m_old, mt), sc = __builtin_amdgcn_exp2f(m_old - m_new);
    float ls = 0.f;
#pragma unroll
    for (int j = 0; j < 5; ++j) if (j >= j0) {
#pragma unroll
        for (int i = 0; i < 16; ++i) { const float e = __builtin_amdgcn_exp2f(st[j][i] - m_new); st[j][i] = e; ls += e; } }
    ls = xor_add<32>(ls);
    const float l_new = l_old * sc + ls;
    if (PASS > 0) {
#pragma unroll
        for (int dt = 0; dt < 2; ++dt)
#pragma unroll
            for (int i = 0; i < 16; ++i) O[dt][i] *= sc; }
#pragma unroll
    for (int j = 0; j < 5; ++j) {
        bf16x8 vc[4];
#pragma unroll
        for (int d0 = 0; d0 < 4; ++d0) vc[d0] = vn[d0];
        if (j < 4) { const bf16_t* vp = proj + 5 * TSQ + DIL_ROW(j + 1) * 512 + head * 64 + 8 * hi;
#pragma unroll
            for (int d0 = 0; d0 < 4; ++d0) vn[d0] = *(const bf16x8*)(vp + 16 * d0); }
        if (j >= j0) {
#pragma unroll
            for (int d0 = 0; d0 < 4; ++d0) {
#pragma unroll
                for (int e = 0; e < 8; ++e) vts[(16 * d0 + 8 * hi + e) * 36 + r32] = vc[d0][e]; }
            WAVE_LDS_SYNC();
#pragma unroll
            for (int cc = 0; cc < 2; ++cc) {
                u32x4 pw; pw.x = pk2(st[j][8 * cc + 0], st[j][8 * cc + 1]); pw.y = pk2(st[j][8 * cc + 2], st[j][8 * cc + 3]); pw.z = pk2(st[j][8 * cc + 4], st[j][8 * cc + 5]); pw.w = pk2(st[j][8 * cc + 6], st[j][8 * cc + 7]);
                const bf16x8 pf = __builtin_bit_cast(bf16x8, pw);
#pragma unroll
                for (int dt = 0; dt < 2; ++dt) { const short* vr = vts + (r32 + 32 * dt) * 36 + 16 * cc + 4 * hi;
                    const s16x4 lo = *(const s16x4*)vr, h4 = *(const s16x4*)(vr + 8);
                    const bf16x8 vf = (bf16x8){lo[0], lo[1], lo[2], lo[3], h4[0], h4[1], h4[2], h4[3]};
                    O[dt] = __builtin_amdgcn_mfma_f32_32x32x16_bf16(vf, pf, O[dt], 0, 0, 0); }
            }
            WAVE_LDS_SYNC();
        }
    }
#undef DIL_ROW
    if (PASS < 2) {
#pragma unroll
        for (int dt = 0; dt < 2; ++dt)
#pragma unroll
            for (int i4 = 0; i4 < 4; ++i4) *(f32x4*)(ap + 32 * dt + 8 * i4) = (f32x4){O[dt][4 * i4], O[dt][4 * i4 + 1], O[dt][4 * i4 + 2], O[dt][4 * i4 + 3]};
        if (hi == 0) { mst[sidx] = m_new; lst[sidx] = l_new; }
    } else {
        const float inv = 1.0f / l_new; bf16_t* yp = ymix + (size_t)rowq * 1024 + 512 + head * 64 + 4 * hi;
#pragma unroll
        for (int dt = 0; dt < 2; ++dt)
#pragma unroll
            for (int i4 = 0; i4 < 4; ++i4) { u32x2 w; w.x = pk2(O[dt][4 * i4] * inv, O[dt][4 * i4 + 1] * inv); w.y = pk2(O[dt][4 * i4 + 2] * inv, O[dt][4 * i4 + 3] * inv); *(u32x2*)(yp + 32 * dt + 8 * i4) = w; }
    }
}
template <int PASS> __device__ __forceinline__ void dil_pass(int dilv, const bf16_t* proj, float* accst, float* mst, float* lst, bf16_t* ymix, unsigned char* lds, int wid, int lane, int gw, int ngw) {
    short* vts = (short*)(lds + wid * 4608);
    for (int u = gw; u < 8192; u += ngw) dil_unit<PASS>(u, dilv, proj, accst, mst, lst, ymix, vts, lane);
}

__device__ __forceinline__ void s5_coef(float lr, float li, float dt, float& ar, float& ai, float& cr, float& ci) {
    const float mag = expf(lr * dt); const float th = li * dt; const float kq = rintf(th * 0.15915494309189535f);
    float rr = fmaf(-kq, 6.2831854820251465f, th); rr = fmaf(-kq, -1.7484556000744883e-07f, rr);
    const float sn = __sinf(rr), cs = __cosf(rr); ar = mag * cs; ai = mag * sn;
    const float den = lr * lr + li * li, nr = ar - 1.f, ni = ai; cr = (nr * lr + ni * li) / den; ci = (ni * lr - nr * li) / den;
}
__device__ __forceinline__ float gelu_tanh(float x) { const float z = 1.5957691216057308f * (x + 0.044715f * x * x * x); return x * __builtin_amdgcn_rcpf(1.0f + __expf(-z)); }

}
#ifndef RP_ATTN
#define RP_ATTN 1
#define RP_DIL 1
#define RP_S5 1
#define RP_BAR 1
#define RP_UP 1
#define RP_PRO 1
#define RP_INP 1
#define RP_PP 1
#define RP_ELT 1
#define RP_OUT 1
#define RP_DOWN 1
#define RP_PLE 1
#define RP_GLU 1
#endif
namespace mk {
#define GAS __attribute__((address_space(1)))
struct DParams { GAS const float* in[29]; GAS float* out; GAS unsigned char* ws; };
typedef const __attribute__((address_space(4))) DParams* KArgs;
__device__ __forceinline__ void s5_phase(KArgs p, int o, const bf16_t* proj, bf16_t* yg, unsigned char* lds, int tid, int lane, int wid, int G, int bid) {
    constexpr int TC = 64, NCH = S / TC, BUP = 132, XP = 136;
    float* Bu = (float*)lds;
    bf16_t* Xs = (bf16_t*)(lds + 2 * TC * BUP * 4);
    const int r32 = lane & 31, hi = lane >> 5, l16 = lane & 15, kq = lane >> 4;
    for (int bg = bid; bg < 256; bg += G) {
        const int b = bg >> 5, g = bg & 31, og = o * 32 + g;
        const float* lam_re = (const float*)p->in[18] + og * 64; const float* lam_im = (const float*)p->in[19] + og * 64; const float dt = expf(p->in[20][og]);
        const float* b_re = (const float*)p->in[21] + (size_t)og * 1024; const float* b_im = (const float*)p->in[22] + (size_t)og * 1024;
        const float* c_re = (const float*)p->in[23] + (size_t)og * 1024; const float* c_im = (const float*)p->in[24] + (size_t)og * 1024; const float* dsk = (const float*)p->in[25] + og * 16;
        const bf16_t* ub = proj + (size_t)b * S * 2048 + g * 16;
        float ar = 0.f, ai = 0.f, xr = 0.f, xi = 0.f;
        bf16x8 Bf[4], Cf[4]; float dsc = 0.f;
        if (wid == 0) { float cr, ci; s5_coef(lam_re[lane], lam_im[lane], dt, ar, ai, cr, ci); }
        else {
#pragma unroll
            for (int nt = 0; nt < 4; ++nt) { const int pp = 16 * nt + (r32 >> 1); float a0, a1, cr, ci; s5_coef(lam_re[pp], lam_im[pp], dt, a0, a1, cr, ci);
                const f32x4 br0 = *(const f32x4*)(b_re + pp * 16 + 8 * hi), br1 = *(const f32x4*)(b_re + pp * 16 + 8 * hi + 4);
                const f32x4 bi0 = *(const f32x4*)(b_im + pp * 16 + 8 * hi), bi1 = *(const f32x4*)(b_im + pp * 16 + 8 * hi + 4);
                f32x4 v0, v1; if (r32 & 1) { v0 = cr * bi0 + ci * br0; v1 = cr * bi1 + ci * br1; } else { v0 = cr * br0 - ci * bi0; v1 = cr * br1 - ci * bi1; }
                u32x4 w; w.x = pk2(v0[0], v0[1]); w.y = pk2(v0[2], v0[3]); w.z = pk2(v1[0], v1[1]); w.w = pk2(v1[2], v1[3]); Bf[nt] = __builtin_bit_cast(bf16x8, w); }
#pragma unroll
            for (int ks = 0; ks < 4; ++ks) { const int p0 = 16 * ks + 4 * kq; const f32x4 cr4 = *(const f32x4*)(c_re + l16 * 64 + p0), ci4 = *(const f32x4*)(c_im + l16 * 64 + p0);
                u32x4 w; w.x = pk2(cr4[0], -ci4[0]); w.y = pk2(cr4[1], -ci4[1]); w.z = pk2(cr4[2], -ci4[2]); w.w = pk2(cr4[3], -ci4[3]); Cf[ks] = __builtin_bit_cast(bf16x8, w); }
            dsc = dsk[l16];
        }
#define S5_LDU(k, tt) (*(const bf16x8*)(ub + (size_t)(((k) < NCH ? (k) : NCH - 1) * TC + 32 * (tt) + r32) * 2048 + 8 * hi))
#define S5_BU(k) do { float* Bb = Bu + ((k) & 1) * TC * BUP; \
        { const int tile = wid - 1, tt = tile >> 2, nt = tile & 3; \
            const f32x16 a = __builtin_amdgcn_mfma_f32_32x32x16_bf16(ufa, nt == 0 ? Bf[0] : nt == 1 ? Bf[1] : nt == 2 ? Bf[2] : Bf[3], f32x16{}, 0, 0, 0); \
            _Pragma("unroll") for (int i = 0; i < 16; ++i) Bb[(32 * tt + crow(i, hi)) * BUP + 32 * nt + r32] = a[i]; } \
        if (wid == 1) { const f32x16 a = __builtin_amdgcn_mfma_f32_32x32x16_bf16(ufb, Bf[3], f32x16{}, 0, 0, 0); \
            _Pragma("unroll") for (int i = 0; i < 16; ++i) Bb[(32 + crow(i, hi)) * BUP + 96 + r32] = a[i]; } \
        ufa = S5_LDU((k) + 1, (wid - 1) >> 2); if (wid == 1) ufb = S5_LDU((k) + 1, 1); } while (0)
#define S5_LDUU(k) do { if (wid <= 4) { _Pragma("unroll") for (int j = 0; j < 4; ++j) uun[j] = proj[((size_t)b * S + ((k) < NCH ? (k) : NCH - 1) * TC + 16 * (wid - 1) + 4 * kq + j) * 2048 + g * 16 + l16]; } } while (0)
#define S5_CP(k) do { const bf16_t* Xb = Xs + ((k) & 1) * TC * XP; \
        if (wid <= 4) { const int tile = wid - 1; f32x4 a = (f32x4){0.f, 0.f, 0.f, 0.f}; \
            _Pragma("unroll") for (int ks = 0; ks < 4; ++ks) { const bf16x8 xf = *(const bf16x8*)(Xb + (16 * tile + l16) * XP + 32 * ks + 8 * kq); \
                a = __builtin_amdgcn_mfma_f32_16x16x32_bf16(xf, Cf[ks], a, 0, 0, 0); } \
            _Pragma("unroll") for (int j = 0; j < 4; ++j) { const size_t tok = (size_t)b * S + (k) * TC + 16 * tile + 4 * kq + j; \
                const float y = gelu_tanh(a[j] + dsc * bf1(uun[j])); \
                yg[tok * 512 + g * 16 + l16] = (bf16_t)(pk2(y, 0.f) & 0xffffu); } } \
        S5_LDUU((k) + 1); } while (0)
        bf16x8 ufa = bf16x8{}, ufb = bf16x8{}; bf16_t uun[4] = {0, 0, 0, 0};
        if (wid > 0) { ufa = S5_LDU(0, (wid - 1) >> 2); if (wid == 1) ufb = S5_LDU(0, 1); S5_LDUU(0); S5_BU(0); }
        __syncthreads();
        for (int k = 0; k < NCH; ++k) {
            if (wid == 0) {
                const float* Bb = Bu + (k & 1) * TC * BUP; bf16_t* Xb = Xs + (k & 1) * TC * XP;
                for (int t0 = 0; t0 < TC; t0 += 16) { f32x2_t bv[16];
#pragma unroll
                    for (int j = 0; j < 16; ++j) bv[j] = *(const f32x2_t*)(Bb + (t0 + j) * BUP + 2 * lane);
#pragma unroll
                    for (int j = 0; j < 16; ++j) { const float nr = fmaf(ar, xr, fmaf(-ai, xi, bv[j].x)), ni = fmaf(ar, xi, fmaf(ai, xr, bv[j].y)); xr = nr; xi = ni;
                        *(unsigned*)(Xb + (t0 + j) * XP + 2 * lane) = pk2(xr, xi); } }
            } else {
                if (k + 1 < NCH) S5_BU(k + 1);
                if (k >= 1) S5_CP(k - 1);
            }
            __syncthreads();
        }
        if (wid > 0) S5_CP(NCH - 1);
        __syncthreads();
#undef S5_BU
#undef S5_LDU
#undef S5_LDUU
#undef S5_CP
    }
}
__device__ __forceinline__ void conv_phase(const float* cw, const bf16_t* proj, bf16_t* ymix, int gtid, int nthr) {
    for (int idx = gtid; idx < T * 64; idx += nthr) { const int t = idx >> 6, c8 = (idx & 63) * 8, s = t & (S - 1);
        const bf16_t* row = proj + (size_t)t * 2048;
        float y[8];
#pragma unroll
        for (int e = 0; e < 8; ++e) y[e] = 0.f;
#pragma unroll
        for (int j = 0; j < 3; ++j) if (s - j >= 0) { const u32x4 gc = *(const u32x4*)(row - (size_t)j * 2048 + 1024 + c8), xt = *(const u32x4*)(row - (size_t)j * 2048 + 1536 + c8);
            const f32x4 w0 = *(const f32x4*)(cw + j * 512 + c8), w1 = *(const f32x4*)(cw + j * 512 + c8 + 4);
            y[0] += w0[0] * bflo(gc.x) * bflo(xt.x); y[1] += w0[1] * bfhi(gc.x) * bfhi(xt.x); y[2] += w0[2] * bflo(gc.y) * bflo(xt.y); y[3] += w0[3] * bfhi(gc.y) * bfhi(xt.y);
            y[4] += w1[0] * bflo(gc.z) * bflo(xt.z); y[5] += w1[1] * bfhi(gc.z) * bfhi(xt.z); y[6] += w1[2] * bflo(gc.w) * bflo(xt.w); y[7] += w1[3] * bfhi(gc.w) * bfhi(xt.w); }
        const u32x4 gb = *(const u32x4*)(row + 512 + c8); u32x4 o;
        o.x = pk2(y[0] * bflo(gb.x), y[1] * bfhi(gb.x)); o.y = pk2(y[2] * bflo(gb.y), y[3] * bfhi(gb.y)); o.z = pk2(y[4] * bflo(gb.z), y[5] * bfhi(gb.z)); o.w = pk2(y[6] * bflo(gb.w), y[7] * bfhi(gb.w));
        *(u32x4*)(ymix + (size_t)t * 1024 + 512 + c8) = o; }
}
__device__ __forceinline__ void diff_post(KArgs p, int e, float lam_init, const bf16_t* O16, bf16_t* ymix, int lane, int gtid, int nthr) {
    float a = p->in[11][e * 64 + lane] * p->in[12][e * 64 + lane], bb = p->in[13][e * 64 + lane] * p->in[14][e * 64 + lane];
    a = wave_sum(a); bb = wave_sum(bb);
    const float lam = expf(a) - expf(bb) + lam_init; const float* gain = (const float*)p->in[15] + e * 128;
    const int j = gtid & 15, vhalf = j >> 3, dd = (j & 7) * 8;
    const f32x4 g0 = *(const f32x4*)(gain + 8 * j), g1 = *(const f32x4*)(gain + 8 * j + 4);
    for (int grp = gtid >> 4; grp < T * 4; grp += nthr >> 4) { const int t = grp >> 2, h = grp & 3;
        const u32x4 o1 = *(const u32x4*)(O16 + (size_t)t * 1024 + ((h * 2 + 0) * 2 + vhalf) * 64 + dd), o2 = *(const u32x4*)(O16 + (size_t)t * 1024 + ((h * 2 + 1) * 2 + vhalf) * 64 + dd);
        float v[8];
        v[0] = bflo(o1.x) - lam * bflo(o2.x); v[1] = bfhi(o1.x) - lam * bfhi(o2.x); v[2] = bflo(o1.y) - lam * bflo(o2.y); v[3] = bfhi(o1.y) - lam * bfhi(o2.y);
        v[4] = bflo(o1.z) - lam * bflo(o2.z); v[5] = bfhi(o1.z) - lam * bfhi(o2.z); v[6] = bflo(o1.w) - lam * bflo(o2.w); v[7] = bfhi(o1.w) - lam * bfhi(o2.w);
        float ss = 0.f;
#pragma unroll
        for (int q = 0; q < 8; ++q) ss += v[q] * v[q];
        ss = xor_add<1>(ss); ss = xor_add<2>(ss); ss = xor_add<4>(ss); ss = xor_add<8>(ss);
        const float rs = rsqrtf(ss * (1.0f / 128.0f) + 1e-5f) * (1.0f - lam_init);
        u32x4 o; o.x = pk2(v[0] * rs * g0[0], v[1] * rs * g0[1]); o.y = pk2(v[2] * rs * g0[2], v[3] * rs * g0[3]); o.z = pk2(v[4] * rs * g1[0], v[5] * rs * g1[1]); o.w = pk2(v[6] * rs * g1[2], v[7] * rs * g1[3]);
        *(u32x4*)(ymix + (size_t)t * 1024 + h * 128 + 8 * j) = o; }
}

__device__ __forceinline__ KArgs kargs() { KArgs k = (KArgs)__builtin_amdgcn_kernarg_segment_ptr(); asm volatile("" : "+s"(k)); return k; }
constexpr size_t WS_BAR = WS_WM + 8 * MiB + 6 * MiB + MiB / 2;
constexpr int LDS_XB = 131072 + 1024;
#define LAS __attribute__((address_space(3)))
#define XB_TMO      128
#define XB_XCNT(j)  (256  + 64 * (j))
#define XB_XSUB(j)  (1280 + 64 * (j))
#define XB_XGEN(j)  (2304 + 64 * (j))
#define XB_TOP      3328
#define XB_TOPGEN   3392
#define XCD_BAR_WORDS 3456
#define XB_SPIN_CAP (1u << 18)

__device__ __forceinline__ unsigned xb_ld(unsigned* p)              { return __hip_atomic_load(p, __ATOMIC_RELAXED, __HIP_MEMORY_SCOPE_AGENT); }
__device__ __forceinline__ unsigned xb_add(unsigned* p, unsigned v) { return __hip_atomic_fetch_add(p, v, __ATOMIC_RELAXED, __HIP_MEMORY_SCOPE_AGENT); }
__device__ __forceinline__ unsigned xb_xcc_id() { return (unsigned)__builtin_amdgcn_s_getreg((3 << 11) | 20) & 0xFu; }
#define XB_SPIN(cond, bar) do { unsigned _sp = 0; while (cond) { __builtin_amdgcn_s_sleep(1); \
    if ((++_sp & 255u) == 0u) { if (xb_ld(&(bar)[XB_TMO])) break; if (_sp > XB_SPIN_CAP) { atomicAdd(&(bar)[XB_TMO], 1u); break; } } } } while (0)

struct XcdBarrier {
    unsigned* bar; unsigned x;
    volatile LAS unsigned* st;
};

__device__ __forceinline__ XcdBarrier xcd_barrier_post(unsigned* bar, volatile LAS unsigned* st) {
    XcdBarrier b; b.bar = bar; b.x = xb_xcc_id(); b.st = st;
    if (threadIdx.x == 0) (void)xb_add(&bar[XB_XCNT(b.x)], 1u);
    return b;
}
__device__ __forceinline__ void xcd_barrier_complete(unsigned* bar, unsigned x, unsigned& nloc, unsigned& nx) {
    const unsigned G = gridDim.x * gridDim.y * gridDim.z;
    unsigned sum, cnt, mine, sp = 0u;
    for (;;) {
        sum = 0u; cnt = 0u; mine = 0u;
#pragma unroll
        for (unsigned j = 0; j < 16; ++j) { const unsigned c = xb_ld(&bar[XB_XCNT(j)]); sum += c; cnt += (c > 0u) ? 1u : 0u; mine = (j == x) ? c : mine; }
        if (sum == G) break;
        __builtin_amdgcn_s_sleep(1);
        if ((++sp & 255u) == 0u) { if (xb_ld(&bar[XB_TMO])) break; if (sp > XB_SPIN_CAP) { atomicAdd(&bar[XB_TMO], 1u); break; } }
    }
    nloc = mine > 0u ? mine : 1u; nx = cnt > 0u ? cnt : 1u;
}

__device__ __forceinline__ void xcd_barrier(const XcdBarrier& b) {
    asm volatile("s_waitcnt vmcnt(0)" ::: "memory");
    __syncthreads();
    if (threadIdx.x == 0) {
        unsigned* bar = b.bar;
        __builtin_amdgcn_s_waitcnt(0);
        unsigned nloc = b.st[0], nx = b.st[1];
        if (nloc == 0u) { xcd_barrier_complete(bar, b.x, nloc, nx); b.st[0] = nloc; b.st[1] = nx; }
        const unsigned old = xb_add(&bar[XB_XSUB(b.x)], 1u);
        const unsigned gen = old / nloc;
        if (old + 1u == (gen + 1u) * nloc) {
            __builtin_amdgcn_fence(__ATOMIC_RELEASE, "agent");
            asm volatile("s_waitcnt vmcnt(0)" ::: "memory");
            const unsigned og = xb_add(&bar[XB_TOP], 1u);
            const unsigned tg = og / nx;
            if (og + 1u == (tg + 1u) * nx) xb_add(&bar[XB_TOPGEN], 1u);
            else XB_SPIN(xb_ld(&bar[XB_TOPGEN]) == tg, bar);
            __builtin_amdgcn_fence(__ATOMIC_ACQUIRE, "agent");
            xb_add(&bar[XB_XGEN(b.x)], 1u);
            asm volatile("s_waitcnt vmcnt(0)" ::: "memory");
        } else {
            XB_SPIN(xb_ld(&bar[XB_XGEN(b.x)]) == gen, bar);
            __builtin_amdgcn_fence(__ATOMIC_ACQUIRE, "agent");
            asm volatile("s_waitcnt vmcnt(0)" ::: "memory");
        }
    }
    __syncthreads();
}

__device__ __forceinline__ void grid_bar1(unsigned) {
    XcdBarrier xbv; xbv.bar = (unsigned*)((unsigned char*)kargs()->ws + WS_BAR); xbv.x = xb_xcc_id(); xbv.st = (volatile LAS unsigned*)(LDS_XB);
    xcd_barrier(xbv);
}
__device__ __forceinline__ void grid_bar(unsigned epoch) { for (int rp = 0; rp < RP_BAR; ++rp) grid_bar1(epoch); }
#define PH_BEGIN KArgs ka = kargs(); unsigned char* ws = (unsigned char*)ka->ws; int tid = threadIdx.x; asm volatile("" : "+v"(tid)); int bid = blockIdx.x; asm volatile("" : "+s"(bid)); const int lane = tid & 63, wid = __builtin_amdgcn_readfirstlane(tid >> 6), G = gridDim.x; \
    const int gw = bid * 8 + wid, ngw = G * 8, gtid = bid * 512 + tid, nthr = G * 512; (void)lane; (void)gw; (void)ngw; (void)gtid; (void)nthr; (void)ws;
#define WL(i) (ws + WS_W + (size_t)(i) * WS_WL)
#define WM(i) (ws + WS_WM + (size_t)(i) * 8 * MiB)
#define SBUF(j) ((bf16_t*)ka->out + (size_t)((j) & 1) * T * 1024)
#define SSQ(k) ((float*)(ws + WS_SSQ + (size_t)((k) & 1) * 2 * MiB))
template <int i> __device__ __forceinline__ void layer_body(unsigned char* lds, PG8_LAS unsigned char* ldsp) {
    unsigned ep = (i == 0 ? 0u : i == 1 ? 8u : i == 2 ? 15u : 23u);
        for (int rp = 0; rp < RP_INP; ++rp) { PH_BEGIN const bool odd = (i & 1) != 0; const int N = odd ? 2048 : 3072;
            pg8::Gemm g{SBUF(i), (const bf16_t*)WM(i), T, N, 1024};     pg8::StaticOrder SO; SO.init(T, N, G, bid);
            pg8::EpiRow<0> E{(bf16_t*)(ws + WS_BIG), odd ? 2048 : 512, SSQ(3 * i), odd ? 0u : 0xC3u, C2, odd ? 0 : 512, TSQ};
            pg8::gemm_phase<pg8::EpiRow<0>, pg8::StaticOrder, true, true>(ldsp, g, SO, E); }
        grid_bar(++ep);
        if ((i & 1) == 0) {
            { PH_BEGIN const int vcu0 = (G % 8 == 0) ? (bid % 8) * (G / 8) + (bid / 8) : bid;
                for (int rp = 0; rp < RP_ATTN; ++rp) for (int vcu = vcu0; vcu < 256; vcu += G) { const int pair = vcu >> 1, s = vcu & 1, b = pair >> 4, vh = pair & 15, h = vh >> 2, c = (vh >> 1) & 1, vhalf = vh & 1;
                    for (int it = 0; it < 8; ++it) { const int j = s + 2 * (it >> 1), qb = (it & 1) ? 15 - j : j;
                        const attn_body::bf16* P = (const attn_body::bf16*)((unsigned char*)kargs()->ws + WS_BIG);
                        attn_body::attn_unit<8>(b, 0, qb, P + h * 128 + c * 64, P + TSQ + h * 128 + c * 64, P + 2 * TSQ + h * 128 + vhalf * 64, (attn_body::bf16*)((unsigned char*)kargs()->ws + WS_O16) + vh * 64, (char*)lds); } } }
            __syncthreads();
            { PH_BEGIN float* dm = (float*)(ws + WS_DML);
                for (int rp = 0; rp < RP_DIL; ++rp) dil_pass<0>(1, (const bf16_t*)(ws + WS_BIG), (float*)(ws + WS_HB), dm, dm + (size_t)T * 8, (bf16_t*)(ws + WS_YMIX), lds, wid, lane, gw, ngw);
                convert_p((const float*)ka->in[1] + (size_t)i * T * 256, (bf16_t*)(ws + WS_PB), gtid, nthr); }
            grid_bar(++ep);
            { PH_BEGIN float* dm = (float*)(ws + WS_DML);
                dil_pass<1>(4, (const bf16_t*)(ws + WS_BIG), (float*)(ws + WS_HB), dm, dm + (size_t)T * 8, (bf16_t*)(ws + WS_YMIX), lds, wid, lane, gw, ngw); }
            grid_bar(++ep);
            { PH_BEGIN float* dm = (float*)(ws + WS_DML);
                dil_pass<2>(16, (const bf16_t*)(ws + WS_BIG), (float*)(ws + WS_HB), dm, dm + (size_t)T * 8, (bf16_t*)(ws + WS_YMIX), lds, wid, lane, gw, ngw); }
            { PH_BEGIN const float lam_init = 0.8f - 0.6f * expf(-0.3f * (float)i);
                for (int rp = 0; rp < RP_ELT; ++rp) diff_post(ka, i >> 1, lam_init, (const bf16_t*)(ws + WS_O16), (bf16_t*)(ws + WS_YMIX), lane, gtid, nthr); }
            grid_bar(++ep);
        } else {
            for (int rp = 0; rp < RP_S5; ++rp) { PH_BEGIN s5_phase(ka, i >> 1, (const bf16_t*)(ws + WS_BIG), (bf16_t*)(ws + WS_HB), lds, tid, lane, wid, G, bid); }
            for (int rp = 0; rp < RP_ELT; ++rp) { PH_BEGIN conv_phase((const float*)ka->in[27] + (i >> 1) * 3 * 512, (const bf16_t*)(ws + WS_BIG), (bf16_t*)(ws + WS_YMIX), gtid, nthr);
                convert_p((const float*)ka->in[1] + (size_t)i * T * 256, (bf16_t*)(ws + WS_PB), gtid, nthr); }
            grid_bar(++ep);
            for (int rp = 0; rp < RP_GLU; ++rp) { PH_BEGIN pg8::Gemm g{(const bf16_t*)(ws + WS_HB), (const bf16_t*)(WM(i) + 6 * MiB), T, 512, 512}; pg8::StaticOrder SO; SO.init(T, 512, G, bid);
                pg8::EpiGlu E{(bf16_t*)(ws + WS_YMIX), (const bf16_t*)(ws + WS_HB)};
                pg8::gemm_phase<pg8::EpiGlu, pg8::StaticOrder, true, true>(ldsp, g, SO, E); }
            grid_bar(++ep);
        }
        for (int rp = 0; rp < RP_OUT; ++rp) { PH_BEGIN const bool odd = (i & 1) != 0;
            pg8::Gemm g{(const bf16_t*)(ws + WS_YMIX), (const bf16_t*)(WM(i) + (odd ? 4 : 6) * MiB), T, 1024, 1024}; pg8::StaticOrder SO; SO.init(T, 1024, G, bid);
            pg8::EpiRes<0> E{SBUF(i), (rp < RP_OUT - 1) ? (bf16_t*)(ws + WS_HB) : SBUF(i), SSQ(3 * i + 1), nullptr, nullptr};
            pg8::gemm_phase<pg8::EpiRes<0>, pg8::StaticOrder, true, true>(ldsp, g, SO, E); }
        grid_bar(++ep);
        for (int rp = 0; rp < RP_UP; ++rp) { PH_BEGIN pg8::Gemm g{SBUF(i), (const bf16_t*)WL(i), T, 4096, 1024}; pg8::StaticOrder SO; SO.init(T, 4096, G, bid);
            pg8::EpiRow<1> E{(bf16_t*)(ws + WS_BIG), 4096, SSQ(3 * i + 1), 0u, 1.f, 0, 0};
            pg8::gemm_phase<pg8::EpiRow<1>, pg8::StaticOrder, true, true>(ldsp, g, SO, E); }
        for (int rp = 0; rp < RP_PP; ++rp) { PH_BEGIN pg8::Gemm g{(const bf16_t*)(ws + WS_PB), (const bf16_t*)(WL(i) + 18 * MiB), T, 1024, 256}; pg8::StaticOrder SO; SO.init(T, 1024, G, bid);
            pg8::EpiPP E{(bf16_t*)(ws + WS_YMIX)};
            pg8::gemm_phase<pg8::EpiPP, pg8::StaticOrder, true, true>(ldsp, g, SO, E); }
        grid_bar(++ep);
        for (int rp = 0; rp < RP_DOWN; ++rp) { PH_BEGIN pg8::Gemm g{(const bf16_t*)(ws + WS_BIG), (const bf16_t*)(WL(i) + 8 * MiB), T, 1024, 4096}; pg8::StaticOrder SO; SO.init(T, 1024, G, bid);
            pg8::EpiRes<0> E{SBUF(i), (rp < RP_DOWN - 1) ? (bf16_t*)(ws + WS_HB) : SBUF(i), SSQ(3 * i + 2), nullptr, nullptr};
            pg8::gemm_phase<pg8::EpiRes<0>, pg8::StaticOrder, true, true>(ldsp, g, SO, E); }
        grid_bar(++ep);
        for (int rp = 0; rp < RP_PLE; ++rp) { PH_BEGIN pg8::Gemm g{SBUF(i), (const bf16_t*)(WL(i) + 16 * MiB), T, 1024, 1024}; pg8::StaticOrder SO; SO.init(T, 1024, G, bid);
            pg8::EpiRes<1> E{SBUF(i), (rp < RP_PLE - 1) ? (bf16_t*)(ws + WS_BIG) : (i == 3) ? (bf16_t*)(ws + WS_HB) : SBUF(i + 1), SSQ(3 * i + 3), SSQ(3 * i + 2), (const bf16_t*)(ws + WS_YMIX)};
            pg8::gemm_phase<pg8::EpiRes<1>, pg8::StaticOrder, true, true>(ldsp, g, SO, E); }
        grid_bar(++ep);
}
__global__ void __launch_bounds__(512, 2) fwd(Params p_unused) {
    extern __shared__ __attribute__((aligned(16))) unsigned char lds[];
    PG8_LAS unsigned char* ldsp = (PG8_LAS unsigned char*)lds;
    for (int rp = 0; rp < RP_PRO; ++rp) {
    { PH_BEGIN
        float* ssq = SSQ(0); bf16_t* hb = SBUF(0); const float* x = (const float*)ka->in[0];
        { f32x4 vn[4]; int m = gw;
            if (m < T) { const f32x4* xr = (const f32x4*)(x + (size_t)m * 1024) + lane;
#pragma unroll
                for (int j = 0; j < 4; ++j) vn[j] = xr[64 * j]; }
            for (; m < T; m += ngw) { f32x4 v[4]; float s = 0.f;
#pragma unroll
                for (int j = 0; j < 4; ++j) v[j] = vn[j];
                if (m + ngw < T) { const f32x4* xn = (const f32x4*)(x + (size_t)(m + ngw) * 1024) + lane;
#pragma unroll
                    for (int j = 0; j < 4; ++j) vn[j] = xn[64 * j]; }
#pragma unroll
                for (int j = 0; j < 4; ++j) s += (v[j][0] * v[j][0] + v[j][1] * v[j][1]) + (v[j][2] * v[j][2] + v[j][3] * v[j][3]);
                s = wave_sum(s); if (lane < 16) ssq[(size_t)m * 16 + lane] = (lane == 0) ? s : 0.f;
                u32x2* o8 = (u32x2*)(hb + (size_t)m * 1024) + lane;
#pragma unroll
                for (int j = 0; j < 4; ++j) { u32x2 w; w.x = pk2(v[j][0], v[j][1]); w.y = pk2(v[j][2], v[j][3]); o8[64 * j] = w; } } } }
    for (int i = 0; i < 4; ++i) { PH_BEGIN
        float* scr = (float*)(lds + wid * 8448); unsigned char* wl = WL(i); unsigned char* wm = WM(i); const int e = i >> 1;
        transpose_items((const float*)ka->in[5] + (size_t)i * 1024 * 4096, 1024, 4096, (const float*)ka->in[3] + i * 1024, (bf16_t*)wl, scr, gw, ngw, lane);
        transpose_items((const float*)ka->in[6] + (size_t)i * 1024 * 4096, 4096, 1024, nullptr, (bf16_t*)(wl + 8 * MiB), scr, gw, ngw, lane);
        transpose_items((const float*)ka->in[8] + (size_t)i * 1024 * 1024, 1024, 1024, (const float*)ka->in[4] + i * 1024, (bf16_t*)(wl + 16 * MiB), scr, gw, ngw, lane);
        transpose_items((const float*)ka->in[7] + (size_t)i * 256 * 1024, 256, 1024, nullptr, (bf16_t*)(wl + 18 * MiB), scr, gw, ngw, lane);
        if ((i & 1) == 0) {
            transpose_items((const float*)ka->in[9] + (size_t)e * 1024 * 3072, 1024, 3072, (const float*)ka->in[2] + i * 1024, (bf16_t*)wm, scr, gw, ngw, lane);
            transpose_items((const float*)ka->in[10] + (size_t)e * 1024 * 1024, 1024, 1024, nullptr, (bf16_t*)(wm + 6 * MiB), scr, gw, ngw, lane);
        } else {
            transpose_items((const float*)ka->in[16] + (size_t)e * 1024 * 2048, 1024, 2048, (const float*)ka->in[2] + i * 1024, (bf16_t*)wm, scr, gw, ngw, lane);
            transpose_items((const float*)ka->in[17] + (size_t)e * 1024 * 1024, 1024, 1024, nullptr, (bf16_t*)(wm + 4 * MiB), scr, gw, ngw, lane);
            transpose_items((const float*)ka->in[26] + (size_t)e * 512 * 512, 512, 512, nullptr, (bf16_t*)(wm + 6 * MiB), scr, gw, ngw, lane);
        } }
    }
    { KArgs ka0 = kargs(); unsigned* bw = (unsigned*)((unsigned char*)ka0->ws + WS_BAR);
        if (blockIdx.x == 0) for (int w = threadIdx.x; w < XCD_BAR_WORDS; w += 512) __hip_atomic_store(bw + w, 0u, __ATOMIC_RELAXED, __HIP_MEMORY_SCOPE_AGENT);
        if (threadIdx.x < 2) ((volatile LAS unsigned*)(LDS_XB))[threadIdx.x] = 0u; }
    cg::this_grid().sync();
    { KArgs ka0 = kargs(); (void)xcd_barrier_post((unsigned*)((unsigned char*)ka0->ws + WS_BAR), (volatile LAS unsigned*)(LDS_XB)); }
    layer_body<0>(lds, ldsp); layer_body<1>(lds, ldsp); layer_body<2>(lds, ldsp); layer_body<3>(lds, ldsp);
    { PH_BEGIN const float* gf = (const float*)ka->in[28]; const float* sq = SSQ(12); float* hf = (float*)ka->out; const bf16_t* hs = (const bf16_t*)(ws + WS_HB);
        for (int m = gw; m < T; m += ngw) { f32x4* xr = (f32x4*)(hf + (size_t)m * 1024) + lane; const u32x2* hr = (const u32x2*)(hs + (size_t)m * 1024) + lane; const float rs = rsqrtf(pg8::ssq16(sq, m) * (1.0f / 1024.0f) + 1e-6f);
#pragma unroll
            for (int j = 0; j < 4; ++j) { const f32x4 gv = ((const f32x4*)gf)[lane + 64 * j]; const u32x2 hv = hr[64 * j]; xr[64 * j] = (f32x4){bflo(hv.x), bfhi(hv.x), bflo(hv.y), bfhi(hv.y)} * rs * gv; } } }
}
}

extern "C" void kernel_launch(void* const* d_in, const int* in_sizes, int n_in, void* d_out, int out_size, void* d_ws, size_t ws_size, hipStream_t stream) {
    static int grid_blocks = 0;
    if (!grid_blocks) {
        int dev = 0, cus = 0, per_cu = 0;
        (void)hipGetDevice(&dev);
        (void)hipDeviceGetAttribute(&cus, hipDeviceAttributeMultiprocessorCount, dev);
        (void)hipFuncSetAttribute((const void*)mk::fwd, hipFuncAttributeMaxDynamicSharedMemorySize, mk::LDS_BYTES);
        (void)hipOccupancyMaxActiveBlocksPerMultiprocessor(&per_cu, (const void*)mk::fwd, 512, mk::LDS_BYTES);
        (void)hipGetLastError();
        grid_blocks = cus > 0 ? cus : 256;
        if (ws_size < mk::WS_END || n_in != 29) { fprintf(stderr, "kernel_launch: workspace %zu < %zu or n_in %d != 29\n", ws_size, (size_t)mk::WS_END, n_in); }
    }
    (void)hipMemsetAsync((unsigned char*)d_ws + mk::WS_BAR, 0, 256, stream);
    mk::Params p{};
    for (int i = 0; i < 29; ++i) p.in[i] = (const float*)d_in[i];
    p.out = (float*)d_out; p.ws = (unsigned char*)d_ws;
    void* args[] = {&p};
    hipError_t e = hipLaunchCooperativeKernel((const void*)mk::fwd, dim3(grid_blocks), dim3(512), args, mk::LDS_BYTES, stream);
    if (e != hipSuccess) fprintf(stderr, "cooperative launch failed: %s (grid %d)\n", hipGetErrorString(e), grid_blocks);
}
```

```cpp
#include <hip/hip_runtime.h>
#include <cstdio>
#include <cstdint>

template <int K> __device__ __forceinline__ float xor_add(float v) {
    if constexpr (K < 32) return v + __int_as_float(__builtin_amdgcn_ds_swizzle(__float_as_int(v), (K << 10) | 0x1f));
    else { auto rr = __builtin_amdgcn_permlane32_swap(__float_as_uint(v), __float_as_uint(v), false, false); return __uint_as_float(rr[0]) + __uint_as_float(rr[1]); }
}
template <int K> __device__ __forceinline__ float xor_max(float v) {
    if constexpr (K < 32) return fmaxf(v, __int_as_float(__builtin_amdgcn_ds_swizzle(__float_as_int(v), (K << 10) | 0x1f)));
    else { auto rr = __builtin_amdgcn_permlane32_swap(__float_as_uint(v), __float_as_uint(v), false, false); return fmaxf(__uint_as_float(rr[0]), __uint_as_float(rr[1])); }
}
namespace pg8 {
#define PG8_LAS __attribute__((address_space(3)))
typedef unsigned short bf16_t;
typedef short bf16x8 __attribute__((ext_vector_type(8)));
typedef float f32x4 __attribute__((ext_vector_type(4)));
typedef unsigned u32x4 __attribute__((ext_vector_type(4)));
constexpr int BM = 256, BK = 64, HALF = 128, HTB = HALF * BK * 2  , STAGE_BYTES = 8 * HTB, NXCD = 8, WGM = 8;

__host__ __device__ __forceinline__ int lds_byte(int r, int c) { const int st = (r >> 4) * 2 + (c >> 5), rr = r & 15, cc = c & 31, ob = rr * 64 + cc * 2; return st * 1024 + (ob ^ (((ob >> 9) & 1) << 5)); }
__host__ __device__ __forceinline__ void stage_rc(int b, int& R, int& C) { const int st = b / 1024, sb = b % 1024, swz = sb ^ (((sb >> 9) & 1) << 5); R = (st >> 1) * 16 + swz / 64; C = (st & 1) * 32 + (swz % 64) / 2; }
__host__ __device__ __forceinline__ int perm32(int rho) { const int n = rho >> 4, i = rho & 15; return 8 * (i >> 2) + 4 * n + (i & 3); }

struct Unit { int pm, pn; };
struct Gemm { const bf16_t* A; const bf16_t* Bt; int M, N, K; };

struct StaticOrder {
    int nM, nN, nwg, G, c;
    __host__ __device__ void init(int M, int N, int G_, int c_) { nM = M / BM; nN = N / BM; nwg = nM * nN; G = G_; c = c_; }
    __host__ __device__ bool next(int i, Unit& u) const {
        const long L = (long)i * G + c; if (L >= nwg) return false;
        int wgid = (int)L; { const int q = nwg / NXCD, r = nwg % NXCD, xcd = wgid % NXCD, off = wgid / NXCD; wgid = (xcd < r ? xcd * (q + 1) : r * (q + 1) + (xcd - r) * q) + off; }
        const int nig = WGM * nN, gid = wgid / nig, fm = gid * WGM, gsz = (nM - fm) < WGM ? (nM - fm) : WGM;
        u.pm = fm + ((wgid % nig) % gsz); u.pn = (wgid % nig) / gsz; return true;
    }
    __device__ __forceinline__ void a_ready(const Unit&) const {}
    __device__ __forceinline__ void done(const Unit&) const {}
};

__device__ __forceinline__ unsigned cvt_pk_bf16(float lo, float hi) { unsigned r; asm volatile("v_cvt_pk_bf16_f32 %0, %1, %2" : "=v"(r) : "v"(lo), "v"(hi)); return r; }
typedef float f32x2 __attribute__((ext_vector_type(2)));
constexpr float RMS_EPS = 1e-6f;
typedef unsigned u32x2 __attribute__((ext_vector_type(2)));
__device__ __forceinline__ float sigm(float x) { return __builtin_amdgcn_rcpf(1.0f + __expf(-x)); }
__device__ __forceinline__ float bflo(unsigned w) { return __uint_as_float(w << 16); }
__device__ __forceinline__ float bfhi(unsigned w) { return __uint_as_float(w & 0xffff0000u); }
__device__ __forceinline__ float ssq16(const float* s, int r) { const f32x4* q = (const f32x4*)(s + (size_t)r * 16); const f32x4 a = q[0] + q[1], b = q[2] + q[3], c = a + b; return (c[0] + c[1]) + (c[2] + c[3]); }
template <int ACT> struct EpiRow {
    static constexpr bool PERM = true, AFTER_DRAIN = false;
    bf16_t* O; int ldc; const float* ssq; unsigned qmask; float qscale; int split_cols; size_t split_stride;
    __device__ __forceinline__ void operator()(const f32x4 (&acc)[2][2][4][2], const Unit& u, int wr, int wc, int fr, int fq) const {
        int colt = u.pn * BM; bf16_t* Ob = O; if (split_cols) { const int t = colt / split_cols; Ob += (size_t)t * split_stride; colt -= t * split_cols; }
        const int row0 = u.pm * BM + wr * 64 + fr, col0 = colt + wc * 32 + 8 * fq;
        const float cs = ((qmask >> u.pn) & 1u) ? qscale : 1.f;
#pragma unroll
        for (int ai = 0; ai < 2; ++ai)
#pragma unroll
            for (int m = 0; m < 4; ++m) { const int r = row0 + ai * HALF + m * 16; const float rs = rsqrtf(ssq16(ssq, r) * (1.0f / 1024.0f) + RMS_EPS) * cs;
                bf16_t* rowp = Ob + (size_t)r * ldc + col0;
#pragma unroll
                for (int bj = 0; bj < 2; ++bj) { f32x4 v0 = acc[ai][bj][m][0] * rs, v1 = acc[ai][bj][m][1] * rs;
                    if (ACT == 1) {
#pragma unroll
                        for (int e = 0; e < 4; ++e) { const float a = fmaxf(v0[e], 0.f), b = fmaxf(v1[e], 0.f); v0[e] = a * a; v1[e] = b * b; } }
                    u32x4 w; w.x = cvt_pk_bf16(v0[0], v0[1]); w.y = cvt_pk_bf16(v0[2], v0[3]); w.z = cvt_pk_bf16(v1[0], v1[1]); w.w = cvt_pk_bf16(v1[2], v1[3]);
                    *(u32x4*)(rowp + bj * HALF) = w; } }
    }
};
template <int MODE> struct EpiRes {
    static constexpr bool PERM = false, AFTER_DRAIN = false;
    const bf16_t* base; bf16_t* outb; float* ssq_next; const float* ssq_cur; const bf16_t* pp;
    __device__ __forceinline__ void operator()(const f32x4 (&acc)[2][2][4][2], const Unit& u, int wr, int wc, int fr, int fq) const {
        const int row0 = u.pm * BM + wr * 64 + fr, col0 = u.pn * BM + wc * 32 + 4 * fq;
#pragma unroll
        for (int ai = 0; ai < 2; ++ai)
#pragma unroll
            for (int m = 0; m < 4; ++m) { const int r = row0 + ai * HALF + m * 16; const size_t off = (size_t)r * 1024 + col0; float sq = 0.f;
                float rs = 0.f; if (MODE == 1) rs = rsqrtf(ssq16(ssq_cur, r) * (1.0f / 1024.0f) + RMS_EPS);
#pragma unroll
                for (int bj = 0; bj < 2; ++bj)
#pragma unroll
                    for (int n = 0; n < 2; ++n) { const size_t o = off + bj * HALF + n * 16; f32x4 a = acc[ai][bj][m][n];
                        if (MODE == 1) { const u32x2 g = *(const u32x2*)(pp + o);
                            a[0] = bflo(g.x) * sigm(a[0] * rs); a[1] = bfhi(g.x) * sigm(a[1] * rs); a[2] = bflo(g.y) * sigm(a[2] * rs); a[3] = bfhi(g.y) * sigm(a[3] * rs); }
                        const u32x2 bv = *(const u32x2*)(base + o);
                        const f32x4 hv = (f32x4){bflo(bv.x), bfhi(bv.x), bflo(bv.y), bfhi(bv.y)} + a;
                        u32x2 w; w.x = cvt_pk_bf16(hv[0], hv[1]); w.y = cvt_pk_bf16(hv[2], hv[3]); *(u32x2*)(outb + o) = w;
                        sq += (hv[0] * hv[0] + hv[1] * hv[1]) + (hv[2] * hv[2] + hv[3] * hv[3]); }
                sq = xor_add<16>(sq); sq = xor_add<32>(sq);
                if (fq == 0) ssq_next[(size_t)r * 16 + u.pn * 4 + wc] = sq; }
    }
};
struct EpiPP {
    static constexpr bool PERM = false, AFTER_DRAIN = false;
    bf16_t* O;
    __device__ __forceinline__ void operator()(const f32x4 (&acc)[2][2][4][2], const Unit& u, int wr, int wc, int fr, int fq) const {
        const int row0 = u.pm * BM + wr * 64 + fr, col0 = u.pn * BM + wc * 32 + 4 * fq;
#pragma unroll
        for (int ai = 0; ai < 2; ++ai)
#pragma unroll
            for (int m = 0; m < 4; ++m) { const size_t off = (size_t)(row0 + ai * HALF + m * 16) * 1024 + col0;
#pragma unroll
                for (int bj = 0; bj < 2; ++bj)
#pragma unroll
                    for (int n = 0; n < 2; ++n) { const f32x4 a = acc[ai][bj][m][n]; u32x2 w; w.x = cvt_pk_bf16(a[0], a[1]); w.y = cvt_pk_bf16(a[2], a[3]); *(u32x2*)(O + off + bj * HALF + n * 16) = w; } }
    }
};
struct EpiGlu {
    static constexpr bool PERM = true, AFTER_DRAIN = false;
    bf16_t* O; const bf16_t* yg;
    __device__ __forceinline__ void operator()(const f32x4 (&acc)[2][2][4][2], const Unit& u, int wr, int wc, int fr, int fq) const {
        const int row0 = u.pm * BM + wr * 64 + fr, col0 = u.pn * BM + wc * 32 + 8 * fq;
#pragma unroll
        for (int ai = 0; ai < 2; ++ai)
#pragma unroll
            for (int m = 0; m < 4; ++m) { const int r = row0 + ai * HALF + m * 16;
#pragma unroll
                for (int bj = 0; bj < 2; ++bj) { const int c = col0 + bj * HALF; const u32x4 y = *(const u32x4*)(yg + (size_t)r * 512 + c);
                    const f32x4 v0 = acc[ai][bj][m][0], v1 = acc[ai][bj][m][1]; u32x4 w;
                    w.x = cvt_pk_bf16(bflo(y.x) * sigm(v0[0]), bfhi(y.x) * sigm(v0[1])); w.y = cvt_pk_bf16(bflo(y.y) * sigm(v0[2]), bfhi(y.y) * sigm(v0[3]));
                    w.z = cvt_pk_bf16(bflo(y.z) * sigm(v1[0]), bfhi(y.z) * sigm(v1[1])); w.w = cvt_pk_bf16(bflo(y.w) * sigm(v1[2]), bfhi(y.w) * sigm(v1[3]));
                    *(u32x4*)(O + (size_t)r * 1024 + c) = w; } }
    }
};
template <class Epi, class Sched, bool ALIGN_EPI = false, bool SP2 = false>
__device__ __forceinline__ void gemm_phase(PG8_LAS unsigned char* lds, const Gemm g, const Sched& S, const Epi& E) {
    int tid = threadIdx.x; asm volatile("" : "+v"(tid)); const int wid = __builtin_amdgcn_readfirstlane(tid >> 6), lane = tid & 63, wr = wid >> 2, wc = wid & 3, fr = lane & 15, fq = lane >> 4;
    const int K = g.K, nt = K / BK;
    unsigned voffA[2], voffB[2];
#pragma unroll
    for (int i = 0; i < 2; ++i) { int R, C; stage_rc(tid * 16 + i * 8192, R, C); const int Rb = Epi::PERM ? ((R & ~31) + perm32(R & 31)) : R;
        voffA[i] = (unsigned)(R * K + C) * 2u; voffB[i] = (unsigned)(Rb * K + C) * 2u; }
    const size_t kstep = (size_t)(BK * 2);
    const size_t hstep = (size_t)HALF * K * 2;
    const size_t tstep = 2 * hstep;
    const unsigned ldsw = (unsigned)wid * 1024u;
    const int aoff = lds_byte(wr * 64 + fr, fq * 8), boff = lds_byte(wc * 32 + fr, fq * 8);
#define PG8_SA(b, h) (((b) * 2 + (h)) * HTB)
#define PG8_SB(b, h) ((4 + (b) * 2 + (h)) * HTB)
#define PG8_STAGE(bufoff, gbase, voff) do { _Pragma("unroll") for (int _i = 0; _i < 2; ++_i) \
        __builtin_amdgcn_global_load_lds((const unsigned*)((const char*)(gbase) + (voff)[_i]), (PG8_LAS unsigned*)(lds + (bufoff) + ldsw + _i * 8192), 16, 0, 0); } while (0)
#define PG8_LDA(dst, b, h) do { _Pragma("unroll") for (int m = 0; m < 4; ++m) _Pragma("unroll") for (int k = 0; k < 2; ++k) dst[m][k] = *(const PG8_LAS bf16x8*)(lds + PG8_SA(b, h) + aoff + m * 2048 + k * 1024); } while (0)
#define PG8_LDB(dst, b, h) do { _Pragma("unroll") for (int n = 0; n < 2; ++n) _Pragma("unroll") for (int k = 0; k < 2; ++k) dst[n][k] = *(const PG8_LAS bf16x8*)(lds + PG8_SB(b, h) + boff + n * 2048 + k * 1024); } while (0)
#define PG8_MMA(ai, bj, At, Bt) do { __builtin_amdgcn_s_setprio(1); _Pragma("unroll") for (int m = 0; m < 4; ++m) _Pragma("unroll") for (int n = 0; n < 2; ++n) _Pragma("unroll") for (int k = 0; k < 2; ++k) \
        acc[ai][bj][m][n] = __builtin_amdgcn_mfma_f32_16x16x32_bf16(Bt[n][k], At[m][k], acc[ai][bj][m][n], 0, 0, 0); __builtin_amdgcn_s_setprio(0); } while (0)
#define PG8_WAIT_V(n) asm volatile("s_waitcnt vmcnt(" #n ")" ::: "memory")
#define PG8_WAIT_L(n) asm volatile("s_waitcnt lgkmcnt(" #n ")" ::: "memory")
#define PG8_BAR __builtin_amdgcn_s_barrier()
#define PG8_SCHED __builtin_amdgcn_sched_barrier(0)
    Unit cur, nxt; int ui = 0;
    if (!S.next(0, cur)) return;
    f32x4 acc[2][2][4][2];
#pragma unroll
    for (int a = 0; a < 2; ++a)
#pragma unroll
        for (int b = 0; b < 2; ++b)
#pragma unroll
            for (int m = 0; m < 4; ++m)
#pragma unroll
                for (int n = 0; n < 2; ++n) acc[a][b][m][n] = (f32x4){0.f, 0.f, 0.f, 0.f};
    bf16x8 At[4][2], B0[2][2], B1[2][2];
    const char* cA = (const char*)g.A + (size_t)cur.pm * tstep; const char* cB = (const char*)g.Bt + (size_t)cur.pn * tstep;
    S.a_ready(cur);
    if constexpr (SP2) {
        PG8_STAGE(PG8_SB(0, 0), cB, voffB); PG8_STAGE(PG8_SB(0, 1), cB + hstep, voffB); PG8_STAGE(PG8_SA(0, 0), cA, voffA); PG8_STAGE(PG8_SA(0, 1), cA + hstep, voffA);
        if (wr == 1) PG8_BAR;
        PG8_WAIT_V(2); PG8_BAR;
        PG8_STAGE(PG8_SB(1, 0), cB + kstep, voffB); PG8_STAGE(PG8_SA(1, 0), cA + kstep, voffA); PG8_STAGE(PG8_SB(1, 1), cB + hstep + kstep, voffB);
        PG8_WAIT_V(6); PG8_BAR;
    } else {
        PG8_STAGE(PG8_SB(0, 0), cB, voffB); PG8_STAGE(PG8_SA(0, 0), cA, voffA); PG8_STAGE(PG8_SB(0, 1), cB + hstep, voffB); PG8_STAGE(PG8_SA(0, 1), cA + hstep, voffA);
        if (wr == 1) PG8_BAR;
        PG8_WAIT_V(4); PG8_BAR;
        PG8_STAGE(PG8_SB(1, 0), cB + kstep, voffB); PG8_STAGE(PG8_SA(1, 0), cA + kstep, voffA); PG8_STAGE(PG8_SB(1, 1), cB + hstep + kstep, voffB);
        PG8_WAIT_V(6); PG8_BAR;
    }
    for (;;) {
        const bool has_next = S.next(ui + 1, nxt);
        const char* nA = has_next ? (const char*)g.A + (size_t)nxt.pm * tstep : cA; const char* nB = has_next ? (const char*)g.Bt + (size_t)nxt.pn * tstep : cB;
        for (int t = 0; t < nt; t += 2) {
            const bool last = (t == nt - 2);
            const char* a1 = cA + (size_t)(t + 1) * kstep;
            const char* a2 = last ? nA : cA + (size_t)(t + 2) * kstep; const char* b2 = last ? nB : cB + (size_t)(t + 2) * kstep;
            const char* a3 = a2 + kstep; const char* b3 = b2 + kstep;
            if (last && has_next) S.a_ready(nxt);
            if constexpr (SP2) {
            PG8_LDB(B0, 0, 0); PG8_LDB(B1, 0, 1); PG8_SCHED; PG8_LDA(At, 0, 0); PG8_STAGE(PG8_SA(1, 1), a1 + hstep, voffA);
            PG8_WAIT_V(8); PG8_WAIT_L(0); PG8_BAR; PG8_MMA(0, 0, At, B0); PG8_MMA(0, 1, At, B1); PG8_BAR; PG8_SCHED;
            PG8_LDA(At, 0, 1); PG8_STAGE(PG8_SB(0, 0), b2, voffB); PG8_STAGE(PG8_SB(0, 1), b2 + hstep, voffB); PG8_STAGE(PG8_SA(0, 0), a2, voffA);
            PG8_WAIT_V(8); PG8_WAIT_L(0); PG8_BAR; PG8_MMA(1, 0, At, B0); PG8_MMA(1, 1, At, B1); PG8_BAR; PG8_SCHED;
            PG8_LDB(B0, 1, 0); PG8_LDB(B1, 1, 1); PG8_SCHED; PG8_LDA(At, 1, 0); PG8_STAGE(PG8_SA(0, 1), a2 + hstep, voffA);
            PG8_WAIT_V(8); PG8_WAIT_L(0); PG8_BAR; PG8_MMA(0, 0, At, B0); PG8_MMA(0, 1, At, B1); PG8_BAR; PG8_SCHED;
            PG8_LDA(At, 1, 1); PG8_STAGE(PG8_SB(1, 0), b3, voffB); PG8_STAGE(PG8_SB(1, 1), b3 + hstep, voffB); PG8_STAGE(PG8_SA(1, 0), a3, voffA);
            PG8_WAIT_V(8); PG8_WAIT_L(0); PG8_BAR; PG8_MMA(1, 0, At, B0); PG8_MMA(1, 1, At, B1); PG8_BAR; PG8_SCHED;
            } else {
            PG8_LDB(B0, 0, 0); PG8_SCHED; PG8_LDA(At, 0, 0); PG8_STAGE(PG8_SA(1, 1), a1 + hstep, voffA);
            PG8_WAIT_L(8); PG8_BAR; PG8_WAIT_L(0); PG8_MMA(0, 0, At, B0); PG8_BAR; PG8_SCHED;
            PG8_LDB(B1, 0, 1); PG8_STAGE(PG8_SB(0, 0), b2, voffB);
            PG8_BAR; PG8_WAIT_L(0); PG8_MMA(0, 1, At, B1); PG8_BAR;
            PG8_LDA(At, 0, 1); PG8_STAGE(PG8_SA(0, 0), a2, voffA);
            PG8_BAR; PG8_WAIT_L(0); PG8_MMA(1, 0, At, B0); PG8_BAR; PG8_SCHED;
            PG8_STAGE(PG8_SB(0, 1), b2 + hstep, voffB);
            PG8_WAIT_V(6); PG8_BAR; PG8_MMA(1, 1, At, B1); PG8_BAR;
            PG8_LDB(B0, 1, 0); PG8_SCHED; PG8_LDA(At, 1, 0); PG8_STAGE(PG8_SA(0, 1), a2 + hstep, voffA);
            PG8_WAIT_L(8); PG8_BAR; PG8_WAIT_L(0); PG8_MMA(0, 0, At, B0); PG8_BAR; PG8_SCHED;
            PG8_LDB(B1, 1, 1); PG8_STAGE(PG8_SB(1, 0), b3, voffB);
            PG8_BAR; PG8_WAIT_L(0); PG8_MMA(0, 1, At, B1); PG8_BAR;
            PG8_LDA(At, 1, 1); PG8_STAGE(PG8_SA(1, 0), a3, voffA);
            PG8_BAR; PG8_WAIT_L(0); PG8_MMA(1, 0, At, B0); PG8_BAR; PG8_SCHED;
            PG8_STAGE(PG8_SB(1, 1), b3 + hstep, voffB);
            PG8_WAIT_V(6); PG8_BAR; PG8_MMA(1, 1, At, B1); PG8_BAR;
            }
        }
        if constexpr (ALIGN_EPI) { if (wr == 0) PG8_BAR; }
        if constexpr (!Epi::AFTER_DRAIN) { E(acc, cur, wr, wc, fr, fq); S.done(cur); }
        if (!has_next) break;
#pragma unroll
        for (int a = 0; a < 2; ++a)
#pragma unroll
            for (int b = 0; b < 2; ++b)
#pragma unroll
                for (int m = 0; m < 4; ++m)
#pragma unroll
                    for (int n = 0; n < 2; ++n) acc[a][b][m][n] = (f32x4){0.f, 0.f, 0.f, 0.f};
        cur = nxt; cA = nA; cB = nB; ++ui;
        if constexpr (ALIGN_EPI) { if (wr == 1) PG8_BAR; }
    }
    PG8_WAIT_V(0);
    if constexpr (!ALIGN_EPI) { if (wr == 0) PG8_BAR; }
    PG8_BAR;
    if constexpr (Epi::AFTER_DRAIN) { E.fused(acc, cur, wr, wc, fr, fq, lds, wid, lane); S.done(cur); }
#undef PG8_SA
#undef PG8_SB
#undef PG8_STAGE
#undef PG8_LDA
#undef PG8_LDB
#undef PG8_MMA
#undef PG8_WAIT_V
#undef PG8_WAIT_L
#undef PG8_BAR
#undef PG8_SCHED
}
}
#include <hip/hip_bf16.h>
#include <cmath>
namespace attn_body {
using bf16=__hip_bfloat16;
using bf16x8=__attribute__((ext_vector_type(8)))short;
using s16x4=__attribute__((ext_vector_type(4)))short;
using f32x16=__attribute__((ext_vector_type(16)))float;
using u32x4=__attribute__((ext_vector_type(4)))unsigned;
constexpr int SEQ=4096,D=64,PQ=512,PO=1024;
constexpr int NW=8,QBLK=32,QB=QBLK*NW,KVBLK=64,NQB=SEQ/QB;

__device__ __forceinline__ int crow(int r,int hi){return (r&3)+8*(r>>2)+4*hi;}
#define SBAR() __builtin_amdgcn_sched_barrier(0)
__device__ __forceinline__ void cmask(f32x16&p0,f32x16&p1,int jb,int qrel,int hi){
  const float NEG=-INFINITY; int kb=64*jb+4*hi;
  #pragma unroll
  for(int r=0;r<16;++r){int kv=kb+(r&3)+8*(r>>2); if(kv>qrel)p0[r]=NEG; if(kv+32>qrel)p1[r]=NEG;}
}

constexpr int NSLOT=3, SLOTB=8192;
constexpr int LDS_K=0, LDS_V=NSLOT*SLOTB, LDS_WS=2*NSLOT*SLOTB, LDS_OST=LDS_WS+NW*64*4, LDS_BYTES=LDS_OST+NW*4096;
constexpr float C2=0.125f*1.4426950408889634f;
__device__ __forceinline__ void glds16(const void*gsrc,unsigned lds_dst){unsigned keep;
  asm volatile("s_mov_b32 %0, m0\n\ts_mov_b32 m0, %2\n\ts_nop 0\n\tglobal_load_lds_dwordx4 %1, off\n\ts_mov_b32 m0, %0":"=&s"(keep):"v"(gsrc),"s"(lds_dst):"memory");}
__device__ __forceinline__ float max3f(float a,float b,float c){float r;asm("v_max3_f32 %0, %1, %2, %3":"=v"(r):"v"(a),"v"(b),"v"(c));return r;}
__device__ __forceinline__ float max2f(float a,float b){float r;asm("v_max_f32_e32 %0, %1, %2":"=v"(r):"v"(a),"v"(b));return r;}
__device__ __forceinline__ float fadd_s(float a,float b){float r;asm("v_add_f32_e32 %0, %1, %2":"=v"(r):"v"(a),"v"(b));return r;}
__device__ __forceinline__ float fsub_s(float a,float b){float r;asm("v_sub_f32_e32 %0, %1, %2":"=v"(r):"v"(a),"v"(b));return r;}
typedef float f32x2_t __attribute__((ext_vector_type(2))); typedef __bf16 bf16x2_t __attribute__((ext_vector_type(2)));
__device__ __forceinline__ unsigned cvtpk_s(float lo,float hi){f32x2_t v={lo,hi};bf16x2_t b=__builtin_convertvector(v,bf16x2_t);return __builtin_bit_cast(unsigned,b);}
#define WAIT_BAR(N) asm volatile("s_waitcnt vmcnt(" #N ") lgkmcnt(0)\n\ts_barrier":::"memory")

__device__ __forceinline__ void qkt(f32x16&p0,f32x16&p1,const char*Kslot,const bf16x8*qr,const f32x16&negm,int r32,int hi){
  const char*kb=Kslot+hi*1024+r32*16;
  #pragma unroll
  for(int d0=0;d0<4;++d0){
    const bf16x8 b0=*reinterpret_cast<const bf16x8*>(kb+d0*2048);
    const bf16x8 b1=*reinterpret_cast<const bf16x8*>(kb+d0*2048+512);
    if(d0==0){p0=__builtin_amdgcn_mfma_f32_32x32x16_bf16(b0,qr[0],negm,0,0,0);p1=__builtin_amdgcn_mfma_f32_32x32x16_bf16(b1,qr[0],negm,0,0,0);}
    else{p0=__builtin_amdgcn_mfma_f32_32x32x16_bf16(b0,qr[d0],p0,0,0,0);p1=__builtin_amdgcn_mfma_f32_32x32x16_bf16(b1,qr[d0],p1,0,0,0);}}
}
typedef __attribute__((address_space(3))) const char* lds_cptr;
typedef short v4i16_t __attribute__((ext_vector_type(4)));
__device__ __forceinline__ void kload8(bf16x8*kf,lds_cptr kp){
  kf[0]=*(const __attribute__((address_space(3))) bf16x8*)(kp);      kf[1]=*(const __attribute__((address_space(3))) bf16x8*)(kp+512);
  kf[2]=*(const __attribute__((address_space(3))) bf16x8*)(kp+2048); kf[3]=*(const __attribute__((address_space(3))) bf16x8*)(kp+2560);
  kf[4]=*(const __attribute__((address_space(3))) bf16x8*)(kp+4096); kf[5]=*(const __attribute__((address_space(3))) bf16x8*)(kp+4608);
  kf[6]=*(const __attribute__((address_space(3))) bf16x8*)(kp+6144); kf[7]=*(const __attribute__((address_space(3))) bf16x8*)(kp+6656);
}
__device__ __forceinline__ void kload2(bf16x8*kf,lds_cptr kp,int j){ kf[2*j]=*(const __attribute__((address_space(3))) bf16x8*)(kp+j*2048); kf[2*j+1]=*(const __attribute__((address_space(3))) bf16x8*)(kp+j*2048+512); }
__device__ __forceinline__ s16x4 vtr(lds_cptr p){ return __builtin_bit_cast(s16x4,__builtin_amdgcn_ds_read_tr16_b64_v4i16((__attribute__((address_space(3))) v4i16_t*)p)); }
__device__ __forceinline__ float rowmax(const f32x16&p0,const f32x16&p1){
  float a=max3f(p0[0],p0[1],p1[0]),b=max3f(p0[2],p0[3],p1[1]);a=max3f(a,p1[2],p1[3]);
  #pragma unroll
  for(int r=4;r<16;r+=4){a=max3f(a,p0[r],p0[r+1]);b=max3f(b,p0[r+2],p0[r+3]);a=max3f(a,p1[r],p1[r+1]);b=max3f(b,p1[r+2],p1[r+3]);}
  const float m=max2f(a,b);
  auto rr=__builtin_amdgcn_permlane32_swap(__float_as_uint(m),__float_as_uint(m),false,false);
  return max2f(__uint_as_float(rr[0]),__uint_as_float(rr[1]));
}
__device__ __forceinline__ void pv(f32x16*o,int vb,bf16x8 pa0,bf16x8 pa1,bf16x8 pa2,bf16x8 pa3){
  #pragma unroll
  for(int d0=0;d0<2;++d0){s16x4 lo[4],hi[4];
    #pragma unroll
    for(int ks=0;ks<4;++ks){
      asm volatile("ds_read_b64_tr_b16 %0,%1 offset:%c2":"=&v"(lo[ks]):"v"(vb),"i"(d0*4096+ks*1024):"memory");
      asm volatile("ds_read_b64_tr_b16 %0,%1 offset:%c2":"=&v"(hi[ks]):"v"(vb),"i"(d0*4096+ks*1024+512):"memory");}
    asm volatile("s_waitcnt lgkmcnt(0)":::"memory");SBAR();
    #define PK(k) (bf16x8){lo[k][0],lo[k][1],lo[k][2],lo[k][3],hi[k][0],hi[k][1],hi[k][2],hi[k][3]}
    o[d0]=__builtin_amdgcn_mfma_f32_32x32x16_bf16(pa0,PK(0),o[d0],0,0,0);
    o[d0]=__builtin_amdgcn_mfma_f32_32x32x16_bf16(pa1,PK(1),o[d0],0,0,0);
    o[d0]=__builtin_amdgcn_mfma_f32_32x32x16_bf16(pa2,PK(2),o[d0],0,0,0);
    o[d0]=__builtin_amdgcn_mfma_f32_32x32x16_bf16(pa3,PK(3),o[d0],0,0,0);
    #undef PK
  }
}

#ifndef ATTN_STORE16
#define ATTN_STORE16(p,v) (*(u32x4*)(p)=(v))
#endif
template<int THRL> __device__ __forceinline__ void attn_unit(int b,int h,int qb,const bf16*Q,const bf16*__restrict__ K,const bf16*__restrict__ V,bf16*O,char*shm){
  int tid=threadIdx.x; asm volatile("":"+v"(tid)); const int lane=tid&63,r32=lane&31,hi=lane>>5; const int wid=__builtin_amdgcn_readfirstlane(tid>>6);
  const long rowbase=(long)b*SEQ; const int q0=qb*QB;
  const bf16*Qw=Q+(rowbase+q0+wid*QBLK)*PQ;
  const bf16*Kh=K+rowbase*PQ,*Vh=V+rowbase*PQ;
  const unsigned lds0=(unsigned)(uintptr_t)shm;
  float*wsf=(float*)(shm+LDS_WS)+wid*64;
  const bf16*ksrc=Kh+(long)lane*PQ+wid*8;
  const bf16*vsrc=Vh+(long)(16*(wid&3)+(lane>>2))*PQ+(wid>>2)*32+(lane&3)*8;
  const unsigned kdst=lds0+LDS_K+wid*1024, vdst=lds0+LDS_V+wid*1024;
  #define DMA_K(t,slot) glds16(ksrc+(long)(t)*KVBLK*PQ,(unsigned)__builtin_amdgcn_readfirstlane(kdst+(slot)))
  #define DMA_V(t,slot) glds16(vsrc+(long)(t)*KVBLK*PQ,(unsigned)__builtin_amdgcn_readfirstlane(vdst+(slot)))
  const int vb0=(int)(lds0+LDS_V)+((lane>>4)&1)*32+(lane&3)*8+(4*hi+((lane&15)>>2))*64;
  const char*Kbase=shm+LDS_K; bf16x8 kf[8];
  const lds_cptr shm3=(lds_cptr)shm; const lds_cptr kp0=shm3+LDS_K+hi*1024+r32*16; const lds_cptr vp0=shm3+LDS_V+((lane>>4)&1)*32+(lane&3)*8+(4*hi+((lane&15)>>2))*64;
  const int NT=(q0+QB)/KVBLK;
  DMA_K(0,0);DMA_V(0,0);DMA_K(1,SLOTB);
  bf16x8 qr[4];
  #pragma unroll
  for(int d0=0;d0<4;++d0)qr[d0]=*reinterpret_cast<const bf16x8*>(&Qw[(long)r32*PQ+d0*16+hi*8]);
  float mhat=0.f,l_reg=0.f;f32x16 o[2];o[0]=f32x16{};o[1]=f32x16{};float zz_=0.f;asm volatile("":"+v"(zz_));f32x16 negm;
  _Pragma("unroll") for(int r=0;r<16;++r)negm[r]=zz_;
  const int qrel=wid*QBLK+r32;
  #define CMASK(P0,P1,t) do{int jb_=(t)-(NT-4); if(jb_>=0)cmask(P0,P1,jb_,qrel,hi);}while(0)
  bool resc=false;
  #define START(P0,P1) do{ const float rm=rowmax(P0,P1); resc=false; \
    { const float dl=rm; mhat=fadd_s(mhat,dl); \
      _Pragma("unroll") for(int r=0;r<16;++r){P0[r]=fsub_s(P0[r],dl);P1[r]=fsub_s(P1[r],dl);} \
      _Pragma("unroll") for(int r=0;r<16;++r)negm[r]=-mhat; asm volatile("":"+v"(negm)); } \
    _Pragma("unroll") for(int r=0;r<16;++r)P0[r]=__builtin_amdgcn_exp2f(P0[r]); }while(0)
  #define RESC() do{ if(resc){ asm volatile("s_waitcnt lgkmcnt(0)":::"memory"); \
      _Pragma("unroll") for(int d_=0;d_<2;++d_) _Pragma("unroll") for(int r=0;r<16;++r)o[d_][r]*=wsf[crow(r,hi)]; } }while(0)
  f32x16 pA0,pA1,pB0,pB1;
  int sl_prev=0,sl_cur=0,sl_next=SLOTB;
  #define ROT() do{sl_prev=sl_cur;sl_cur=sl_next;sl_next=(sl_next==(NSLOT-1)*SLOTB)?0:sl_next+SLOTB;}while(0)
  DMA_K(2,2*SLOTB);
  WAIT_BAR(3);
  qkt(pA0,pA1,Kbase,qr,negm,r32,hi);asm volatile("s_nop 15\n\ts_nop 7":"+v"(pA0),"+v"(pA1));CMASK(pA0,pA1,0);
  START(pA0,pA1);
  _Pragma("unroll") for(int r=0;r<16;++r)pA1[r]=__builtin_amdgcn_exp2f(pA1[r]);
  WAIT_BAR(0);
  DMA_K(3,0);DMA_V(1,SLOTB);
  ROT();
  kload8(kf,kp0+sl_cur);
  WAIT_BAR(2);
  s16x4 vlo[8],vhi[8]; u32x4 pw0,pw1,pw2,pw3;
  #define PKW(P,B) cvtpk_s(P[B],P[B+1])
  #define PAF(k) __builtin_bit_cast(bf16x8,pw##k)
  #define VFR(i) (bf16x8){vlo[i][0],vlo[i][1],vlo[i][2],vlo[i][3],vhi[i][0],vhi[i][1],vhi[i][2],vhi[i][3]}
  #define PIN(x) asm volatile("":"+v"(x))
  #define MX3(a,b,c) __builtin_fmaxf(__builtin_fmaxf((a),(b)),(c))
  #define GAPA(MF,A0,A1,A2,A3,W0,W1,PW) do{ MF; sacc+=A0; sacc+=A1; sacc+=A2; sacc+=A3; PIN(sacc); W0; W1; PIN(PW); SBAR(); }while(0)
  #define EX(v) __builtin_amdgcn_exp2f(v)
  #define GAPB(MF,X,B) do{ MF; X[B]=EX(X[B]); X[B+1]=EX(X[B+1]); X[B+2]=EX(X[B+2]); X[B+3]=EX(X[B+3]); PIN(X); SBAR(); }while(0)
  #define VRD(i) do{ vlo[i]=vtr(vp_+(((i)>>2)*4096+((i)&3)*1024)); vhi[i]=vtr(vp_+(((i)>>2)*4096+((i)&3)*1024+512)); }while(0)
  #define KRD(G,j) do{ if(G){ kload2(kf,kp0+sl_next,j); SBAR(); } }while(0)
  #define STEP(C0,C1,P0,P1,t,GK,GV,GL) do{ SBAR(); \
    const lds_cptr vp_=vp0+sl_prev; \
    VRD(0); SBAR(); float sacc=(P0[0]+P0[1]); \
    GAPA(C0=__builtin_amdgcn_mfma_f32_32x32x16_bf16(kf[0],qr[0],negm,0,0,0), P0[2],P0[3],P0[4],P0[5],     pw0[0]=PKW(P0,0), pw0[1]=PKW(P0,2), pw0); \
    VRD(4); SBAR(); GAPA(C1=__builtin_amdgcn_mfma_f32_32x32x16_bf16(kf[1],qr[0],negm,0,0,0), P0[6],P0[7],P0[8],P0[9],     pw0[2]=PKW(P0,4), pw0[3]=PKW(P0,6), pw0); \
    VRD(1); SBAR(); GAPA(C0=__builtin_amdgcn_mfma_f32_32x32x16_bf16(kf[2],qr[1],C0,0,0,0),   P0[10],P0[11],P0[12],P0[13], pw1[0]=PKW(P0,8), pw1[1]=PKW(P0,10), pw1); \
    VRD(5); SBAR(); GAPA(C1=__builtin_amdgcn_mfma_f32_32x32x16_bf16(kf[3],qr[1],C1,0,0,0),   P0[14],P0[15],P1[0],P1[1],   pw1[2]=PKW(P0,12),pw1[3]=PKW(P0,14), pw1); \
    VRD(2); SBAR(); GAPA(C0=__builtin_amdgcn_mfma_f32_32x32x16_bf16(kf[4],qr[2],C0,0,0,0),   P1[2],P1[3],P1[4],P1[5],     pw2[0]=PKW(P1,0), pw2[1]=PKW(P1,2), pw2); \
    VRD(6); SBAR(); GAPA(C1=__builtin_amdgcn_mfma_f32_32x32x16_bf16(kf[5],qr[2],C1,0,0,0),   P1[6],P1[7],P1[8],P1[9],     pw2[2]=PKW(P1,4), pw2[3]=PKW(P1,6), pw2); \
    VRD(3); SBAR(); GAPA(C0=__builtin_amdgcn_mfma_f32_32x32x16_bf16(kf[6],qr[3],C0,0,0,0),   P1[10],P1[11],P1[12],P1[13], pw3[0]=PKW(P1,8), pw3[1]=PKW(P1,10), pw3); \
    VRD(7); SBAR(); GAPA(C1=__builtin_amdgcn_mfma_f32_32x32x16_bf16(kf[7],qr[3],C1,0,0,0),   P1[14],P1[15],0.f,0.f,       pw3[2]=PKW(P1,12),pw3[3]=PKW(P1,14), pw3); \
    l_reg+=sacc; \
    if(GK){DMA_K((t)+3,sl_cur);} if(GV){DMA_V((t)+1,sl_next);} \
    CMASK(C0,C1,t); \
    { float a=MX3(C0[0],C0[1],C1[0]),b=MX3(C0[2],C0[3],C1[1]); a=MX3(a,C1[2],C1[3]); \
      _Pragma("unroll") for(int r=4;r<16;r+=4){a=MX3(a,C0[r],C0[r+1]);b=MX3(b,C0[r+2],C0[r+3]);a=MX3(a,C1[r],C1[r+1]);b=MX3(b,C1[r+2],C1[r+3]);} \
      float rm=__builtin_fmaxf(a,b); { auto rr=__builtin_amdgcn_permlane32_swap(__float_as_uint(rm),__float_as_uint(rm),false,false); rm=__builtin_fmaxf(__uint_as_float(rr[0]),__uint_as_float(rr[1])); } \
      resc=false; \
      if(__builtin_expect(__any(rm>(float)THRL),0)){ const float dl=__builtin_fmaxf(rm,0.f); mhat+=dl; \
        _Pragma("unroll") for(int r=0;r<16;++r){C0[r]-=dl;C1[r]-=dl;} \
        _Pragma("unroll") for(int r=0;r<16;++r)negm[r]=-mhat; asm volatile("":"+v"(negm)); \
        const float f=__builtin_amdgcn_exp2f(-dl); l_reg*=f; if(hi==0)wsf[r32]=f; resc=true; } } \
    SBAR(); \
    GAPB(o[0]=__builtin_amdgcn_mfma_f32_32x32x16_bf16(PAF(0),VFR(0),o[0],0,0,0), C0,0); \
    GAPB(o[1]=__builtin_amdgcn_mfma_f32_32x32x16_bf16(PAF(0),VFR(4),o[1],0,0,0), C0,4); \
    KRD(GL,0); GAPB(o[0]=__builtin_amdgcn_mfma_f32_32x32x16_bf16(PAF(1),VFR(1),o[0],0,0,0), C0,8); \
    KRD(GL,1); GAPB(o[1]=__builtin_amdgcn_mfma_f32_32x32x16_bf16(PAF(1),VFR(5),o[1],0,0,0), C0,12); \
    KRD(GL,2); GAPB(o[0]=__builtin_amdgcn_mfma_f32_32x32x16_bf16(PAF(2),VFR(2),o[0],0,0,0), C1,0); \
    KRD(GL,3); GAPB(o[1]=__builtin_amdgcn_mfma_f32_32x32x16_bf16(PAF(2),VFR(6),o[1],0,0,0), C1,4); \
    GAPB(o[0]=__builtin_amdgcn_mfma_f32_32x32x16_bf16(PAF(3),VFR(3),o[0],0,0,0), C1,8); \
    GAPB(o[1]=__builtin_amdgcn_mfma_f32_32x32x16_bf16(PAF(3),VFR(7),o[1],0,0,0), C1,12); \
    }while(0)
  int t=1;
  #undef CMASK
  #define CMASK(P0,P1,t) do{}while(0)
  for(;t+5<NT;t+=2){
    STEP(pB0,pB1,pA0,pA1,t,true,true,true);     WAIT_BAR(2); RESC(); ROT();
    STEP(pA0,pA1,pB0,pB1,t+1,true,true,true);   WAIT_BAR(2); RESC(); ROT();
  }
  #undef CMASK
  #define CMASK(P0,P1,t) do{int jb_=(t)-(NT-4); if(jb_>=0)cmask(P0,P1,jb_,qrel,hi);}while(0)
  #define ENDW(tt) do{ if((tt)+3<NT){WAIT_BAR(2);} else if((tt)+2<NT){WAIT_BAR(1);} else {WAIT_BAR(0);} }while(0)
  for(;t+1<NT;t+=2){
    STEP(pB0,pB1,pA0,pA1,t,(t+3<NT),(t+1<NT),(t+1<NT));       ENDW(t);   RESC(); ROT();
    STEP(pA0,pA1,pB0,pB1,t+1,(t+4<NT),(t+2<NT),(t+2<NT));     ENDW(t+1); RESC(); ROT();
  }
  STEP(pB0,pB1,pA0,pA1,NT-1,false,false,false); RESC();
  { float sacc=pB0[0]+pB0[1]; _Pragma("unroll") for(int r=2;r<16;++r)sacc+=pB0[r]; _Pragma("unroll") for(int r=0;r<16;++r)sacc+=pB1[r]; l_reg+=sacc;
    pw0=(u32x4){PKW(pB0,0),PKW(pB0,2),PKW(pB0,4),PKW(pB0,6)};pw1=(u32x4){PKW(pB0,8),PKW(pB0,10),PKW(pB0,12),PKW(pB0,14)};pw2=(u32x4){PKW(pB1,0),PKW(pB1,2),PKW(pB1,4),PKW(pB1,6)};pw3=(u32x4){PKW(pB1,8),PKW(pB1,10),PKW(pB1,12),PKW(pB1,14)};
    SBAR(); pv(o,vb0+sl_cur,PAF(0),PAF(1),PAF(2),PAF(3)); }
  #undef PKW
  #undef PAF
  #undef VFR
  #undef PIN
  #undef MX3
  #undef GAPA
  #undef GAPB
  #undef EX
  #undef VRD
  #undef KRD
  #undef STEP
  #undef ENDW
  {auto rr=__builtin_amdgcn_permlane32_swap(__float_as_uint(l_reg),__float_as_uint(l_reg),false,false);l_reg=__uint_as_float(rr[0])+__uint_as_float(rr[1]);}
  if(hi==0)wsf[32+r32]=l_reg;asm volatile("s_waitcnt lgkmcnt(0)":::"memory");
  float rli[16];
  #pragma unroll
  for(int r=0;r<16;++r)rli[r]=__builtin_amdgcn_rcpf(wsf[32+crow(r,hi)]);
  bf16*Ow=O+(rowbase+q0+wid*QBLK)*PO;
  { bf16*stg=(bf16*)(shm+LDS_OST)+wid*2048;
    #pragma unroll
    for(int r=0;r<16;++r){const int orow=crow(r,hi);
      #pragma unroll
      for(int d0=0;d0<2;++d0)stg[orow*64+d0*32+r32]=__float2bfloat16(o[d0][r]*rli[r]);}
    asm volatile("s_waitcnt lgkmcnt(0)":::"memory");
    #pragma unroll
    for(int i=0;i<4;++i){const int row=i*8+(lane>>3),ch=lane&7; const u32x4 v=*(const u32x4*)(stg+row*64+ch*8); ATTN_STORE16(Ow+(long)row*PO+ch*8,v);} }
  asm volatile("s_waitcnt lgkmcnt(0)\n\ts_barrier":::"memory");
  #undef DMA_K
  #undef DMA_V
  #undef CMASK
  #undef START
  #undef RESC
  #undef ROT
}
constexpr int ATTN_LDS_BYTES=LDS_BYTES;
#undef SBAR
#undef WAIT_BAR
}
#include <hip/hip_cooperative_groups.h>
namespace cg = cooperative_groups;
namespace mk {
typedef unsigned short bf16_t;
typedef short bf16x8 __attribute__((ext_vector_type(8)));
typedef short s16x4 __attribute__((ext_vector_type(4)));
typedef float f32x4 __attribute__((ext_vector_type(4)));
typedef float f32x16 __attribute__((ext_vector_type(16)));
typedef unsigned u32x4 __attribute__((ext_vector_type(4)));
typedef unsigned u32x2 __attribute__((ext_vector_type(2)));
typedef float f32x2_t __attribute__((ext_vector_type(2))); typedef __bf16 bf16x2_t __attribute__((ext_vector_type(2)));
constexpr int T = 32768, S = 4096;
constexpr size_t TSQ = (size_t)T * 512;
constexpr size_t MiB = 1u << 20;
constexpr size_t WS_SSQ = 0, WS_DML = 4 * MiB, WS_W = 6 * MiB, WS_WL = 18 * MiB + MiB / 2, WS_WM = WS_W + 74 * MiB, WS_PB = 112 * MiB, WS_HB = 128 * MiB, WS_YMIX = 192 * MiB, WS_BIG = 256 * MiB, WS_O16 = WS_BIG + 192 * MiB, WS_END = 512 * MiB;
constexpr int LDS_BYTES = 147456;
constexpr float C2 = 0.125f * 1.4426950408889634f;
struct Params { const float* in[29]; float* out; unsigned char* ws; };

__device__ __forceinline__ unsigned pk2(float lo, float hi) { f32x2_t v = {lo, hi}; bf16x2_t b = __builtin_convertvector(v, bf16x2_t); return __builtin_bit_cast(unsigned, b); }
__device__ __forceinline__ float bflo(unsigned w) { return __uint_as_float(w << 16); }
__device__ __forceinline__ float bfhi(unsigned w) { return __uint_as_float(w & 0xffff0000u); }
__device__ __forceinline__ float bf1(bf16_t h) { return __uint_as_float((unsigned)h << 16); }
__device__ __forceinline__ float wave_sum(float v) {
v = xor_add<1>(v); v = xor_add<2>(v); v = xor_add<4>(v); v = xor_add<8>(v); v = xor_add<16>(v); v = xor_add<32>(v);
    return v;
}
#define WAVE_LDS_SYNC() asm volatile("s_waitcnt lgkmcnt(0)" ::: "memory")
__device__ __forceinline__ int crow(int r, int hi) { return (r & 3) + 8 * (r >> 2) + 4 * hi; }

__device__ __forceinline__ void transpose_items(const float* W, int K, int N, const float* gain, bf16_t* WT, float* scr, int gw, int ngw, int lane) {
    const int nblk = N / 32, nitems = (K / 64) * nblk;
    const int lr = lane >> 3, lc = (lane & 7) * 4;
    f32x4 r[8];
    int it = gw;
    if (it < nitems) { const int k0 = 64 * (it / nblk), n0 = 32 * (it % nblk);
#pragma unroll
        for (int i = 0; i < 8; ++i) r[i] = __builtin_nontemporal_load((const f32x4*)(W + (size_t)(k0 + lr + 8 * i) * N + n0 + lc)); }
    for (; it < nitems; it += ngw) {
        const int kb = it / nblk, nb = it % nblk, k0 = 64 * kb, n0 = 32 * nb;
#pragma unroll
        for (int i = 0; i < 8; ++i) { const int kk = lr + 8 * i; const float g = gain ? gain[k0 + kk] : 1.0f; float* d = scr + kk * 33 + lc;
            d[0] = r[i][0] * g; d[1] = r[i][1] * g; d[2] = r[i][2] * g; d[3] = r[i][3] * g; }
        WAVE_LDS_SYNC();
        const int itn = it + ngw;
        if (itn < nitems) { const int k1 = 64 * (itn / nblk), n1 = 32 * (itn % nblk);
#pragma unroll
            for (int i = 0; i < 8; ++i) r[i] = __builtin_nontemporal_load((const f32x4*)(W + (size_t)(k1 + lr + 8 * i) * N + n1 + lc)); }
        const int c = lane & 7;
#pragma unroll
        for (int j = 0; j < 4; ++j) { const int n = (lane >> 3) + 8 * j; const float* s = scr + (8 * c) * 33 + n;
            u32x4 o; o.x = pk2(s[0 * 33], s[1 * 33]); o.y = pk2(s[2 * 33], s[3 * 33]); o.z = pk2(s[4 * 33], s[5 * 33]); o.w = pk2(s[6 * 33], s[7 * 33]);
            *(u32x4*)(WT + (size_t)(n0 + n) * K + k0 + 8 * c) = o; }
        WAVE_LDS_SYNC();
    }
}
__device__ __forceinline__ void convert_p(const float* psrc, bf16_t* pb, int gtid, int nthr) {
    int i = gtid; f32x4 a = (f32x4){0.f, 0.f, 0.f, 0.f}, b = a;
    if (i < T * 256 / 8) { a = __builtin_nontemporal_load((const f32x4*)psrc + 2 * i); b = __builtin_nontemporal_load((const f32x4*)psrc + 2 * i + 1); }
    for (; i < T * 256 / 8; i += nthr) { const f32x4 ca = a, cb = b; const int in = i + nthr;
        if (in < T * 256 / 8) { a = __builtin_nontemporal_load((const f32x4*)psrc + 2 * in); b = __builtin_nontemporal_load((const f32x4*)psrc + 2 * in + 1); }
        u32x4 o; o.x = pk2(ca[0], ca[1]); o.y = pk2(ca[2], ca[3]); o.z = pk2(cb[0], cb[1]); o.w = pk2(cb[2], cb[3]); ((u32x4*)pb)[i] = o; }
}

template <int PASS> __device__ __forceinline__ void dil_unit(int u, int dilv, const bf16_t* proj, float* accst, float* mst, float* lst, bf16_t* ymix, short* vts, int lane) {
    const int r32 = lane & 31, hi = lane >> 5;
    const int LB = 128 / dilv, ql = u & 127, head = (u >> 7) & 7, b = u >> 10, r = ql / LB, qblk = ql % LB;
    const long rowq = (long)b * S + (long)(32 * qblk + r32) * dilv + r;
    const bf16_t* qp = proj + 3 * TSQ + rowq * 512 + head * 64 + 8 * hi;
    const int j0 = qblk < 4 ? 4 - qblk : 0;
    const float NEG = -1e30f;
#define DIL_ROW(j) ((long)b * S + (long)(32 * qblk - 128 + 32 * ((j) >= j0 ? (j) : j0) + r32) * dilv + r)
    bf16x8 qf[4], kn[4];
#pragma unroll
    for (int d0 = 0; d0 < 4; ++d0) qf[d0] = *(const bf16x8*)(qp + 16 * d0);
    { const bf16_t* kp = proj + 4 * TSQ + DIL_ROW(0) * 512 + head * 64 + 8 * hi;
#pragma unroll
        for (int d0 = 0; d0 < 4; ++d0) kn[d0] = *(const bf16x8*)(kp + 16 * d0); }
    const size_t sidx = (size_t)rowq * 8 + head;
    float m_old = NEG, l_old = 0.f;
    if (PASS > 0) { m_old = mst[sidx]; l_old = lst[sidx]; }
    f32x16 st[5]; float mt = NEG;
#pragma unroll
    for (int j = 0; j < 5; ++j) {
        bf16x8 kc[4];
#pragma unroll
        for (int d0 = 0; d0 < 4; ++d0) kc[d0] = kn[d0];
        if (j < 4) { const bf16_t* kp = proj + 4 * TSQ + DIL_ROW(j + 1) * 512 + head * 64 + 8 * hi;
#pragma unroll
            for (int d0 = 0; d0 < 4; ++d0) kn[d0] = *(const bf16x8*)(kp + 16 * d0); }
        if (j >= j0) {
            f32x16 a = f32x16{};
#pragma unroll
            for (int d0 = 0; d0 < 4; ++d0) a = __builtin_amdgcn_mfma_f32_32x32x16_bf16(kc[d0], qf[d0], a, 0, 0, 0);
            if (j == 0) {
#pragma unroll
                for (int i = 0; i < 16; ++i) if (crow(i, hi) < r32) a[i] = NEG; }
            if (j == 4) {
#pragma unroll
                for (int i = 0; i < 16; ++i) if (crow(i, hi) > r32) a[i] = NEG; }
#pragma unroll
            for (int i = 0; i < 16; ++i) mt = fmaxf(mt, a[i]);
            st[j] = a;
        } else st[j] = f32x16{};
    }
    bf16x8 vn[4];
    { const bf16_t* vp = proj + 5 * TSQ + DIL_ROW(0) * 512 + head * 64 + 8 * hi;
#pragma unroll
        for (int d0 = 0; d0 < 4; ++d0) vn[d0] = *(const bf16x8*)(vp + 16 * d0); }
    f32x16 O[2]; float* ap = accst + sidx * 64 + 4 * hi;
    if (PASS > 0) {
#pragma unroll
        for (int dt = 0; dt < 2; ++dt)
#pragma unroll
            for (int i4 = 0; i4 < 4; ++i4) { const f32x4 v = *(const f32x4*)(ap + 32 * dt + 8 * i4);
#pragma unroll
                for (int e = 0; e < 4; ++e) O[dt][4 * i4 + e] = v[e]; }
    } else { O[0] = f32x16{}; O[1] = f32x16{}; }
    mt = xor_max<32>(mt);
    const float m_new = fmaxf(m_old, mt), sc = __builtin_amdgcn_exp2f(m_old - m_new);
    float ls = 0.f;
#pragma unroll
    for (int j = 0; j < 5; ++j) if (j >= j0) {
#pragma unroll
        for (int i = 0; i < 16; ++i) { const float e = __builtin_amdgcn_exp2f(st[j][i] - m_new); st[j][i] = e; ls += e; } }
    ls = xor_add<32>(ls);
    const float l_new = l_old * sc + ls;
    if (PASS > 0) {
#pragma unroll
        for (int dt = 0; dt < 2; ++dt)
#pragma unroll
            for (int i = 0; i < 16; ++i) O[dt][i] *= sc; }
#pragma unroll
    for (int j = 0; j < 5; ++j) {
        bf16x8 vc[4];
#pragma unroll
        for (int d0 = 0; d0 < 4; ++d0) vc[d0] = vn[d0];
        if (j < 4) { const bf16_t* vp = proj + 5 * TSQ + DIL_ROW(j + 1) * 512 + head * 64 + 8 * hi;
#pragma unroll
            for (int d0 = 0; d0 < 4; ++d0) vn[d0] = *(const bf16x8*)(vp + 16 * d0); }
        if (j >= j0) {
#pragma unroll
            for (int d0 = 0; d0 < 4; ++d0) {
#pragma unroll
                for (int e = 0; e < 8; ++e) vts[(16 * d0 + 8 * hi + e) * 36 + r32] = vc[d0][e]; }
            WAVE_LDS_SYNC();
#pragma unroll
            for (int cc = 0; cc < 2; ++cc) {
                u32x4 pw; pw.x = pk2(st[j][8 * cc + 0], st[j][8 * cc + 1]); pw.y = pk2(st[j][8 * cc + 2], st[j][8 * cc + 3]); pw.z = pk2(st[j][8 * cc + 4], st[j][8 * cc + 5]); pw.w = pk2(st[j][8 * cc + 6], st[j][8 * cc + 7]);
                const bf16x8 pf = __builtin_bit_cast(bf16x8, pw);
#pragma unroll
                for (int dt = 0; dt < 2; ++dt) { const short* vr = vts + (r32 + 32 * dt) * 36 + 16 * cc + 4 * hi;
                    const s16x4 lo = *(const s16x4*)vr, h4 = *(const s16x4*)(vr + 8);
                    const bf16x8 vf = (bf16x8){lo[0], lo[1], lo[2], lo[3], h4[0], h4[1], h4[2], h4[3]};
                    O[dt] = __builtin_amdgcn_mfma_f32_32x32x16_bf16(vf, pf, O[dt], 0, 0, 0); }
            }
            WAVE_LDS_SYNC();
        }
    }
#undef DIL_ROW
    if (PASS < 2) {
#pragma unroll
        for (int dt = 0; dt < 2; ++dt)
#pragma unroll
            for (int i4 = 0; i4 < 4; ++i4) *(f32x4*)(ap + 32 * dt + 8 * i4) = (f32x4){O[dt][4 * i4], O[dt][4 * i4 + 1], O[dt][4 * i4 + 2], O[dt][4 * i4 + 3]};
        if (hi == 0) { mst[sidx] = m_new; lst[sidx] = l_new; }
    } else {
        const float inv = 1.0f / l_new; bf16_t* yp = ymix + (size_t)rowq * 1024 + 512 + head * 64 + 4 * hi;
#pragma unroll
        for (int dt = 0; dt < 2; ++dt)
#pragma unroll
            for (int i4 = 0; i4 < 4; ++i4) { u32x2 w; w.x = pk2(O[dt][4 * i4] * inv, O[dt][4 * i4 + 1] * inv); w.y = pk2(O[dt][4 * i4 + 2] * inv, O[dt][4 * i4 + 3] * inv); *(u32x2*)(yp + 32 * dt + 8 * i4) = w; }
    }
}
template <int PASS> __device__ __forceinline__ void dil_pass(int dilv, const bf16_t* proj, float* accst, float* mst, float* lst, bf16_t* ymix, unsigned char* lds, int wid, int lane, int gw, int ngw) {
    short* vts = (short*)(lds + wid * 4608);
    for (int u = gw; u < 8192; u += ngw) dil_unit<PASS>(u, dilv, proj, accst, mst, lst, ymix, vts, lane);
}

__device__ __forceinline__ void s5_coef(float lr, float li, float dt, float& ar, float& ai, float& cr, float& ci) {
    const float mag = expf(lr * dt); const float th = li * dt; const float kq = rintf(th * 0.15915494309189535f);
    float rr = fmaf(-kq, 6.2831854820251465f, th); rr = fmaf(-kq, -1.7484556000744883e-07f, rr);
    const float sn = __sinf(rr), cs = __cosf(rr); ar = mag * cs; ai = mag * sn;
    const float den = lr * lr + li * li, nr = ar - 1.f, ni = ai; cr = (nr * lr + ni * li) / den; ci = (ni * lr - nr * li) / den;
}
__device__ __forceinline__ float gelu_tanh(float x) { const float z = 1.5957691216057308f * (x + 0.044715f * x * x * x); return x * __builtin_amdgcn_rcpf(1.0f + __expf(-z)); }

}
#ifndef RP_ATTN
#define RP_ATTN 1
#define RP_DIL 1
#define RP_S5 1
#define RP_BAR 1
#define RP_UP 1
#define RP_PRO 1
#define RP_INP 1
#define RP_PP 1
#define RP_ELT 1
#define RP_OUT 1
#define RP_DOWN 1
#define RP_PLE 1
#define RP_GLU 1
#endif
namespace mk {
#define GAS __attribute__((address_space(1)))
struct DParams { GAS const float* in[29]; GAS float* out; GAS unsigned char* ws; };
typedef const __attribute__((address_space(4))) DParams* KArgs;
__device__ __forceinline__ void s5_phase(KArgs p, int o, const bf16_t* proj, bf16_t* yg, unsigned char* lds, int tid, int lane, int wid, int G, int bid) {
    constexpr int TC = 64, NCH = S / TC, BUP = 132, XP = 136;
    float* Bu = (float*)lds;
    bf16_t* Xs = (bf16_t*)(lds + 2 * TC * BUP * 4);
    const int r32 = lane & 31, hi = lane >> 5, l16 = lane & 15, kq = lane >> 4;
    for (int bg = bid; bg < 256; bg += G) {
        const int b = bg >> 5, g = bg & 31, og = o * 32 + g;
        const float* lam_re = (const float*)p->in[18] + og * 64; const float* lam_im = (const float*)p->in[19] + og * 64; const float dt = expf(p->in[20][og]);
        const float* b_re = (const float*)p->in[21] + (size_t)og * 1024; const float* b_im = (const float*)p->in[22] + (size_t)og * 1024;
        const float* c_re = (const float*)p->in[23] + (size_t)og * 1024; const float* c_im = (const float*)p->in[24] + (size_t)og * 1024; const float* dsk = (const float*)p->in[25] + og * 16;
        const bf16_t* ub = proj + (size_t)b * S * 2048 + g * 16;
        float ar = 0.f, ai = 0.f, xr = 0.f, xi = 0.f;
        bf16x8 Bf[4], Cf[4]; float dsc = 0.f;
        if (wid == 0) { float cr, ci; s5_coef(lam_re[lane], lam_im[lane], dt, ar, ai, cr, ci); }
        else {
#pragma unroll
            for (int nt = 0; nt < 4; ++nt) { const int pp = 16 * nt + (r32 >> 1); float a0, a1, cr, ci; s5_coef(lam_re[pp], lam_im[pp], dt, a0, a1, cr, ci);
                const f32x4 br0 = *(const f32x4*)(b_re + pp * 16 + 8 * hi), br1 = *(const f32x4*)(b_re + pp * 16 + 8 * hi + 4);
                const f32x4 bi0 = *(const f32x4*)(b_im + pp * 16 + 8 * hi), bi1 = *(const f32x4*)(b_im + pp * 16 + 8 * hi + 4);
                f32x4 v0, v1; if (r32 & 1) { v0 = cr * bi0 + ci * br0; v1 = cr * bi1 + ci * br1; } else { v0 = cr * br0 - ci * bi0; v1 = cr * br1 - ci * bi1; }
                u32x4 w; w.x = pk2(v0[0], v0[1]); w.y = pk2(v0[2], v0[3]); w.z = pk2(v1[0], v1[1]); w.w = pk2(v1[2], v1[3]); Bf[nt] = __builtin_bit_cast(bf16x8, w); }
#pragma unroll
            for (int ks = 0; ks < 4; ++ks) { const int p0 = 16 * ks + 4 * kq; const f32x4 cr4 = *(const f32x4*)(c_re + l16 * 64 + p0), ci4 = *(const f32x4*)(c_im + l16 * 64 + p0);
                u32x4 w; w.x = pk2(cr4[0], -ci4[0]); w.y = pk2(cr4[1], -ci4[1]); w.z = pk2(cr4[2], -ci4[2]); w.w = pk2(cr4[3], -ci4[3]); Cf[ks] = __builtin_bit_cast(bf16x8, w); }
            dsc = dsk[l16];
        }
#define S5_LDU(k, tt) (*(const bf16x8*)(ub + (size_t)(((k) < NCH ? (k) : NCH - 1) * TC + 32 * (tt) + r32) * 2048 + 8 * hi))
#define S5_BU(k) do { float* Bb = Bu + ((k) & 1) * TC * BUP; \
        { const int tile = wid - 1, tt = tile >> 2, nt = tile & 3; \
            const f32x16 a = __builtin_amdgcn_mfma_f32_32x32x16_bf16(ufa, nt == 0 ? Bf[0] : nt == 1 ? Bf[1] : nt == 2 ? Bf[2] : Bf[3], f32x16{}, 0, 0, 0); \
            _Pragma("unroll") for (int i = 0; i < 16; ++i) Bb[(32 * tt + crow(i, hi)) * BUP + 32 * nt + r32] = a[i]; } \
        if (wid == 1) { const f32x16 a = __builtin_amdgcn_mfma_f32_32x32x16_bf16(ufb, Bf[3], f32x16{}, 0, 0, 0); \
            _Pragma("unroll") for (int i = 0; i < 16; ++i) Bb[(32 + crow(i, hi)) * BUP + 96 + r32] = a[i]; } \
        ufa = S5_LDU((k) + 1, (wid - 1) >> 2); if (wid == 1) ufb = S5_LDU((k) + 1, 1); } while (0)
#define S5_LDUU(k) do { if (wid <= 4) { _Pragma("unroll") for (int j = 0; j < 4; ++j) uun[j] = proj[((size_t)b * S + ((k) < NCH ? (k) : NCH - 1) * TC + 16 * (wid - 1) + 4 * kq + j) * 2048 + g * 16 + l16]; } } while (0)
#define S5_CP(k) do { const bf16_t* Xb = Xs + ((k) & 1) * TC * XP; \
        if (wid <= 4) { const int tile = wid - 1; f32x4 a = (f32x4){0.f, 0.f, 0.f, 0.f}; \
            _Pragma("unroll") for (int ks = 0; ks < 4; ++ks) { const bf16x8 xf = *(const bf16x8*)(Xb + (16 * tile + l16) * XP + 32 * ks + 8 * kq); \
                a = __builtin_amdgcn_mfma_f32_16x16x32_bf16(xf, Cf[ks], a, 0, 0, 0); } \
            _Pragma("unroll") for (int j = 0; j < 4; ++j) { const size_t tok = (size_t)b * S + (k) * TC + 16 * tile + 4 * kq + j; \
                const float y = gelu_tanh(a[j] + dsc * bf1(uun[j])); \
                yg[tok * 512 + g * 16 + l16] = (bf16_t)(pk2(y, 0.f) & 0xffffu); } } \
        S5_LDUU((k) + 1); } while (0)
        bf16x8 ufa = bf16x8{}, ufb = bf16x8{}; bf16_t uun[4] = {0, 0, 0, 0};
        if (wid > 0) { ufa = S5_LDU(0, (wid - 1) >> 2); if (wid == 1) ufb = S5_LDU(0, 1); S5_LDUU(0); S5_BU(0); }
        __syncthreads();
        for (int k = 0; k < NCH; ++k) {
            if (wid == 0) {
                const float* Bb = Bu + (k & 1) * TC * BUP; bf16_t* Xb = Xs + (k & 1) * TC * XP;
                for (int t0 = 0; t0 < TC; t0 += 16) { f32x2_t bv[16];
#pragma unroll
                    for (int j = 0; j < 16; ++j) bv[j] = *(const f32x2_t*)(Bb + (t0 + j) * BUP + 2 * lane);
#pragma unroll
                    for (int j = 0; j < 16; ++j) { const float nr = fmaf(ar, xr, fmaf(-ai, xi, bv[j].x)), ni = fmaf(ar, xi, fmaf(ai, xr, bv[j].y)); xr = nr; xi = ni;
                        *(unsigned*)(Xb + (t0 + j) * XP + 2 * lane) = pk2(xr, xi); } }
            } else {
                if (k + 1 < NCH) S5_BU(k + 1);
                if (k >= 1) S5_CP(k - 1);
            }
            __syncthreads();
        }
        if (wid > 0) S5_CP(NCH - 1);
        __syncthreads();
#undef S5_BU
#undef S5_LDU
#undef S5_LDUU
#undef S5_CP
    }
}
__device__ __forceinline__ void conv_phase(const float* cw, const bf16_t* proj, bf16_t* ymix, int gtid, int nthr) {
    for (int idx = gtid; idx < T * 64; idx += nthr) { const int t = idx >> 6, c8 = (idx & 63) * 8, s = t & (S - 1);
        const bf16_t* row = proj + (size_t)t * 2048;
        float y[8];
#pragma unroll
        for (int e = 0; e < 8; ++e) y[e] = 0.f;
#pragma unroll
        for (int j = 0; j < 3; ++j) if (s - j >= 0) { const u32x4 gc = *(const u32x4*)(row - (size_t)j * 2048 + 1024 + c8), xt = *(const u32x4*)(row - (size_t)j * 2048 + 1536 + c8);
            const f32x4 w0 = *(const f32x4*)(cw + j * 512 + c8), w1 = *(const f32x4*)(cw + j * 512 + c8 + 4);
            y[0] += w0[0] * bflo(gc.x) * bflo(xt.x); y[1] += w0[1] * bfhi(gc.x) * bfhi(xt.x); y[2] += w0[2] * bflo(gc.y) * bflo(xt.y); y[3] += w0[3] * bfhi(gc.y) * bfhi(xt.y);
            y[4] += w1[0] * bflo(gc.z) * bflo(xt.z); y[5] += w1[1] * bfhi(gc.z) * bfhi(xt.z); y[6] += w1[2] * bflo(gc.w) * bflo(xt.w); y[7] += w1[3] * bfhi(gc.w) * bfhi(xt.w); }
        const u32x4 gb = *(const u32x4*)(row + 512 + c8); u32x4 o;
        o.x = pk2(y[0] * bflo(gb.x), y[1] * bfhi(gb.x)); o.y = pk2(y[2] * bflo(gb.y), y[3] * bfhi(gb.y)); o.z = pk2(y[4] * bflo(gb.z), y[5] * bfhi(gb.z)); o.w = pk2(y[6] * bflo(gb.w), y[7] * bfhi(gb.w));
        *(u32x4*)(ymix + (size_t)t * 1024 + 512 + c8) = o; }
}
__device__ __forceinline__ void diff_post(KArgs p, int e, float lam_init, const bf16_t* O16, bf16_t* ymix, int lane, int gtid, int nthr) {
    float a = p->in[11][e * 64 + lane] * p->in[12][e * 64 + lane], bb = p->in[13][e * 64 + lane] * p->in[14][e * 64 + lane];
    a = wave_sum(a); bb = wave_sum(bb);
    const float lam = expf(a) - expf(bb) + lam_init; const float* gain = (const float*)p->in[15] + e * 128;
    const int j = gtid & 15, vhalf = j >> 3, dd = (j & 7) * 8;
    const f32x4 g0 = *(const f32x4*)(gain + 8 * j), g1 = *(const f32x4*)(gain + 8 * j + 4);
    for (int grp = gtid >> 4; grp < T * 4; grp += nthr >> 4) { const int t = grp >> 2, h = grp & 3;
        const u32x4 o1 = *(const u32x4*)(O16 + (size_t)t * 1024 + ((h * 2 + 0) * 2 + vhalf) * 64 + dd), o2 = *(const u32x4*)(O16 + (size_t)t * 1024 + ((h * 2 + 1) * 2 + vhalf) * 64 + dd);
        float v[8];
        v[0] = bflo(o1.x) - lam * bflo(o2.x); v[1] = bfhi(o1.x) - lam * bfhi(o2.x); v[2] = bflo(o1.y) - lam * bflo(o2.y); v[3] = bfhi(o1.y) - lam * bfhi(o2.y);
        v[4] = bflo(o1.z) - lam * bflo(o2.z); v[5] = bfhi(o1.z) - lam * bfhi(o2.z); v[6] = bflo(o1.w) - lam * bflo(o2.w); v[7] = bfhi(o1.w) - lam * bfhi(o2.w);
        float ss = 0.f;
#pragma unroll
        for (int q = 0; q < 8; ++q) ss += v[q] * v[q];
        ss = xor_add<1>(ss); ss = xor_add<2>(ss); ss = xor_add<4>(ss); ss = xor_add<8>(ss);
        const float rs = rsqrtf(ss * (1.0f / 128.0f) + 1e-5f) * (1.0f - lam_init);
        u32x4 o; o.x = pk2(v[0] * rs * g0[0], v[1] * rs * g0[1]); o.y = pk2(v[2] * rs * g0[2], v[3] * rs * g0[3]); o.z = pk2(v[4] * rs * g1[0], v[5] * rs * g1[1]); o.w = pk2(v[6] * rs * g1[2], v[7] * rs * g1[3]);
        *(u32x4*)(ymix + (size_t)t * 1024 + h * 128 + 8 * j) = o; }
}

__device__ __forceinline__ KArgs kargs() { KArgs k = (KArgs)__builtin_amdgcn_kernarg_segment_ptr(); asm volatile("" : "+s"(k)); return k; }
constexpr size_t WS_BAR = WS_WM + 8 * MiB + 6 * MiB + MiB / 2;
constexpr int LDS_XB = 131072 + 1024;
#define LAS __attribute__((address_space(3)))
#define XB_TMO      128
#define XB_XCNT(j)  (256  + 64 * (j))
#define XB_XSUB(j)  (1280 + 64 * (j))
#define XB_XGEN(j)  (2304 + 64 * (j))
#define XB_TOP      3328
#define XB_TOPGEN   3392
#define XCD_BAR_WORDS 3456
#define XB_SPIN_CAP (1u << 18)

__device__ __forceinline__ unsigned xb_ld(unsigned* p)              { return __hip_atomic_load(p, __ATOMIC_RELAXED, __HIP_MEMORY_SCOPE_AGENT); }
__device__ __forceinline__ unsigned xb_add(unsigned* p, unsigned v) { return __hip_atomic_fetch_add(p, v, __ATOMIC_RELAXED, __HIP_MEMORY_SCOPE_AGENT); }
__device__ __forceinline__ unsigned xb_xcc_id() { return (unsigned)__builtin_amdgcn_s_getreg((3 << 11) | 20) & 0xFu; }
#define XB_SPIN(cond, bar) do { unsigned _sp = 0; while (cond) { __builtin_amdgcn_s_sleep(1); \
    if ((++_sp & 255u) == 0u) { if (xb_ld(&(bar)[XB_TMO])) break; if (_sp > XB_SPIN_CAP) { atomicAdd(&(bar)[XB_TMO], 1u); break; } } } } while (0)

struct XcdBarrier {
    unsigned* bar; unsigned x;
    volatile LAS unsigned* st;
};

__device__ __forceinline__ XcdBarrier xcd_barrier_post(unsigned* bar, volatile LAS unsigned* st) {
    XcdBarrier b; b.bar = bar; b.x = xb_xcc_id(); b.st = st;
    if (threadIdx.x == 0) (void)xb_add(&bar[XB_XCNT(b.x)], 1u);
    return b;
}
__device__ __forceinline__ void xcd_barrier_complete(unsigned* bar, unsigned x, unsigned& nloc, unsigned& nx) {
    const unsigned G = gridDim.x * gridDim.y * gridDim.z;
    unsigned sum, cnt, mine, sp = 0u;
    for (;;) {
        sum = 0u; cnt = 0u; mine = 0u;
#pragma unroll
        for (unsigned j = 0; j < 16; ++j) { const unsigned c = xb_ld(&bar[XB_XCNT(j)]); sum += c; cnt += (c > 0u) ? 1u : 0u; mine = (j == x) ? c : mine; }
        if (sum == G) break;
        __builtin_amdgcn_s_sleep(1);
        if ((++sp & 255u) == 0u) { if (xb_ld(&bar[XB_TMO])) break; if (sp > XB_SPIN_CAP) { atomicAdd(&bar[XB_TMO], 1u); break; } }
    }
    nloc = mine > 0u ? mine : 1u; nx = cnt > 0u ? cnt : 1u;
}

__device__ __forceinline__ void xcd_barrier(const XcdBarrier& b) {
    asm volatile("s_waitcnt vmcnt(0)" ::: "memory");
    __syncthreads();
    if (threadIdx.x == 0) {
        unsigned* bar = b.bar;
        __builtin_amdgcn_s_waitcnt(0);
        unsigned nloc = b.st[0], nx = b.st[1];
        if (nloc == 0u) { xcd_barrier_complete(bar, b.x, nloc, nx); b.st[0] = nloc; b.st[1] = nx; }
        const unsigned old = xb_add(&bar[XB_XSUB(b.x)], 1u);
        const unsigned gen = old / nloc;
        if (old + 1u == (gen + 1u) * nloc) {
            __builtin_amdgcn_fence(__ATOMIC_RELEASE, "agent");
            asm volatile("s_waitcnt vmcnt(0)" ::: "memory");
            const unsigned og = xb_add(&bar[XB_TOP], 1u);
            const unsigned tg = og / nx;
            if (og + 1u == (tg + 1u) * nx) xb_add(&bar[XB_TOPGEN], 1u);
            else XB_SPIN(xb_ld(&bar[XB_TOPGEN]) == tg, bar);
            __builtin_amdgcn_fence(__ATOMIC_ACQUIRE, "agent");
            xb_add(&bar[XB_XGEN(b.x)], 1u);
            asm volatile("s_waitcnt vmcnt(0)" ::: "memory");
        } else {
            XB_SPIN(xb_ld(&bar[XB_XGEN(b.x)]) == gen, bar);
            __builtin_amdgcn_fence(__ATOMIC_ACQUIRE, "agent");
            asm volatile("s_waitcnt vmcnt(0)" ::: "memory");
        }
    }
    __syncthreads();
}

__device__ __forceinline__ void grid_bar1(unsigned) {
    XcdBarrier xbv; xbv.bar = (unsigned*)((unsigned char*)kargs()->ws + WS_BAR); xbv.x = xb_xcc_id(); xbv.st = (volatile LAS unsigned*)(LDS_XB);
    xcd_barrier(xbv);
}
__device__ __forceinline__ void grid_bar(unsigned epoch) { for (int rp = 0; rp < RP_BAR; ++rp) grid_bar1(epoch); }
#define PH_BEGIN KArgs ka = kargs(); unsigned char* ws = (unsigned char*)ka->ws; int tid = threadIdx.x; asm volatile("" : "+v"(tid)); int bid = blockIdx.x; asm volatile("" : "+s"(bid)); const int lane = tid & 63, wid = __builtin_amdgcn_readfirstlane(tid >> 6), G = gridDim.x; \
    const int gw = bid * 8 + wid, ngw = G * 8, gtid = bid * 512 + tid, nthr = G * 512; (void)lane; (void)gw; (void)ngw; (void)gtid; (void)nthr; (void)ws;
#define WL(i) (ws + WS_W + (size_t)(i) * WS_WL)
#define WM(i) (ws + WS_WM + (size_t)(i) * 8 * MiB)
#define SBUF(j) ((bf16_t*)ka->out + (size_t)((j) & 1) * T * 1024)
#define SSQ(k) ((float*)(ws + WS_SSQ + (size_t)((k) & 1) * 2 * MiB))
template <int i> __device__ __forceinline__ void layer_body(unsigned char* lds, PG8_LAS unsigned char* ldsp) {
    unsigned ep = (i == 0 ? 0u : i == 1 ? 8u : i == 2 ? 15u : 23u);
        for (int rp = 0; rp < RP_INP; ++rp) { PH_BEGIN const bool odd = (i & 1) != 0; const int N = odd ? 2048 : 3072;
            pg8::Gemm g{SBUF(i), (const bf16_t*)WM(i), T, N, 1024};     pg8::StaticOrder SO; SO.init(T, N, G, bid);
            pg8::EpiRow<0> E{(bf16_t*)(ws + WS_BIG), odd ? 2048 : 512, SSQ(3 * i), odd ? 0u : 0xC3u, C2, odd ? 0 : 512, TSQ};
            pg8::gemm_phase<pg8::EpiRow<0>, pg8::StaticOrder, true, true>(ldsp, g, SO, E); }
        grid_bar(++ep);
        if ((i & 1) == 0) {
            { PH_BEGIN const int vcu0 = (G % 8 == 0) ? (bid % 8) * (G / 8) + (bid / 8) : bid;
                for (int rp = 0; rp < RP_ATTN; ++rp) for (int vcu = vcu0; vcu < 256; vcu += G) { const int pair = vcu >> 1, s = vcu & 1, b = pair >> 4, vh = pair & 15, h = vh >> 2, c = (vh >> 1) & 1, vhalf = vh & 1;
                    for (int it = 0; it < 8; ++it) { const int j = s + 2 * (it >> 1), qb = (it & 1) ? 15 - j : j;
                        const attn_body::bf16* P = (const attn_body::bf16*)((unsigned char*)kargs()->ws + WS_BIG);
                        attn_body::attn_unit<8>(b, 0, qb, P + h * 128 + c * 64, P + TSQ + h * 128 + c * 64, P + 2 * TSQ + h * 128 + vhalf * 64, (attn_body::bf16*)((unsigned char*)kargs()->ws + WS_O16) + vh * 64, (char*)lds); } } }
            __syncthreads();
            { PH_BEGIN float* dm = (float*)(ws + WS_DML);
                for (int rp = 0; rp < RP_DIL; ++rp) dil_pass<0>(1, (const bf16_t*)(ws + WS_BIG), (float*)(ws + WS_HB), dm, dm + (size_t)T * 8, (bf16_t*)(ws + WS_YMIX), lds, wid, lane, gw, ngw);
                convert_p((const float*)ka->in[1] + (size_t)i * T * 256, (bf16_t*)(ws + WS_PB), gtid, nthr); }
            grid_bar(++ep);
            { PH_BEGIN float* dm = (float*)(ws + WS_DML);
                dil_pass<1>(4, (const bf16_t*)(ws + WS_BIG), (float*)(ws + WS_HB), dm, dm + (size_t)T * 8, (bf16_t*)(ws + WS_YMIX), lds, wid, lane, gw, ngw); }
            grid_bar(++ep);
            { PH_BEGIN float* dm = (float*)(ws + WS_DML);
                dil_pass<2>(16, (const bf16_t*)(ws + WS_BIG), (float*)(ws + WS_HB), dm, dm + (size_t)T * 8, (bf16_t*)(ws + WS_YMIX), lds, wid, lane, gw, ngw); }
            { PH_BEGIN const float lam_init = 0.8f - 0.6f * expf(-0.3f * (float)i);
                for (int rp = 0; rp < RP_ELT; ++rp) diff_post(ka, i >> 1, lam_init, (const bf16_t*)(ws + WS_O16), (bf16_t*)(ws + WS_YMIX), lane, gtid, nthr); }
            grid_bar(++ep);
        } else {
            for (int rp = 0; rp < RP_S5; ++rp) { PH_BEGIN s5_phase(ka, i >> 1, (const bf16_t*)(ws + WS_BIG), (bf16_t*)(ws + WS_HB), lds, tid, lane, wid, G, bid); }
            for (int rp = 0; rp < RP_ELT; ++rp) { PH_BEGIN conv_phase((const float*)ka->in[27] + (i >> 1) * 3 * 512, (const bf16_t*)(ws + WS_BIG), (bf16_t*)(ws + WS_YMIX), gtid, nthr);
                convert_p((const float*)ka->in[1] + (size_t)i * T * 256, (bf16_t*)(ws + WS_PB), gtid, nthr); }
            grid_bar(++ep);
            for (int rp = 0; rp < RP_GLU; ++rp) { PH_BEGIN pg8::Gemm g{(const bf16_t*)(ws + WS_HB), (const bf16_t*)(WM(i) + 6 * MiB), T, 512, 512}; pg8::StaticOrder SO; SO.init(T, 512, G, bid);
                pg8::EpiGlu E{(bf16_t*)(ws + WS_YMIX), (const bf16_t*)(ws + WS_HB)};
                pg8::gemm_phase<pg8::EpiGlu, pg8::StaticOrder, true, true>(ldsp, g, SO, E); }
            grid_bar(++ep);
        }
        for (int rp = 0; rp < RP_OUT; ++rp) { PH_BEGIN const bool odd = (i & 1) != 0;
            pg8::Gemm g{(const bf16_t*)(ws + WS_YMIX), (const bf16_t*)(WM(i) + (odd ? 4 : 6) * MiB), T, 1024, 1024}; pg8::StaticOrder SO; SO.init(T, 1024, G, bid);
            pg8::EpiRes<0> E{SBUF(i), (rp < RP_OUT - 1) ? (bf16_t*)(ws + WS_HB) : SBUF(i), SSQ(3 * i + 1), nullptr, nullptr};
            pg8::gemm_phase<pg8::EpiRes<0>, pg8::StaticOrder, true, true>(ldsp, g, SO, E); }
        grid_bar(++ep);
        for (int rp = 0; rp < RP_UP; ++rp) { PH_BEGIN pg8::Gemm g{SBUF(i), (const bf16_t*)WL(i), T, 4096, 1024}; pg8::StaticOrder SO; SO.init(T, 4096, G, bid);
            pg8::EpiRow<1> E{(bf16_t*)(ws + WS_BIG), 4096, SSQ(3 * i + 1), 0u, 1.f, 0, 0};
            pg8::gemm_phase<pg8::EpiRow<1>, pg8::StaticOrder, true, true>(ldsp, g, SO, E); }
        for (int rp = 0; rp < RP_PP; ++rp) { PH_BEGIN pg8::Gemm g{(const bf16_t*)(ws + WS_PB), (const bf16_t*)(WL(i) + 18 * MiB), T, 1024, 256}; pg8::StaticOrder SO; SO.init(T, 1024, G, bid);
            pg8::EpiPP E{(bf16_t*)(ws + WS_YMIX)};
            pg8::gemm_phase<pg8::EpiPP, pg8::StaticOrder, true, true>(ldsp, g, SO, E); }
        grid_bar(++ep);
        for (int rp = 0; rp < RP_DOWN; ++rp) { PH_BEGIN pg8::Gemm g{(const bf16_t*)(ws + WS_BIG), (const bf16_t*)(WL(i) + 8 * MiB), T, 1024, 4096}; pg8::StaticOrder SO; SO.init(T, 1024, G, bid);
            pg8::EpiRes<0> E{SBUF(i), (rp < RP_DOWN - 1) ? (bf16_t*)(ws + WS_HB) : SBUF(i), SSQ(3 * i + 2), nullptr, nullptr};
            pg8::gemm_phase<pg8::EpiRes<0>, pg8::StaticOrder, true, true>(ldsp, g, SO, E); }
        grid_bar(++ep);
        for (int rp = 0; rp < RP_PLE; ++rp) { PH_BEGIN pg8::Gemm g{SBUF(i), (const bf16_t*)(WL(i) + 16 * MiB), T, 1024, 1024}; pg8::StaticOrder SO; SO.init(T, 1024, G, bid);
            pg8::EpiRes<1> E{SBUF(i), (rp < RP_PLE - 1) ? (bf16_t*)(ws + WS_BIG) : (i == 3) ? (bf16_t*)(ws + WS_HB) : SBUF(i + 1), SSQ(3 * i + 3), SSQ(3 * i + 2), (const bf16_t*)(ws + WS_YMIX)};
            pg8::gemm_phase<pg8::EpiRes<1>, pg8::StaticOrder, true, true>(ldsp, g, SO, E); }
        grid_bar(++ep);
}
__global__ void __launch_bounds__(512, 2) fwd(Params p_unused) {
    extern __shared__ __attribute__((aligned(16))) unsigned char lds[];
    PG8_LAS unsigned char* ldsp = (PG8_LAS unsigned char*)lds;
    for (int rp = 0; rp < RP_PRO; ++rp) {
    { PH_BEGIN
        float* ssq = SSQ(0); bf16_t* hb = SBUF(0); const float* x = (const float*)ka->in[0];
        { f32x4 vn[4]; int m = gw;
            if (m < T) { const f32x4* xr = (const f32x4*)(x + (size_t)m * 1024) + lane;
#pragma unroll
                for (int j = 0; j < 4; ++j) vn[j] = __builtin_nontemporal_load(xr + 64 * j); }
            for (; m < T; m += ngw) { f32x4 v[4]; float s = 0.f;
#pragma unroll
                for (int j = 0; j < 4; ++j) v[j] = vn[j];
                if (m + ngw < T) { const f32x4* xn = (const f32x4*)(x + (size_t)(m + ngw) * 1024) + lane;
#pragma unroll
                    for (int j = 0; j < 4; ++j) vn[j] = __builtin_nontemporal_load(xn + 64 * j); }
#pragma unroll
                for (int j = 0; j < 4; ++j) s += (v[j][0] * v[j][0] + v[j][1] * v[j][1]) + (v[j][2] * v[j][2] + v[j][3] * v[j][3]);
                s = wave_sum(s); if (lane < 16) ssq[(size_t)m * 16 + lane] = (lane == 0) ? s : 0.f;
                u32x2* o8 = (u32x2*)(hb + (size_t)m * 1024) + lane;
#pragma unroll
                for (int j = 0; j < 4; ++j) { u32x2 w; w.x = pk2(v[j][0], v[j][1]); w.y = pk2(v[j][2], v[j][3]); o8[64 * j] = w; } } } }
    for (int i = 0; i < 4; ++i) { PH_BEGIN
        float* scr = (float*)(lds + wid * 8448); unsigned char* wl = WL(i); unsigned char* wm = WM(i); const int e = i >> 1;
        transpose_items((const float*)ka->in[5] + (size_t)i * 1024 * 4096, 1024, 4096, (const float*)ka->in[3] + i * 1024, (bf16_t*)wl, scr, gw, ngw, lane);
        transpose_items((const float*)ka->in[6] + (size_t)i * 1024 * 4096, 4096, 1024, nullptr, (bf16_t*)(wl + 8 * MiB), scr, gw, ngw, lane);
        transpose_items((const float*)ka->in[8] + (size_t)i * 1024 * 1024, 1024, 1024, (const float*)ka->in[4] + i * 1024, (bf16_t*)(wl + 16 * MiB), scr, gw, ngw, lane);
        transpose_items((const float*)ka->in[7] + (size_t)i * 256 * 1024, 256, 1024, nullptr, (bf16_t*)(wl + 18 * MiB), scr, gw, ngw, lane);
        if ((i & 1) == 0) {
            transpose_items((const float*)ka->in[9] + (size_t)e * 1024 * 3072, 1024, 3072, (const float*)ka->in[2] + i * 1024, (bf16_t*)wm, scr, gw, ngw, lane);
            transpose_items((const float*)ka->in[10] + (size_t)e * 1024 * 1024, 1024, 1024, nullptr, (bf16_t*)(wm + 6 * MiB), scr, gw, ngw, lane);
        } else {
            transpose_items((const float*)ka->in[16] + (size_t)e * 1024 * 2048, 1024, 2048, (const float*)ka->in[2] + i * 1024, (bf16_t*)wm, scr, gw, ngw, lane);
            transpose_items((const float*)ka->in[17] + (size_t)e * 1024 * 1024, 1024, 1024, nullptr, (bf16_t*)(wm + 4 * MiB), scr, gw, ngw, lane);
            transpose_items((const float*)ka->in[26] + (size_t)e * 512 * 512, 512, 512, nullptr, (bf16_t*)(wm + 6 * MiB), scr, gw, ngw, lane);
        } }
    }
    { KArgs ka0 = kargs(); unsigned* bw = (unsigned*)((unsigned char*)ka0->ws + WS_BAR);
        if (blockIdx.x == 0) for (int w = threadIdx.x; w < XCD_BAR_WORDS; w += 512) __hip_atomic_store(bw + w, 0u, __ATOMIC_RELAXED, __HIP_MEMORY_SCOPE_AGENT);
        if (threadIdx.x < 2) ((volatile LAS unsigned*)(LDS_XB))[threadIdx.x] = 0u; }
    cg::this_grid().sync();
    { KArgs ka0 = kargs(); (void)xcd_barrier_post((unsigned*)((unsigned char*)ka0->ws + WS_BAR), (volatile LAS unsigned*)(LDS_XB)); }
    layer_body<0>(lds, ldsp); layer_body<1>(lds, ldsp); layer_body<2>(lds, ldsp); layer_body<3>(lds, ldsp);
    { PH_BEGIN const float* gf = (const float*)ka->in[28]; const float* sq = SSQ(12); float* hf = (float*)ka->out; const bf16_t* hs = (const bf16_t*)(ws + WS_HB);
        for (int m = gw; m < T; m += ngw) { f32x4* xr = (f32x4*)(hf + (size_t)m * 1024) + lane; const u32x2* hr = (const u32x2*)(hs + (size_t)m * 1024) + lane; const float rs = rsqrtf(pg8::ssq16(sq, m) * (1.0f / 1024.0f) + 1e-6f);
#pragma unroll
            for (int j = 0; j < 4; ++j) { const f32x4 gv = ((const f32x4*)gf)[lane + 64 * j]; const u32x2 hv = hr[64 * j]; xr[64 * j] = (f32x4){bflo(hv.x), bfhi(hv.x), bflo(hv.y), bfhi(hv.y)} * rs * gv; } } }
}
}

extern "C" void kernel_launch(void* const* d_in, const int* in_sizes, int n_in, void* d_out, int out_size, void* d_ws, size_t ws_size, hipStream_t stream) {
    static int grid_blocks = 0;
    if (!grid_blocks) {
        int dev = 0, cus = 0, per_cu = 0;
        (void)hipGetDevice(&dev);
        (void)hipDeviceGetAttribute(&cus, hipDeviceAttributeMultiprocessorCount, dev);
        (void)hipFuncSetAttribute((const void*)mk::fwd, hipFuncAttributeMaxDynamicSharedMemorySize, mk::LDS_BYTES);
        (void)hipOccupancyMaxActiveBlocksPerMultiprocessor(&per_cu, (const void*)mk::fwd, 512, mk::LDS_BYTES);
        (void)hipGetLastError();
        grid_blocks = cus > 0 ? cus : 256;
        if (ws_size < mk::WS_END || n_in != 29) { fprintf(stderr, "kernel_launch: workspace %zu < %zu or n_in %d != 29\n", ws_size, (size_t)mk::WS_END, n_in); }
    }
    (void)hipMemsetAsync((unsigned char*)d_ws + mk::WS_BAR, 0, 256, stream);
    mk::Params p{};
    for (int i = 0; i < 29; ++i) p.in[i] = (const float*)d_in[i];
    p.out = (float*)d_out; p.ws = (unsigned char*)d_ws;
    void* args[] = {&p};
    hipError_t e = hipLaunchCooperativeKernel((const void*)mk::fwd, dim3(grid_blocks), dim3(512), args, mk::LDS_BYTES, stream);
    if (e != hipSuccess) fprintf(stderr, "cooperative launch failed: %s (grid %d)\n", hipGetErrorString(e), grid_blocks);
}
```

```cpp
#include <hip/hip_runtime.h>
#include <cstdio>
#include <cstdint>

template <int K> __device__ __forceinline__ float xor_add(float v) {
    if constexpr (K < 32) return v + __int_as_float(__builtin_amdgcn_ds_swizzle(__float_as_int(v), (K << 10) | 0x1f));
    else { auto rr = __builtin_amdgcn_permlane32_swap(__float_as_uint(v), __float_as_uint(v), false, false); return __uint_as_float(rr[0]) + __uint_as_float(rr[1]); }
}
template <int K> __device__ __forceinline__ float xor_max(float v) {
    if constexpr (K < 32) return fmaxf(v, __int_as_float(__builtin_amdgcn_ds_swizzle(__float_as_int(v), (K << 10) | 0x1f)));
    else { auto rr = __builtin_amdgcn_permlane32_swap(__float_as_uint(v), __float_as_uint(v), false, false); return fmaxf(__uint_as_float(rr[0]), __uint_as_float(rr[1])); }
}
namespace pg8 {
#define PG8_LAS __attribute__((address_space(3)))
typedef unsigned short bf16_t;
typedef short bf16x8 __attribute__((ext_vector_type(8)));
typedef float f32x4 __attribute__((ext_vector_type(4)));
typedef unsigned u32x4 __attribute__((ext_vector_type(4)));
constexpr int BM = 256, BK = 64, HALF = 128, HTB = HALF * BK * 2  , STAGE_BYTES = 8 * HTB, NXCD = 8, WGM = 8;

__host__ __device__ __forceinline__ int lds_byte(int r, int c) { const int st = (r >> 4) * 2 + (c >> 5), rr = r & 15, cc = c & 31, ob = rr * 64 + cc * 2; return st * 1024 + (ob ^ (((ob >> 9) & 1) << 5)); }
__host__ __device__ __forceinline__ void stage_rc(int b, int& R, int& C) { const int st = b / 1024, sb = b % 1024, swz = sb ^ (((sb >> 9) & 1) << 5); R = (st >> 1) * 16 + swz / 64; C = (st & 1) * 32 + (swz % 64) / 2; }
__host__ __device__ __forceinline__ int perm32(int rho) { const int n = rho >> 4, i = rho & 15; return 8 * (i >> 2) + 4 * n + (i & 3); }

struct Unit { int pm, pn; };
struct Gemm { const bf16_t* A; const bf16_t* Bt; int M, N, K; };

struct StaticOrder {
    int nM, nN, nwg, G, c, rev;
    __host__ __device__ void init(int M, int N, int G_, int c_) { nM = M / BM; nN = N / BM; nwg = nM * nN; G = G_; c = c_; rev = 0; }
    __host__ __device__ bool next(int i, Unit& u) const {
        const long L = (long)i * G + c; if (L >= nwg) return false;
        int wgid = (int)L; { const int q = nwg / NXCD, r = nwg % NXCD, xcd = wgid % NXCD, off = wgid / NXCD; wgid = (xcd < r ? xcd * (q + 1) : r * (q + 1) + (xcd - r) * q) + off; }
        const int nig = WGM * nN, gid = wgid / nig, fm = gid * WGM, gsz = (nM - fm) < WGM ? (nM - fm) : WGM;
        u.pm = fm + ((wgid % nig) % gsz); u.pn = (wgid % nig) / gsz; if (rev) u.pm = nM - 1 - u.pm; return true;
    }
    __device__ __forceinline__ void a_ready(const Unit&) const {}
    __device__ __forceinline__ void done(const Unit&) const {}
};

__device__ __forceinline__ unsigned cvt_pk_bf16(float lo, float hi) { unsigned r; asm volatile("v_cvt_pk_bf16_f32 %0, %1, %2" : "=v"(r) : "v"(lo), "v"(hi)); return r; }
typedef float f32x2 __attribute__((ext_vector_type(2)));
constexpr float RMS_EPS = 1e-6f;
typedef unsigned u32x2 __attribute__((ext_vector_type(2)));
__device__ __forceinline__ float sigm(float x) { return __builtin_amdgcn_rcpf(1.0f + __expf(-x)); }
__device__ __forceinline__ float bflo(unsigned w) { return __uint_as_float(w << 16); }
__device__ __forceinline__ float bfhi(unsigned w) { return __uint_as_float(w & 0xffff0000u); }
__device__ __forceinline__ float ssq16(const float* s, int r) { const f32x4* q = (const f32x4*)(s + (size_t)r * 16); const f32x4 a = q[0] + q[1], b = q[2] + q[3], c = a + b; return (c[0] + c[1]) + (c[2] + c[3]); }
template <int ACT> struct EpiRow {
    static constexpr bool PERM = true, AFTER_DRAIN = false;
    bf16_t* O; int ldc; const float* ssq; unsigned qmask; float qscale; int split_cols; size_t split_stride;
    __device__ __forceinline__ void operator()(const f32x4 (&acc)[2][2][4][2], const Unit& u, int wr, int wc, int fr, int fq) const {
        int colt = u.pn * BM; bf16_t* Ob = O; if (split_cols) { const int t = colt / split_cols; Ob += (size_t)t * split_stride; colt -= t * split_cols; }
        const int row0 = u.pm * BM + wr * 64 + fr, col0 = colt + wc * 32 + 8 * fq;
        const float cs = ((qmask >> u.pn) & 1u) ? qscale : 1.f;
#pragma unroll
        for (int ai = 0; ai < 2; ++ai)
#pragma unroll
            for (int m = 0; m < 4; ++m) { const int r = row0 + ai * HALF + m * 16; const float rs = rsqrtf(ssq16(ssq, r) * (1.0f / 1024.0f) + RMS_EPS) * cs;
                bf16_t* rowp = Ob + (size_t)r * ldc + col0;
#pragma unroll
                for (int bj = 0; bj < 2; ++bj) { f32x4 v0 = acc[ai][bj][m][0] * rs, v1 = acc[ai][bj][m][1] * rs;
                    if (ACT == 1) {
#pragma unroll
                        for (int e = 0; e < 4; ++e) { const float a = fmaxf(v0[e], 0.f), b = fmaxf(v1[e], 0.f); v0[e] = a * a; v1[e] = b * b; } }
                    u32x4 w; w.x = cvt_pk_bf16(v0[0], v0[1]); w.y = cvt_pk_bf16(v0[2], v0[3]); w.z = cvt_pk_bf16(v1[0], v1[1]); w.w = cvt_pk_bf16(v1[2], v1[3]);
                    *(u32x4*)(rowp + bj * HALF) = w; } }
    }
};
template <int MODE> struct EpiRes {
    static constexpr bool PERM = false, AFTER_DRAIN = false;
    const bf16_t* base; bf16_t* outb; float* ssq_next; const float* ssq_cur; const bf16_t* pp;
    __device__ __forceinline__ void operator()(const f32x4 (&acc)[2][2][4][2], const Unit& u, int wr, int wc, int fr, int fq) const {
        const int row0 = u.pm * BM + wr * 64 + fr, col0 = u.pn * BM + wc * 32 + 4 * fq;
#pragma unroll
        for (int ai = 0; ai < 2; ++ai)
#pragma unroll
            for (int m = 0; m < 4; ++m) { const int r = row0 + ai * HALF + m * 16; const size_t off = (size_t)r * 1024 + col0; float sq = 0.f;
                float rs = 0.f; if (MODE == 1) rs = rsqrtf(ssq16(ssq_cur, r) * (1.0f / 1024.0f) + RMS_EPS);
#pragma unroll
                for (int bj = 0; bj < 2; ++bj)
#pragma unroll
                    for (int n = 0; n < 2; ++n) { const size_t o = off + bj * HALF + n * 16; f32x4 a = acc[ai][bj][m][n];
                        if (MODE == 1) { const u32x2 g = *(const u32x2*)(pp + o);
                            a[0] = bflo(g.x) * sigm(a[0] * rs); a[1] = bfhi(g.x) * sigm(a[1] * rs); a[2] = bflo(g.y) * sigm(a[2] * rs); a[3] = bfhi(g.y) * sigm(a[3] * rs); }
                        const u32x2 bv = *(const u32x2*)(base + o);
                        const f32x4 hv = (f32x4){bflo(bv.x), bfhi(bv.x), bflo(bv.y), bfhi(bv.y)} + a;
                        u32x2 w; w.x = cvt_pk_bf16(hv[0], hv[1]); w.y = cvt_pk_bf16(hv[2], hv[3]); *(u32x2*)(outb + o) = w;
                        sq += (hv[0] * hv[0] + hv[1] * hv[1]) + (hv[2] * hv[2] + hv[3] * hv[3]); }
                sq = xor_add<16>(sq); sq = xor_add<32>(sq);
                if (fq == 0) ssq_next[(size_t)r * 16 + u.pn * 4 + wc] = sq; }
    }
};
struct EpiPP {
    static constexpr bool PERM = false, AFTER_DRAIN = false;
    bf16_t* O;
    __device__ __forceinline__ void operator()(const f32x4 (&acc)[2][2][4][2], const Unit& u, int wr, int wc, int fr, int fq) const {
        const int row0 = u.pm * BM + wr * 64 + fr, col0 = u.pn * BM + wc * 32 + 4 * fq;
#pragma unroll
        for (int ai = 0; ai < 2; ++ai)
#pragma unroll
            for (int m = 0; m < 4; ++m) { const size_t off = (size_t)(row0 + ai * HALF + m * 16) * 1024 + col0;
#pragma unroll
                for (int bj = 0; bj < 2; ++bj)
#pragma unroll
                    for (int n = 0; n < 2; ++n) { const f32x4 a = acc[ai][bj][m][n]; u32x2 w; w.x = cvt_pk_bf16(a[0], a[1]); w.y = cvt_pk_bf16(a[2], a[3]); *(u32x2*)(O + off + bj * HALF + n * 16) = w; } }
    }
};
struct EpiGlu {
    static constexpr bool PERM = true, AFTER_DRAIN = false;
    bf16_t* O; const bf16_t* yg;
    __device__ __forceinline__ void operator()(const f32x4 (&acc)[2][2][4][2], const Unit& u, int wr, int wc, int fr, int fq) const {
        const int row0 = u.pm * BM + wr * 64 + fr, col0 = u.pn * BM + wc * 32 + 8 * fq;
#pragma unroll
        for (int ai = 0; ai < 2; ++ai)
#pragma unroll
            for (int m = 0; m < 4; ++m) { const int r = row0 + ai * HALF + m * 16;
#pragma unroll
                for (int bj = 0; bj < 2; ++bj) { const int c = col0 + bj * HALF; const u32x4 y = *(const u32x4*)(yg + (size_t)r * 512 + c);
                    const f32x4 v0 = acc[ai][bj][m][0], v1 = acc[ai][bj][m][1]; u32x4 w;
                    w.x = cvt_pk_bf16(bflo(y.x) * sigm(v0[0]), bfhi(y.x) * sigm(v0[1])); w.y = cvt_pk_bf16(bflo(y.y) * sigm(v0[2]), bfhi(y.y) * sigm(v0[3]));
                    w.z = cvt_pk_bf16(bflo(y.z) * sigm(v1[0]), bfhi(y.z) * sigm(v1[1])); w.w = cvt_pk_bf16(bflo(y.w) * sigm(v1[2]), bfhi(y.w) * sigm(v1[3]));
                    *(u32x4*)(O + (size_t)r * 1024 + c) = w; } }
    }
};
template <class Epi, class Sched, bool ALIGN_EPI = false, bool SP2 = false>
__device__ __forceinline__ void gemm_phase(PG8_LAS unsigned char* lds, const Gemm g, const Sched& S, const Epi& E) {
    int tid = threadIdx.x; asm volatile("" : "+v"(tid)); const int wid = __builtin_amdgcn_readfirstlane(tid >> 6), lane = tid & 63, wr = wid >> 2, wc = wid & 3, fr = lane & 15, fq = lane >> 4;
    const int K = g.K, nt = K / BK;
    unsigned voffA[2], voffB[2];
#pragma unroll
    for (int i = 0; i < 2; ++i) { int R, C; stage_rc(tid * 16 + i * 8192, R, C); const int Rb = Epi::PERM ? ((R & ~31) + perm32(R & 31)) : R;
        voffA[i] = (unsigned)(R * K + C) * 2u; voffB[i] = (unsigned)(Rb * K + C) * 2u; }
    const size_t kstep = (size_t)(BK * 2);
    const size_t hstep = (size_t)HALF * K * 2;
    const size_t tstep = 2 * hstep;
    const unsigned ldsw = (unsigned)wid * 1024u;
    const int aoff = lds_byte(wr * 64 + fr, fq * 8), boff = lds_byte(wc * 32 + fr, fq * 8);
#define PG8_SA(b, h) (((b) * 2 + (h)) * HTB)
#define PG8_SB(b, h) ((4 + (b) * 2 + (h)) * HTB)
#define PG8_STAGE(bufoff, gbase, voff) do { _Pragma("unroll") for (int _i = 0; _i < 2; ++_i) \
        __builtin_amdgcn_global_load_lds((const unsigned*)((const char*)(gbase) + (voff)[_i]), (PG8_LAS unsigned*)(lds + (bufoff) + ldsw + _i * 8192), 16, 0, 0); } while (0)
#define PG8_LDA(dst, b, h) do { _Pragma("unroll") for (int m = 0; m < 4; ++m) _Pragma("unroll") for (int k = 0; k < 2; ++k) dst[m][k] = *(const PG8_LAS bf16x8*)(lds + PG8_SA(b, h) + aoff + m * 2048 + k * 1024); } while (0)
#define PG8_LDB(dst, b, h) do { _Pragma("unroll") for (int n = 0; n < 2; ++n) _Pragma("unroll") for (int k = 0; k < 2; ++k) dst[n][k] = *(const PG8_LAS bf16x8*)(lds + PG8_SB(b, h) + boff + n * 2048 + k * 1024); } while (0)
#define PG8_MMA(ai, bj, At, Bt) do { __builtin_amdgcn_s_setprio(1); _Pragma("unroll") for (int m = 0; m < 4; ++m) _Pragma("unroll") for (int n = 0; n < 2; ++n) _Pragma("unroll") for (int k = 0; k < 2; ++k) \
        acc[ai][bj][m][n] = __builtin_amdgcn_mfma_f32_16x16x32_bf16(Bt[n][k], At[m][k], acc[ai][bj][m][n], 0, 0, 0); __builtin_amdgcn_s_setprio(0); } while (0)
#define PG8_WAIT_V(n) asm volatile("s_waitcnt vmcnt(" #n ")" ::: "memory")
#define PG8_WAIT_L(n) asm volatile("s_waitcnt lgkmcnt(" #n ")" ::: "memory")
#define PG8_BAR __builtin_amdgcn_s_barrier()
#define PG8_SCHED __builtin_amdgcn_sched_barrier(0)
    Unit cur, nxt; int ui = 0;
    if (!S.next(0, cur)) return;
    f32x4 acc[2][2][4][2];
#pragma unroll
    for (int a = 0; a < 2; ++a)
#pragma unroll
        for (int b = 0; b < 2; ++b)
#pragma unroll
            for (int m = 0; m < 4; ++m)
#pragma unroll
                for (int n = 0; n < 2; ++n) acc[a][b][m][n] = (f32x4){0.f, 0.f, 0.f, 0.f};
    bf16x8 At[4][2], B0[2][2], B1[2][2];
    const char* cA = (const char*)g.A + (size_t)cur.pm * tstep; const char* cB = (const char*)g.Bt + (size_t)cur.pn * tstep;
    S.a_ready(cur);
    if constexpr (SP2) {
        PG8_STAGE(PG8_SB(0, 0), cB, voffB); PG8_STAGE(PG8_SB(0, 1), cB + hstep, voffB); PG8_STAGE(PG8_SA(0, 0), cA, voffA); PG8_STAGE(PG8_SA(0, 1), cA + hstep, voffA);
        if (wr == 1) PG8_BAR;
        PG8_WAIT_V(2); PG8_BAR;
        PG8_STAGE(PG8_SB(1, 0), cB + kstep, voffB); PG8_STAGE(PG8_SA(1, 0), cA + kstep, voffA); PG8_STAGE(PG8_SB(1, 1), cB + hstep + kstep, voffB);
        PG8_WAIT_V(6); PG8_BAR;
    } else {
        PG8_STAGE(PG8_SB(0, 0), cB, voffB); PG8_STAGE(PG8_SA(0, 0), cA, voffA); PG8_STAGE(PG8_SB(0, 1), cB + hstep, voffB); PG8_STAGE(PG8_SA(0, 1), cA + hstep, voffA);
        if (wr == 1) PG8_BAR;
        PG8_WAIT_V(4); PG8_BAR;
        PG8_STAGE(PG8_SB(1, 0), cB + kstep, voffB); PG8_STAGE(PG8_SA(1, 0), cA + kstep, voffA); PG8_STAGE(PG8_SB(1, 1), cB + hstep + kstep, voffB);
        PG8_WAIT_V(6); PG8_BAR;
    }
    for (;;) {
        const bool has_next = S.next(ui + 1, nxt);
        const char* nA = has_next ? (const char*)g.A + (size_t)nxt.pm * tstep : cA; const char* nB = has_next ? (const char*)g.Bt + (size_t)nxt.pn * tstep : cB;
        for (int t = 0; t < nt; t += 2) {
            const bool last = (t == nt - 2);
            const char* a1 = cA + (size_t)(t + 1) * kstep;
            const char* a2 = last ? nA : cA + (size_t)(t + 2) * kstep; const char* b2 = last ? nB : cB + (size_t)(t + 2) * kstep;
            const char* a3 = a2 + kstep; const char* b3 = b2 + kstep;
            if (last && has_next) S.a_ready(nxt);
            if constexpr (SP2) {
            PG8_LDB(B0, 0, 0); PG8_LDB(B1, 0, 1); PG8_SCHED; PG8_LDA(At, 0, 0); PG8_STAGE(PG8_SA(1, 1), a1 + hstep, voffA);
            PG8_WAIT_V(8); PG8_WAIT_L(0); PG8_BAR; PG8_MMA(0, 0, At, B0); PG8_MMA(0, 1, At, B1); PG8_BAR; PG8_SCHED;
            PG8_LDA(At, 0, 1); PG8_STAGE(PG8_SB(0, 0), b2, voffB); PG8_STAGE(PG8_SB(0, 1), b2 + hstep, voffB); PG8_STAGE(PG8_SA(0, 0), a2, voffA);
            PG8_WAIT_V(8); PG8_WAIT_L(0); PG8_BAR; PG8_MMA(1, 0, At, B0); PG8_MMA(1, 1, At, B1); PG8_BAR; PG8_SCHED;
            PG8_LDB(B0, 1, 0); PG8_LDB(B1, 1, 1); PG8_SCHED; PG8_LDA(At, 1, 0); PG8_STAGE(PG8_SA(0, 1), a2 + hstep, voffA);
            PG8_WAIT_V(8); PG8_WAIT_L(0); PG8_BAR; PG8_MMA(0, 0, At, B0); PG8_MMA(0, 1, At, B1); PG8_BAR; PG8_SCHED;
            PG8_LDA(At, 1, 1); PG8_STAGE(PG8_SB(1, 0), b3, voffB); PG8_STAGE(PG8_SB(1, 1), b3 + hstep, voffB); PG8_STAGE(PG8_SA(1, 0), a3, voffA);
            PG8_WAIT_V(8); PG8_WAIT_L(0); PG8_BAR; PG8_MMA(1, 0, At, B0); PG8_MMA(1, 1, At, B1); PG8_BAR; PG8_SCHED;
            } else {
            PG8_LDB(B0, 0, 0); PG8_SCHED; PG8_LDA(At, 0, 0); PG8_STAGE(PG8_SA(1, 1), a1 + hstep, voffA);
            PG8_WAIT_L(8); PG8_BAR; PG8_WAIT_L(0); PG8_MMA(0, 0, At, B0); PG8_BAR; PG8_SCHED;
            PG8_LDB(B1, 0, 1); PG8_STAGE(PG8_SB(0, 0), b2, voffB);
            PG8_BAR; PG8_WAIT_L(0); PG8_MMA(0, 1, At, B1); PG8_BAR;
            PG8_LDA(At, 0, 1); PG8_STAGE(PG8_SA(0, 0), a2, voffA);
            PG8_BAR; PG8_WAIT_L(0); PG8_MMA(1, 0, At, B0); PG8_BAR; PG8_SCHED;
            PG8_STAGE(PG8_SB(0, 1), b2 + hstep, voffB);
            PG8_WAIT_V(6); PG8_BAR; PG8_MMA(1, 1, At, B1); PG8_BAR;
            PG8_LDB(B0, 1, 0); PG8_SCHED; PG8_LDA(At, 1, 0); PG8_STAGE(PG8_SA(0, 1), a2 + hstep, voffA);
            PG8_WAIT_L(8); PG8_BAR; PG8_WAIT_L(0); PG8_MMA(0, 0, At, B0); PG8_BAR; PG8_SCHED;
            PG8_LDB(B1, 1, 1); PG8_STAGE(PG8_SB(1, 0), b3, voffB);
            PG8_BAR; PG8_WAIT_L(0); PG8_MMA(0, 1, At, B1); PG8_BAR;
            PG8_LDA(At, 1, 1); PG8_STAGE(PG8_SA(1, 0), a3, voffA);
            PG8_BAR; PG8_WAIT_L(0); PG8_MMA(1, 0, At, B0); PG8_BAR; PG8_SCHED;
            PG8_STAGE(PG8_SB(1, 1), b3 + hstep, voffB);
            PG8_WAIT_V(6); PG8_BAR; PG8_MMA(1, 1, At, B1); PG8_BAR;
            }
        }
        if constexpr (ALIGN_EPI) { if (wr == 0) PG8_BAR; }
        if constexpr (!Epi::AFTER_DRAIN) { E(acc, cur, wr, wc, fr, fq); S.done(cur); }
        if (!has_next) break;
#pragma unroll
        for (int a = 0; a < 2; ++a)
#pragma unroll
            for (int b = 0; b < 2; ++b)
#pragma unroll
                for (int m = 0; m < 4; ++m)
#pragma unroll
                    for (int n = 0; n < 2; ++n) acc[a][b][m][n] = (f32x4){0.f, 0.f, 0.f, 0.f};
        cur = nxt; cA = nA; cB = nB; ++ui;
        if constexpr (ALIGN_EPI) { if (wr == 1) PG8_BAR; }
    }
    PG8_WAIT_V(0);
    if constexpr (!ALIGN_EPI) { if (wr == 0) PG8_BAR; }
    PG8_BAR;
    if constexpr (Epi::AFTER_DRAIN) { E.fused(acc, cur, wr, wc, fr, fq, lds, wid, lane); S.done(cur); }
#undef PG8_SA
#undef PG8_SB
#undef PG8_STAGE
#undef PG8_LDA
#undef PG8_LDB
#undef PG8_MMA
#undef PG8_WAIT_V
#undef PG8_WAIT_L
#undef PG8_BAR
#undef PG8_SCHED
}
}
#include <hip/hip_bf16.h>
#include <cmath>
namespace attn_body {
using bf16=__hip_bfloat16;
using bf16x8=__attribute__((ext_vector_type(8)))short;
using s16x4=__attribute__((ext_vector_type(4)))short;
using f32x16=__attribute__((ext_vector_type(16)))float;
using u32x4=__attribute__((ext_vector_type(4)))unsigned;
constexpr int SEQ=4096,D=64,PQ=512,PO=1024;
constexpr int NW=8,QBLK=32,QB=QBLK*NW,KVBLK=64,NQB=SEQ/QB;

__device__ __forceinline__ int crow(int r,int hi){return (r&3)+8*(r>>2)+4*hi;}
#define SBAR() __builtin_amdgcn_sched_barrier(0)
__device__ __forceinline__ void cmask(f32x16&p0,f32x16&p1,int jb,int qrel,int hi){
  const float NEG=-INFINITY; int kb=64*jb+4*hi;
  #pragma unroll
  for(int r=0;r<16;++r){int kv=kb+(r&3)+8*(r>>2); if(kv>qrel)p0[r]=NEG; if(kv+32>qrel)p1[r]=NEG;}
}

constexpr int NSLOT=3, SLOTB=8192;
constexpr int LDS_K=0, LDS_V=NSLOT*SLOTB, LDS_WS=2*NSLOT*SLOTB, LDS_OST=LDS_WS+NW*64*4, LDS_BYTES=LDS_OST+NW*4096;
constexpr float C2=0.125f*1.4426950408889634f;
__device__ __forceinline__ void glds16(const void*gsrc,unsigned lds_dst){unsigned keep;
  asm volatile("s_mov_b32 %0, m0\n\ts_mov_b32 m0, %2\n\ts_nop 0\n\tglobal_load_lds_dwordx4 %1, off\n\ts_mov_b32 m0, %0":"=&s"(keep):"v"(gsrc),"s"(lds_dst):"memory");}
__device__ __forceinline__ float max3f(float a,float b,float c){float r;asm("v_max3_f32 %0, %1, %2, %3":"=v"(r):"v"(a),"v"(b),"v"(c));return r;}
__device__ __forceinline__ float max2f(float a,float b){float r;asm("v_max_f32_e32 %0, %1, %2":"=v"(r):"v"(a),"v"(b));return r;}
__device__ __forceinline__ float fadd_s(float a,float b){float r;asm("v_add_f32_e32 %0, %1, %2":"=v"(r):"v"(a),"v"(b));return r;}
__device__ __forceinline__ float fsub_s(float a,float b){float r;asm("v_sub_f32_e32 %0, %1, %2":"=v"(r):"v"(a),"v"(b));return r;}
typedef float f32x2_t __attribute__((ext_vector_type(2))); typedef __bf16 bf16x2_t __attribute__((ext_vector_type(2)));
__device__ __forceinline__ unsigned cvtpk_s(float lo,float hi){f32x2_t v={lo,hi};bf16x2_t b=__builtin_convertvector(v,bf16x2_t);return __builtin_bit_cast(unsigned,b);}
#define WAIT_BAR(N) asm volatile("s_waitcnt vmcnt(" #N ") lgkmcnt(0)\n\ts_barrier":::"memory")

__device__ __forceinline__ void qkt(f32x16&p0,f32x16&p1,const char*Kslot,const bf16x8*qr,const f32x16&negm,int r32,int hi){
  const char*kb=Kslot+hi*1024+r32*16;
  #pragma unroll
  for(int d0=0;d0<4;++d0){
    const bf16x8 b0=*reinterpret_cast<const bf16x8*>(kb+d0*2048);
    const bf16x8 b1=*reinterpret_cast<const bf16x8*>(kb+d0*2048+512);
    if(d0==0){p0=__builtin_amdgcn_mfma_f32_32x32x16_bf16(b0,qr[0],negm,0,0,0);p1=__builtin_amdgcn_mfma_f32_32x32x16_bf16(b1,qr[0],negm,0,0,0);}
    else{p0=__builtin_amdgcn_mfma_f32_32x32x16_bf16(b0,qr[d0],p0,0,0,0);p1=__builtin_amdgcn_mfma_f32_32x32x16_bf16(b1,qr[d0],p1,0,0,0);}}
}
typedef __attribute__((address_space(3))) const char* lds_cptr;
typedef short v4i16_t __attribute__((ext_vector_type(4)));
__device__ __forceinline__ void kload8(bf16x8*kf,lds_cptr kp){
  kf[0]=*(const __attribute__((address_space(3))) bf16x8*)(kp);      kf[1]=*(const __attribute__((address_space(3))) bf16x8*)(kp+512);
  kf[2]=*(const __attribute__((address_space(3))) bf16x8*)(kp+2048); kf[3]=*(const __attribute__((address_space(3))) bf16x8*)(kp+2560);
  kf[4]=*(const __attribute__((address_space(3))) bf16x8*)(kp+4096); kf[5]=*(const __attribute__((address_space(3))) bf16x8*)(kp+4608);
  kf[6]=*(const __attribute__((address_space(3))) bf16x8*)(kp+6144); kf[7]=*(const __attribute__((address_space(3))) bf16x8*)(kp+6656);
}
__device__ __forceinline__ void kload2(bf16x8*kf,lds_cptr kp,int j){ kf[2*j]=*(const __attribute__((address_space(3))) bf16x8*)(kp+j*2048); kf[2*j+1]=*(const __attribute__((address_space(3))) bf16x8*)(kp+j*2048+512); }
__device__ __forceinline__ s16x4 vtr(lds_cptr p){ return __builtin_bit_cast(s16x4,__builtin_amdgcn_ds_read_tr16_b64_v4i16((__attribute__((address_space(3))) v4i16_t*)p)); }
__device__ __forceinline__ float rowmax(const f32x16&p0,const f32x16&p1){
  float a=max3f(p0[0],p0[1],p1[0]),b=max3f(p0[2],p0[3],p1[1]);a=max3f(a,p1[2],p1[3]);
  #pragma unroll
  for(int r=4;r<16;r+=4){a=max3f(a,p0[r],p0[r+1]);b=max3f(b,p0[r+2],p0[r+3]);a=max3f(a,p1[r],p1[r+1]);b=max3f(b,p1[r+2],p1[r+3]);}
  const float m=max2f(a,b);
  auto rr=__builtin_amdgcn_permlane32_swap(__float_as_uint(m),__float_as_uint(m),false,false);
  return max2f(__uint_as_float(rr[0]),__uint_as_float(rr[1]));
}
__device__ __forceinline__ void pv(f32x16*o,int vb,bf16x8 pa0,bf16x8 pa1,bf16x8 pa2,bf16x8 pa3){
  #pragma unroll
  for(int d0=0;d0<2;++d0){s16x4 lo[4],hi[4];
    #pragma unroll
    for(int ks=0;ks<4;++ks){
      asm volatile("ds_read_b64_tr_b16 %0,%1 offset:%c2":"=&v"(lo[ks]):"v"(vb),"i"(d0*4096+ks*1024):"memory");
      asm volatile("ds_read_b64_tr_b16 %0,%1 offset:%c2":"=&v"(hi[ks]):"v"(vb),"i"(d0*4096+ks*1024+512):"memory");}
    asm volatile("s_waitcnt lgkmcnt(0)":::"memory");SBAR();
    #define PK(k) (bf16x8){lo[k][0],lo[k][1],lo[k][2],lo[k][3],hi[k][0],hi[k][1],hi[k][2],hi[k][3]}
    o[d0]=__builtin_amdgcn_mfma_f32_32x32x16_bf16(pa0,PK(0),o[d0],0,0,0);
    o[d0]=__builtin_amdgcn_mfma_f32_32x32x16_bf16(pa1,PK(1),o[d0],0,0,0);
    o[d0]=__builtin_amdgcn_mfma_f32_32x32x16_bf16(pa2,PK(2),o[d0],0,0,0);
    o[d0]=__builtin_amdgcn_mfma_f32_32x32x16_bf16(pa3,PK(3),o[d0],0,0,0);
    #undef PK
  }
}

#ifndef ATTN_STORE16
#define ATTN_STORE16(p,v) (*(u32x4*)(p)=(v))
#endif
template<int THRL> __device__ __forceinline__ void attn_unit(int b,int h,int qb,const bf16*Q,const bf16*__restrict__ K,const bf16*__restrict__ V,bf16*O,char*shm){
  int tid=threadIdx.x; asm volatile("":"+v"(tid)); const int lane=tid&63,r32=lane&31,hi=lane>>5; const int wid=__builtin_amdgcn_readfirstlane(tid>>6);
  const long rowbase=(long)b*SEQ; const int q0=qb*QB;
  const bf16*Qw=Q+(rowbase+q0+wid*QBLK)*PQ;
  const bf16*Kh=K+rowbase*PQ,*Vh=V+rowbase*PQ;
  const unsigned lds0=(unsigned)(uintptr_t)shm;
  float*wsf=(float*)(shm+LDS_WS)+wid*64;
  const bf16*ksrc=Kh+(long)lane*PQ+wid*8;
  const bf16*vsrc=Vh+(long)(16*(wid&3)+(lane>>2))*PQ+(wid>>2)*32+(lane&3)*8;
  const unsigned kdst=lds0+LDS_K+wid*1024, vdst=lds0+LDS_V+wid*1024;
  #define DMA_K(t,slot) glds16(ksrc+(long)(t)*KVBLK*PQ,(unsigned)__builtin_amdgcn_readfirstlane(kdst+(slot)))
  #define DMA_V(t,slot) glds16(vsrc+(long)(t)*KVBLK*PQ,(unsigned)__builtin_amdgcn_readfirstlane(vdst+(slot)))
  const int vb0=(int)(lds0+LDS_V)+((lane>>4)&1)*32+(lane&3)*8+(4*hi+((lane&15)>>2))*64;
  const char*Kbase=shm+LDS_K; bf16x8 kf[8];
  const lds_cptr shm3=(lds_cptr)shm; const lds_cptr kp0=shm3+LDS_K+hi*1024+r32*16; const lds_cptr vp0=shm3+LDS_V+((lane>>4)&1)*32+(lane&3)*8+(4*hi+((lane&15)>>2))*64;
  const int NT=(q0+QB)/KVBLK;
  DMA_K(0,0);DMA_V(0,0);DMA_K(1,SLOTB);
  bf16x8 qr[4];
  #pragma unroll
  for(int d0=0;d0<4;++d0)qr[d0]=*reinterpret_cast<const bf16x8*>(&Qw[(long)r32*PQ+d0*16+hi*8]);
  float mhat=0.f,l_reg=0.f;f32x16 o[2];o[0]=f32x16{};o[1]=f32x16{};float zz_=0.f;asm volatile("":"+v"(zz_));f32x16 negm;
  _Pragma("unroll") for(int r=0;r<16;++r)negm[r]=zz_;
  const int qrel=wid*QBLK+r32;
  #define CMASK(P0,P1,t) do{int jb_=(t)-(NT-4); if(jb_>=0)cmask(P0,P1,jb_,qrel,hi);}while(0)
  bool resc=false;
  #define START(P0,P1) do{ const float rm=rowmax(P0,P1); resc=false; \
    { const float dl=rm; mhat=fadd_s(mhat,dl); \
      _Pragma("unroll") for(int r=0;r<16;++r){P0[r]=fsub_s(P0[r],dl);P1[r]=fsub_s(P1[r],dl);} \
      _Pragma("unroll") for(int r=0;r<16;++r)negm[r]=-mhat; asm volatile("":"+v"(negm)); } \
    _Pragma("unroll") for(int r=0;r<16;++r)P0[r]=__builtin_amdgcn_exp2f(P0[r]); }while(0)
  #define RESC() do{ if(resc){ asm volatile("s_waitcnt lgkmcnt(0)":::"memory"); \
      _Pragma("unroll") for(int d_=0;d_<2;++d_) _Pragma("unroll") for(int r=0;r<16;++r)o[d_][r]*=wsf[crow(r,hi)]; } }while(0)
  f32x16 pA0,pA1,pB0,pB1;
  int sl_prev=0,sl_cur=0,sl_next=SLOTB;
  #define ROT() do{sl_prev=sl_cur;sl_cur=sl_next;sl_next=(sl_next==(NSLOT-1)*SLOTB)?0:sl_next+SLOTB;}while(0)
  DMA_K(2,2*SLOTB);
  WAIT_BAR(3);
  qkt(pA0,pA1,Kbase,qr,negm,r32,hi);asm volatile("s_nop 15\n\ts_nop 7":"+v"(pA0),"+v"(pA1));CMASK(pA0,pA1,0);
  START(pA0,pA1);
  _Pragma("unroll") for(int r=0;r<16;++r)pA1[r]=__builtin_amdgcn_exp2f(pA1[r]);
  WAIT_BAR(0);
  DMA_K(3,0);DMA_V(1,SLOTB);
  ROT();
  kload8(kf,kp0+sl_cur);
  WAIT_BAR(2);
  s16x4 vlo[8],vhi[8]; u32x4 pw0,pw1,pw2,pw3;
  #define PKW(P,B) cvtpk_s(P[B],P[B+1])
  #define PAF(k) __builtin_bit_cast(bf16x8,pw##k)
  #define VFR(i) (bf16x8){vlo[i][0],vlo[i][1],vlo[i][2],vlo[i][3],vhi[i][0],vhi[i][1],vhi[i][2],vhi[i][3]}
  #define PIN(x) asm volatile("":"+v"(x))
  #define MX3(a,b,c) __builtin_fmaxf(__builtin_fmaxf((a),(b)),(c))
  #define GAPA(MF,A0,A1,A2,A3,W0,W1,PW) do{ MF; sacc+=A0; sacc+=A1; sacc+=A2; sacc+=A3; PIN(sacc); W0; W1; PIN(PW); SBAR(); }while(0)
  #define EX(v) __builtin_amdgcn_exp2f(v)
  #define GAPB(MF,X,B) do{ MF; X[B]=EX(X[B]); X[B+1]=EX(X[B+1]); X[B+2]=EX(X[B+2]); X[B+3]=EX(X[B+3]); PIN(X); SBAR(); }while(0)
  #define VRD(i) do{ vlo[i]=vtr(vp_+(((i)>>2)*4096+((i)&3)*1024)); vhi[i]=vtr(vp_+(((i)>>2)*4096+((i)&3)*1024+512)); }while(0)
  #define KRD(G,j) do{ if(G){ kload2(kf,kp0+sl_next,j); SBAR(); } }while(0)
  #define STEP(C0,C1,P0,P1,t,GK,GV,GL) do{ SBAR(); \
    const lds_cptr vp_=vp0+sl_prev; \
    VRD(0); SBAR(); float sacc=(P0[0]+P0[1]); \
    GAPA(C0=__builtin_amdgcn_mfma_f32_32x32x16_bf16(kf[0],qr[0],negm,0,0,0), P0[2],P0[3],P0[4],P0[5],     pw0[0]=PKW(P0,0), pw0[1]=PKW(P0,2), pw0); \
    VRD(4); SBAR(); GAPA(C1=__builtin_amdgcn_mfma_f32_32x32x16_bf16(kf[1],qr[0],negm,0,0,0), P0[6],P0[7],P0[8],P0[9],     pw0[2]=PKW(P0,4), pw0[3]=PKW(P0,6), pw0); \
    VRD(1); SBAR(); GAPA(C0=__builtin_amdgcn_mfma_f32_32x32x16_bf16(kf[2],qr[1],C0,0,0,0),   P0[10],P0[11],P0[12],P0[13], pw1[0]=PKW(P0,8), pw1[1]=PKW(P0,10), pw1); \
    VRD(5); SBAR(); GAPA(C1=__builtin_amdgcn_mfma_f32_32x32x16_bf16(kf[3],qr[1],C1,0,0,0),   P0[14],P0[15],P1[0],P1[1],   pw1[2]=PKW(P0,12),pw1[3]=PKW(P0,14), pw1); \
    VRD(2); SBAR(); GAPA(C0=__builtin_amdgcn_mfma_f32_32x32x16_bf16(kf[4],qr[2],C0,0,0,0),   P1[2],P1[3],P1[4],P1[5],     pw2[0]=PKW(P1,0), pw2[1]=PKW(P1,2), pw2); \
    VRD(6); SBAR(); GAPA(C1=__builtin_amdgcn_mfma_f32_32x32x16_bf16(kf[5],qr[2],C1,0,0,0),   P1[6],P1[7],P1[8],P1[9],     pw2[2]=PKW(P1,4), pw2[3]=PKW(P1,6), pw2); \
    VRD(3); SBAR(); GAPA(C0=__builtin_amdgcn_mfma_f32_32x32x16_bf16(kf[6],qr[3],C0,0,0,0),   P1[10],P1[11],P1[12],P1[13], pw3[0]=PKW(P1,8), pw3[1]=PKW(P1,10), pw3); \
    VRD(7); SBAR(); GAPA(C1=__builtin_amdgcn_mfma_f32_32x32x16_bf16(kf[7],qr[3],C1,0,0,0),   P1[14],P1[15],0.f,0.f,       pw3[2]=PKW(P1,12),pw3[3]=PKW(P1,14), pw3); \
    l_reg+=sacc; \
    if(GK){DMA_K((t)+3,sl_cur);} if(GV){DMA_V((t)+1,sl_next);} \
    CMASK(C0,C1,t); \
    { float a=MX3(C0[0],C0[1],C1[0]),b=MX3(C0[2],C0[3],C1[1]); a=MX3(a,C1[2],C1[3]); \
      _Pragma("unroll") for(int r=4;r<16;r+=4){a=MX3(a,C0[r],C0[r+1]);b=MX3(b,C0[r+2],C0[r+3]);a=MX3(a,C1[r],C1[r+1]);b=MX3(b,C1[r+2],C1[r+3]);} \
      float rm=__builtin_fmaxf(a,b); { auto rr=__builtin_amdgcn_permlane32_swap(__float_as_uint(rm),__float_as_uint(rm),false,false); rm=__builtin_fmaxf(__uint_as_float(rr[0]),__uint_as_float(rr[1])); } \
      resc=false; \
      if(__builtin_expect(__any(rm>(float)THRL),0)){ const float dl=__builtin_fmaxf(rm,0.f); mhat+=dl; \
        _Pragma("unroll") for(int r=0;r<16;++r){C0[r]-=dl;C1[r]-=dl;} \
        _Pragma("unroll") for(int r=0;r<16;++r)negm[r]=-mhat; asm volatile("":"+v"(negm)); \
        const float f=__builtin_amdgcn_exp2f(-dl); l_reg*=f; if(hi==0)wsf[r32]=f; resc=true; } } \
    SBAR(); \
    GAPB(o[0]=__builtin_amdgcn_mfma_f32_32x32x16_bf16(PAF(0),VFR(0),o[0],0,0,0), C0,0); \
    GAPB(o[1]=__builtin_amdgcn_mfma_f32_32x32x16_bf16(PAF(0),VFR(4),o[1],0,0,0), C0,4); \
    KRD(GL,0); GAPB(o[0]=__builtin_amdgcn_mfma_f32_32x32x16_bf16(PAF(1),VFR(1),o[0],0,0,0), C0,8); \
    KRD(GL,1); GAPB(o[1]=__builtin_amdgcn_mfma_f32_32x32x16_bf16(PAF(1),VFR(5),o[1],0,0,0), C0,12); \
    KRD(GL,2); GAPB(o[0]=__builtin_amdgcn_mfma_f32_32x32x16_bf16(PAF(2),VFR(2),o[0],0,0,0), C1,0); \
    KRD(GL,3); GAPB(o[1]=__builtin_amdgcn_mfma_f32_32x32x16_bf16(PAF(2),VFR(6),o[1],0,0,0), C1,4); \
    GAPB(o[0]=__builtin_amdgcn_mfma_f32_32x32x16_bf16(PAF(3),VFR(3),o[0],0,0,0), C1,8); \
    GAPB(o[1]=__builtin_amdgcn_mfma_f32_32x32x16_bf16(PAF(3),VFR(7),o[1],0,0,0), C1,12); \
    }while(0)
  int t=1;
  #undef CMASK
  #define CMASK(P0,P1,t) do{}while(0)
  for(;t+5<NT;t+=2){
    STEP(pB0,pB1,pA0,pA1,t,true,true,true);     WAIT_BAR(2); RESC(); ROT();
    STEP(pA0,pA1,pB0,pB1,t+1,true,true,true);   WAIT_BAR(2); RESC(); ROT();
  }
  #undef CMASK
  #define CMASK(P0,P1,t) do{int jb_=(t)-(NT-4); if(jb_>=0)cmask(P0,P1,jb_,qrel,hi);}while(0)
  #define ENDW(tt) do{ if((tt)+3<NT){WAIT_BAR(2);} else if((tt)+2<NT){WAIT_BAR(1);} else {WAIT_BAR(0);} }while(0)
  for(;t+1<NT;t+=2){
    STEP(pB0,pB1,pA0,pA1,t,(t+3<NT),(t+1<NT),(t+1<NT));       ENDW(t);   RESC(); ROT();
    STEP(pA0,pA1,pB0,pB1,t+1,(t+4<NT),(t+2<NT),(t+2<NT));     ENDW(t+1); RESC(); ROT();
  }
  STEP(pB0,pB1,pA0,pA1,NT-1,false,false,false); RESC();
  { float sacc=pB0[0]+pB0[1]; _Pragma("unroll") for(int r=2;r<16;++r)sacc+=pB0[r]; _Pragma("unroll") for(int r=0;r<16;++r)sacc+=pB1[r]; l_reg+=sacc;
    pw0=(u32x4){PKW(pB0,0),PKW(pB0,2),PKW(pB0,4),PKW(pB0,6)};pw1=(u32x4){PKW(pB0,8),PKW(pB0,10),PKW(pB0,12),PKW(pB0,14)};pw2=(u32x4){PKW(pB1,0),PKW(pB1,2),PKW(pB1,4),PKW(pB1,6)};pw3=(u32x4){PKW(pB1,8),PKW(pB1,10),PKW(pB1,12),PKW(pB1,14)};
    SBAR(); pv(o,vb0+sl_cur,PAF(0),PAF(1),PAF(2),PAF(3)); }
  #undef PKW
  #undef PAF
  #undef VFR
  #undef PIN
  #undef MX3
  #undef GAPA
  #undef GAPB
  #undef EX
  #undef VRD
  #undef KRD
  #undef STEP
  #undef ENDW
  {auto rr=__builtin_amdgcn_permlane32_swap(__float_as_uint(l_reg),__float_as_uint(l_reg),false,false);l_reg=__uint_as_float(rr[0])+__uint_as_float(rr[1]);}
  if(hi==0)wsf[32+r32]=l_reg;asm volatile("s_waitcnt lgkmcnt(0)":::"memory");
  float rli[16];
  #pragma unroll
  for(int r=0;r<16;++r)rli[r]=__builtin_amdgcn_rcpf(wsf[32+crow(r,hi)]);
  bf16*Ow=O+(rowbase+q0+wid*QBLK)*PO;
  { bf16*stg=(bf16*)(shm+LDS_OST)+wid*2048;
    #pragma unroll
    for(int r=0;r<16;++r){const int orow=crow(r,hi);
      #pragma unroll
      for(int d0=0;d0<2;++d0)stg[orow*64+d0*32+r32]=__float2bfloat16(o[d0][r]*rli[r]);}
    asm volatile("s_waitcnt lgkmcnt(0)":::"memory");
    #pragma unroll
    for(int i=0;i<4;++i){const int row=i*8+(lane>>3),ch=lane&7; const u32x4 v=*(const u32x4*)(stg+row*64+ch*8); ATTN_STORE16(Ow+(long)row*PO+ch*8,v);} }
  asm volatile("s_waitcnt lgkmcnt(0)\n\ts_barrier":::"memory");
  #undef DMA_K
  #undef DMA_V
  #undef CMASK
  #undef START
  #undef RESC
  #undef ROT
}
constexpr int ATTN_LDS_BYTES=LDS_BYTES;
#undef SBAR
#undef WAIT_BAR
}
#include <hip/hip_cooperative_groups.h>
namespace cg = cooperative_groups;
namespace mk {
typedef unsigned short bf16_t;
typedef short bf16x8 __attribute__((ext_vector_type(8)));
typedef short s16x4 __attribute__((ext_vector_type(4)));
typedef float f32x4 __attribute__((ext_vector_type(4)));
typedef float f32x16 __attribute__((ext_vector_type(16)));
typedef unsigned u32x4 __attribute__((ext_vector_type(4)));
typedef unsigned u32x2 __attribute__((ext_vector_type(2)));
typedef float f32x2_t __attribute__((ext_vector_type(2))); typedef __bf16 bf16x2_t __attribute__((ext_vector_type(2)));
constexpr int T = 32768, S = 4096;
constexpr size_t TSQ = (size_t)T * 512;
constexpr size_t MiB = 1u << 20;
constexpr size_t WS_SSQ = 0, WS_DML = 4 * MiB, WS_W = 6 * MiB, WS_WL = 18 * MiB + MiB / 2, WS_WM = WS_W + 74 * MiB, WS_PB = 112 * MiB, WS_HB = 128 * MiB, WS_YMIX = 192 * MiB, WS_BIG = 256 * MiB, WS_O16 = WS_BIG + 192 * MiB, WS_END = 512 * MiB;
constexpr int LDS_BYTES = 147456;
constexpr float C2 = 0.125f * 1.4426950408889634f;
struct Params { const float* in[29]; float* out; unsigned char* ws; };

__device__ __forceinline__ unsigned pk2(float lo, float hi) { f32x2_t v = {lo, hi}; bf16x2_t b = __builtin_convertvector(v, bf16x2_t); return __builtin_bit_cast(unsigned, b); }
__device__ __forceinline__ float bflo(unsigned w) { return __uint_as_float(w << 16); }
__device__ __forceinline__ float bfhi(unsigned w) { return __uint_as_float(w & 0xffff0000u); }
__device__ __forceinline__ float bf1(bf16_t h) { return __uint_as_float((unsigned)h << 16); }
__device__ __forceinline__ float wave_sum(float v) {
v = xor_add<1>(v); v = xor_add<2>(v); v = xor_add<4>(v); v = xor_add<8>(v); v = xor_add<16>(v); v = xor_add<32>(v);
    return v;
}
#define WAVE_LDS_SYNC() asm volatile("s_waitcnt lgkmcnt(0)" ::: "memory")
__device__ __forceinline__ int crow(int r, int hi) { return (r & 3) + 8 * (r >> 2) + 4 * hi; }

__device__ __forceinline__ void transpose_items(const float* W, int K, int N, const float* gain, bf16_t* WT, float* scr, int gw, int ngw, int lane) {
    const int nblk = N / 32, nitems = (K / 64) * nblk;
    const int lr = lane >> 3, lc = (lane & 7) * 4;
    f32x4 r[8];
    int it = gw;
    if (it < nitems) { const int k0 = 64 * (it / nblk), n0 = 32 * (it % nblk);
#pragma unroll
        for (int i = 0; i < 8; ++i) r[i] = __builtin_nontemporal_load((const f32x4*)(W + (size_t)(k0 + lr + 8 * i) * N + n0 + lc)); }
    for (; it < nitems; it += ngw) {
        const int kb = it / nblk, nb = it % nblk, k0 = 64 * kb, n0 = 32 * nb;
#pragma unroll
        for (int i = 0; i < 8; ++i) { const int kk = lr + 8 * i; const float g = gain ? gain[k0 + kk] : 1.0f; float* d = scr + kk * 33 + lc;
            d[0] = r[i][0] * g; d[1] = r[i][1] * g; d[2] = r[i][2] * g; d[3] = r[i][3] * g; }
        WAVE_LDS_SYNC();
        const int itn = it + ngw;
        if (itn < nitems) { const int k1 = 64 * (itn / nblk), n1 = 32 * (itn % nblk);
#pragma unroll
            for (int i = 0; i < 8; ++i) r[i] = __builtin_nontemporal_load((const f32x4*)(W + (size_t)(k1 + lr + 8 * i) * N + n1 + lc)); }
        const int c = lane & 7;
#pragma unroll
        for (int j = 0; j < 4; ++j) { const int n = (lane >> 3) + 8 * j; const float* s = scr + (8 * c) * 33 + n;
            u32x4 o; o.x = pk2(s[0 * 33], s[1 * 33]); o.y = pk2(s[2 * 33], s[3 * 33]); o.z = pk2(s[4 * 33], s[5 * 33]); o.w = pk2(s[6 * 33], s[7 * 33]);
            *(u32x4*)(WT + (size_t)(n0 + n) * K + k0 + 8 * c) = o; }
        WAVE_LDS_SYNC();
    }
}
__device__ __forceinline__ void convert_p(const float* psrc, bf16_t* pb, int gtid, int nthr) {
    int i = gtid; f32x4 a = (f32x4){0.f, 0.f, 0.f, 0.f}, b = a;
    if (i < T * 256 / 8) { a = __builtin_nontemporal_load((const f32x4*)psrc + 2 * i); b = __builtin_nontemporal_load((const f32x4*)psrc + 2 * i + 1); }
    for (; i < T * 256 / 8; i += nthr) { const f32x4 ca = a, cb = b; const int in = i + nthr;
        if (in < T * 256 / 8) { a = __builtin_nontemporal_load((const f32x4*)psrc + 2 * in); b = __builtin_nontemporal_load((const f32x4*)psrc + 2 * in + 1); }
        u32x4 o; o.x = pk2(ca[0], ca[1]); o.y = pk2(ca[2], ca[3]); o.z = pk2(cb[0], cb[1]); o.w = pk2(cb[2], cb[3]); ((u32x4*)pb)[i] = o; }
}

template <int PASS> __device__ __forceinline__ void dil_unit(int u, int dilv, const bf16_t* proj, float* accst, float* mst, float* lst, bf16_t* ymix, short* vts, int lane) {
    const int r32 = lane & 31, hi = lane >> 5;
    const int LB = 128 / dilv, ql = u & 127, head = (u >> 7) & 7, b = u >> 10, r = ql / LB, qblk = ql % LB;
    const long rowq = (long)b * S + (long)(32 * qblk + r32) * dilv + r;
    const bf16_t* qp = proj + 3 * TSQ + rowq * 512 + head * 64 + 8 * hi;
    const int j0 = qblk < 4 ? 4 - qblk : 0;
    const float NEG = -1e30f;
#define DIL_ROW(j) ((long)b * S + (long)(32 * qblk - 128 + 32 * ((j) >= j0 ? (j) : j0) + r32) * dilv + r)
    bf16x8 qf[4], kn[4];
#pragma unroll
    for (int d0 = 0; d0 < 4; ++d0) qf[d0] = *(const bf16x8*)(qp + 16 * d0);
    { const bf16_t* kp = proj + 4 * TSQ + DIL_ROW(0) * 512 + head * 64 + 8 * hi;
#pragma unroll
        for (int d0 = 0; d0 < 4; ++d0) kn[d0] = *(const bf16x8*)(kp + 16 * d0); }
    const size_t sidx = (size_t)rowq * 8 + head;
    float m_old = NEG, l_old = 0.f;
    if (PASS > 0) { m_old = mst[sidx]; l_old = lst[sidx]; }
    f32x16 st[5]; float mt = NEG;
#pragma unroll
    for (int j = 0; j < 5; ++j) {
        bf16x8 kc[4];
#pragma unroll
        for (int d0 = 0; d0 < 4; ++d0) kc[d0] = kn[d0];
        if (j < 4) { const bf16_t* kp = proj + 4 * TSQ + DIL_ROW(j + 1) * 512 + head * 64 + 8 * hi;
#pragma unroll
            for (int d0 = 0; d0 < 4; ++d0) kn[d0] = *(const bf16x8*)(kp + 16 * d0); }
        if (j >= j0) {
            f32x16 a = f32x16{};
#pragma unroll
            for (int d0 = 0; d0 < 4; ++d0) a = __builtin_amdgcn_mfma_f32_32x32x16_bf16(kc[d0], qf[d0], a, 0, 0, 0);
            if (j == 0) {
#pragma unroll
                for (int i = 0; i < 16; ++i) if (crow(i, hi) < r32) a[i] = NEG; }
            if (j == 4) {
#pragma unroll
                for (int i = 0; i < 16; ++i) if (crow(i, hi) > r32) a[i] = NEG; }
#pragma unroll
            for (int i = 0; i < 16; ++i) mt = fmaxf(mt, a[i]);
            st[j] = a;
        } else st[j] = f32x16{};
    }
    bf16x8 vn[4];
    { const bf16_t* vp = proj + 5 * TSQ + DIL_ROW(0) * 512 + head * 64 + 8 * hi;
#pragma unroll
        for (int d0 = 0; d0 < 4; ++d0) vn[d0] = *(const bf16x8*)(vp + 16 * d0); }
    f32x16 O[2]; float* ap = accst + sidx * 64 + 4 * hi;
    if (PASS > 0) {
#pragma unroll
        for (int dt = 0; dt < 2; ++dt)
#pragma unroll
            for (int i4 = 0; i4 < 4; ++i4) { const f32x4 v = *(const f32x4*)(ap + 32 * dt + 8 * i4);
#pragma unroll
                for (int e = 0; e < 4; ++e) O[dt][4 * i4 + e] = v[e]; }
    } else { O[0] = f32x16{}; O[1] = f32x16{}; }
    mt = xor_max<32>(mt);
    const float m_new = fmaxf(m_old, mt), sc = __builtin_amdgcn_exp2f(m_old - m_new);
    float ls = 0.f;
#pragma unroll
    for (int j = 0; j < 5; ++j) if (j >= j0) {
#pragma unroll
        for (int i = 0; i < 16; ++i) { const float e = __builtin_amdgcn_exp2f(st[j][i] - m_new); st[j][i] = e; ls += e; } }
    ls = xor_add<32>(ls);
    const float l_new = l_old * sc + ls;
    if (PASS > 0) {
#pragma unroll
        for (int dt = 0; dt < 2; ++dt)
#pragma unroll
            for (int i = 0; i < 16; ++i) O[dt][i] *= sc; }
#pragma unroll
    for (int j = 0; j < 5; ++j) {
        bf16x8 vc[4];
#pragma unroll
        for (int d0 = 0; d0 < 4; ++d0) vc[d0] = vn[d0];
        if (j < 4) { const bf16_t* vp = proj + 5 * TSQ + DIL_ROW(j + 1) * 512 + head * 64 + 8 * hi;
#pragma unroll
            for (int d0 = 0; d0 < 4; ++d0) vn[d0] = *(const bf16x8*)(vp + 16 * d0); }
        if (j >= j0) {
#pragma unroll
            for (int d0 = 0; d0 < 4; ++d0) {
#pragma unroll
                for (int e = 0; e < 8; ++e) vts[(16 * d0 + 8 * hi + e) * 36 + r32] = vc[d0][e]; }
            WAVE_LDS_SYNC();
#pragma unroll
            for (int cc = 0; cc < 2; ++cc) {
                u32x4 pw; pw.x = pk2(st[j][8 * cc + 0], st[j][8 * cc + 1]); pw.y = pk2(st[j][8 * cc + 2], st[j][8 * cc + 3]); pw.z = pk2(st[j][8 * cc + 4], st[j][8 * cc + 5]); pw.w = pk2(st[j][8 * cc + 6], st[j][8 * cc + 7]);
                const bf16x8 pf = __builtin_bit_cast(bf16x8, pw);
#pragma unroll
                for (int dt = 0; dt < 2; ++dt) { const short* vr = vts + (r32 + 32 * dt) * 36 + 16 * cc + 4 * hi;
                    const s16x4 lo = *(const s16x4*)vr, h4 = *(const s16x4*)(vr + 8);
                    const bf16x8 vf = (bf16x8){lo[0], lo[1], lo[2], lo[3], h4[0], h4[1], h4[2], h4[3]};
                    O[dt] = __builtin_amdgcn_mfma_f32_32x32x16_bf16(vf, pf, O[dt], 0, 0, 0); }
            }
            WAVE_LDS_SYNC();
        }
    }
#undef DIL_ROW
    if (PASS < 2) {
#pragma unroll
        for (int dt = 0; dt < 2; ++dt)
#pragma unroll
            for (int i4 = 0; i4 < 4; ++i4) *(f32x4*)(ap + 32 * dt + 8 * i4) = (f32x4){O[dt][4 * i4], O[dt][4 * i4 + 1], O[dt][4 * i4 + 2], O[dt][4 * i4 + 3]};
        if (hi == 0) { mst[sidx] = m_new; lst[sidx] = l_new; }
    } else {
        const float inv = 1.0f / l_new; bf16_t* yp = ymix + (size_t)rowq * 1024 + 512 + head * 64 + 4 * hi;
#pragma unroll
        for (int dt = 0; dt < 2; ++dt)
#pragma unroll
            for (int i4 = 0; i4 < 4; ++i4) { u32x2 w; w.x = pk2(O[dt][4 * i4] * inv, O[dt][4 * i4 + 1] * inv); w.y = pk2(O[dt][4 * i4 + 2] * inv, O[dt][4 * i4 + 3] * inv); *(u32x2*)(yp + 32 * dt + 8 * i4) = w; }
    }
}
template <int PASS> __device__ __forceinline__ void dil_pass(int dilv, const bf16_t* proj, float* accst, float* mst, float* lst, bf16_t* ymix, unsigned char* lds, int wid, int lane, int gw, int ngw) {
    short* vts = (short*)(lds + wid * 4608);
    for (int u = gw; u < 8192; u += ngw) dil_unit<PASS>(u, dilv, proj, accst, mst, lst, ymix, vts, lane);
}

__device__ __forceinline__ void s5_coef(float lr, float li, float dt, float& ar, float& ai, float& cr, float& ci) {
    const float mag = expf(lr * dt); const float th = li * dt; const float kq = rintf(th * 0.15915494309189535f);
    float rr = fmaf(-kq, 6.2831854820251465f, th); rr = fmaf(-kq, -1.7484556000744883e-07f, rr);
    const float sn = __sinf(rr), cs = __cosf(rr); ar = mag * cs; ai = mag * sn;
    const float den = lr * lr + li * li, nr = ar - 1.f, ni = ai; cr = (nr * lr + ni * li) / den; ci = (ni * lr - nr * li) / den;
}
__device__ __forceinline__ float gelu_tanh(float x) { const float z = 1.5957691216057308f * (x + 0.044715f * x * x * x); return x * __builtin_amdgcn_rcpf(1.0f + __expf(-z)); }

}
#ifndef RP_ATTN
#define RP_ATTN 1
#define RP_DIL 1
#define RP_S5 1
#define RP_BAR 1
#define RP_UP 1
#define RP_PRO 1
#define RP_INP 1
#define RP_PP 1
#define RP_ELT 1
#define RP_OUT 1
#define RP_DOWN 1
#define RP_PLE 1
#define RP_GLU 1
#endif
namespace mk {
#define GAS __attribute__((address_space(1)))
struct DParams { GAS const float* in[29]; GAS float* out; GAS unsigned char* ws; };
typedef const __attribute__((address_space(4))) DParams* KArgs;
__device__ __forceinline__ void s5_phase(KArgs p, int o, const bf16_t* proj, bf16_t* yg, unsigned char* lds, int tid, int lane, int wid, int G, int bid) {
    constexpr int TC = 64, NCH = S / TC, BUP = 132, XP = 136;
    float* Bu = (float*)lds;
    bf16_t* Xs = (bf16_t*)(lds + 2 * TC * BUP * 4);
    const int r32 = lane & 31, hi = lane >> 5, l16 = lane & 15, kq = lane >> 4;
    for (int bg = bid; bg < 256; bg += G) {
        const int b = bg >> 5, g = bg & 31, og = o * 32 + g;
        const float* lam_re = (const float*)p->in[18] + og * 64; const float* lam_im = (const float*)p->in[19] + og * 64; const float dt = expf(p->in[20][og]);
        const float* b_re = (const float*)p->in[21] + (size_t)og * 1024; const float* b_im = (const float*)p->in[22] + (size_t)og * 1024;
        const float* c_re = (const float*)p->in[23] + (size_t)og * 1024; const float* c_im = (const float*)p->in[24] + (size_t)og * 1024; const float* dsk = (const float*)p->in[25] + og * 16;
        const bf16_t* ub = proj + (size_t)b * S * 2048 + g * 16;
        float ar = 0.f, ai = 0.f, xr = 0.f, xi = 0.f;
        bf16x8 Bf[4], Cf[4]; float dsc = 0.f;
        if (wid == 0) { float cr, ci; s5_coef(lam_re[lane], lam_im[lane], dt, ar, ai, cr, ci); }
        else {
#pragma unroll
            for (int nt = 0; nt < 4; ++nt) { const int pp = 16 * nt + (r32 >> 1); float a0, a1, cr, ci; s5_coef(lam_re[pp], lam_im[pp], dt, a0, a1, cr, ci);
                const f32x4 br0 = *(const f32x4*)(b_re + pp * 16 + 8 * hi), br1 = *(const f32x4*)(b_re + pp * 16 + 8 * hi + 4);
                const f32x4 bi0 = *(const f32x4*)(b_im + pp * 16 + 8 * hi), bi1 = *(const f32x4*)(b_im + pp * 16 + 8 * hi + 4);
                f32x4 v0, v1; if (r32 & 1) { v0 = cr * bi0 + ci * br0; v1 = cr * bi1 + ci * br1; } else { v0 = cr * br0 - ci * bi0; v1 = cr * br1 - ci * bi1; }
                u32x4 w; w.x = pk2(v0[0], v0[1]); w.y = pk2(v0[2], v0[3]); w.z = pk2(v1[0], v1[1]); w.w = pk2(v1[2], v1[3]); Bf[nt] = __builtin_bit_cast(bf16x8, w); }
#pragma unroll
            for (int ks = 0; ks < 4; ++ks) { const int p0 = 16 * ks + 4 * kq; const f32x4 cr4 = *(const f32x4*)(c_re + l16 * 64 + p0), ci4 = *(const f32x4*)(c_im + l16 * 64 + p0);
                u32x4 w; w.x = pk2(cr4[0], -ci4[0]); w.y = pk2(cr4[1], -ci4[1]); w.z = pk2(cr4[2], -ci4[2]); w.w = pk2(cr4[3], -ci4[3]); Cf[ks] = __builtin_bit_cast(bf16x8, w); }
            dsc = dsk[l16];
        }
#define S5_LDU(k, tt) (*(const bf16x8*)(ub + (size_t)(((k) < NCH ? (k) : NCH - 1) * TC + 32 * (tt) + r32) * 2048 + 8 * hi))
#define S5_BU(k) do { float* Bb = Bu + ((k) & 1) * TC * BUP; \
        { const int tile = wid - 1, tt = tile >> 2, nt = tile & 3; \
            const f32x16 a = __builtin_amdgcn_mfma_f32_32x32x16_bf16(ufa, nt == 0 ? Bf[0] : nt == 1 ? Bf[1] : nt == 2 ? Bf[2] : Bf[3], f32x16{}, 0, 0, 0); \
            _Pragma("unroll") for (int i = 0; i < 16; ++i) Bb[(32 * tt + crow(i, hi)) * BUP + 32 * nt + r32] = a[i]; } \
        if (wid == 1) { const f32x16 a = __builtin_amdgcn_mfma_f32_32x32x16_bf16(ufb, Bf[3], f32x16{}, 0, 0, 0); \
            _Pragma("unroll") for (int i = 0; i < 16; ++i) Bb[(32 + crow(i, hi)) * BUP + 96 + r32] = a[i]; } \
        ufa = S5_LDU((k) + 1, (wid - 1) >> 2); if (wid == 1) ufb = S5_LDU((k) + 1, 1); } while (0)
#define S5_LDUU(k) do { if (wid <= 4) { _Pragma("unroll") for (int j = 0; j < 4; ++j) uun[j] = proj[((size_t)b * S + ((k) < NCH ? (k) : NCH - 1) * TC + 16 * (wid - 1) + 4 * kq + j) * 2048 + g * 16 + l16]; } } while (0)
#define S5_CP(k) do { const bf16_t* Xb = Xs + ((k) & 1) * TC * XP; \
        if (wid <= 4) { const int tile = wid - 1; f32x4 a = (f32x4){0.f, 0.f, 0.f, 0.f}; \
            _Pragma("unroll") for (int ks = 0; ks < 4; ++ks) { const bf16x8 xf = *(const bf16x8*)(Xb + (16 * tile + l16) * XP + 32 * ks + 8 * kq); \
                a = __builtin_amdgcn_mfma_f32_16x16x32_bf16(xf, Cf[ks], a, 0, 0, 0); } \
            _Pragma("unroll") for (int j = 0; j < 4; ++j) { const size_t tok = (size_t)b * S + (k) * TC + 16 * tile + 4 * kq + j; \
                const float y = gelu_tanh(a[j] + dsc * bf1(uun[j])); \
                yg[tok * 512 + g * 16 + l16] = (bf16_t)(pk2(y, 0.f) & 0xffffu); } } \
        S5_LDUU((k) + 1); } while (0)
        bf16x8 ufa = bf16x8{}, ufb = bf16x8{}; bf16_t uun[4] = {0, 0, 0, 0};
        if (wid > 0) { ufa = S5_LDU(0, (wid - 1) >> 2); if (wid == 1) ufb = S5_LDU(0, 1); S5_LDUU(0); S5_BU(0); }
        __syncthreads();
        for (int k = 0; k < NCH; ++k) {
            if (wid == 0) {
                const float* Bb = Bu + (k & 1) * TC * BUP; bf16_t* Xb = Xs + (k & 1) * TC * XP;
                for (int t0 = 0; t0 < TC; t0 += 16) { f32x2_t bv[16];
#pragma unroll
                    for (int j = 0; j < 16; ++j) bv[j] = *(const f32x2_t*)(Bb + (t0 + j) * BUP + 2 * lane);
#pragma unroll
                    for (int j = 0; j < 16; ++j) { const float nr = fmaf(ar, xr, fmaf(-ai, xi, bv[j].x)), ni = fmaf(ar, xi, fmaf(ai, xr, bv[j].y)); xr = nr; xi = ni;
                        *(unsigned*)(Xb + (t0 + j) * XP + 2 * lane) = pk2(xr, xi); } }
            } else {
                if (k + 1 < NCH) S5_BU(k + 1);
                if (k >= 1) S5_CP(k - 1);
            }
            __syncthreads();
        }
        if (wid > 0) S5_CP(NCH - 1);
        __syncthreads();
#undef S5_BU
#undef S5_LDU
#undef S5_LDUU
#undef S5_CP
    }
}
__device__ __forceinline__ void conv_phase(const float* cw, const bf16_t* proj, bf16_t* ymix, int gtid, int nthr) {
    for (int idx = gtid; idx < T * 64; idx += nthr) { const int t = idx >> 6, c8 = (idx & 63) * 8, s = t & (S - 1);
        const bf16_t* row = proj + (size_t)t * 2048;
        float y[8];
#pragma unroll
        for (int e = 0; e < 8; ++e) y[e] = 0.f;
#pragma unroll
        for (int j = 0; j < 3; ++j) if (s - j >= 0) { const u32x4 gc = *(const u32x4*)(row - (size_t)j * 2048 + 1024 + c8), xt = *(const u32x4*)(row - (size_t)j * 2048 + 1536 + c8);
            const f32x4 w0 = *(const f32x4*)(cw + j * 512 + c8), w1 = *(const f32x4*)(cw + j * 512 + c8 + 4);
            y[0] += w0[0] * bflo(gc.x) * bflo(xt.x); y[1] += w0[1] * bfhi(gc.x) * bfhi(xt.x); y[2] += w0[2] * bflo(gc.y) * bflo(xt.y); y[3] += w0[3] * bfhi(gc.y) * bfhi(xt.y);
            y[4] += w1[0] * bflo(gc.z) * bflo(xt.z); y[5] += w1[1] * bfhi(gc.z) * bfhi(xt.z); y[6] += w1[2] * bflo(gc.w) * bflo(xt.w); y[7] += w1[3] * bfhi(gc.w) * bfhi(xt.w); }
        const u32x4 gb = *(const u32x4*)(row + 512 + c8); u32x4 o;
        o.x = pk2(y[0] * bflo(gb.x), y[1] * bfhi(gb.x)); o.y = pk2(y[2] * bflo(gb.y), y[3] * bfhi(gb.y)); o.z = pk2(y[4] * bflo(gb.z), y[5] * bfhi(gb.z)); o.w = pk2(y[6] * bflo(gb.w), y[7] * bfhi(gb.w));
        *(u32x4*)(ymix + (size_t)t * 1024 + 512 + c8) = o; }
}
__device__ __forceinline__ void diff_post(KArgs p, int e, float lam_init, const bf16_t* O16, bf16_t* ymix, int lane, int gtid, int nthr) {
    float a = p->in[11][e * 64 + lane] * p->in[12][e * 64 + lane], bb = p->in[13][e * 64 + lane] * p->in[14][e * 64 + lane];
    a = wave_sum(a); bb = wave_sum(bb);
    const float lam = expf(a) - expf(bb) + lam_init; const float* gain = (const float*)p->in[15] + e * 128;
    const int j = gtid & 15, vhalf = j >> 3, dd = (j & 7) * 8;
    const f32x4 g0 = *(const f32x4*)(gain + 8 * j), g1 = *(const f32x4*)(gain + 8 * j + 4);
    for (int grp = gtid >> 4; grp < T * 4; grp += nthr >> 4) { const int t = grp >> 2, h = grp & 3;
        const u32x4 o1 = *(const u32x4*)(O16 + (size_t)t * 1024 + ((h * 2 + 0) * 2 + vhalf) * 64 + dd), o2 = *(const u32x4*)(O16 + (size_t)t * 1024 + ((h * 2 + 1) * 2 + vhalf) * 64 + dd);
        float v[8];
        v[0] = bflo(o1.x) - lam * bflo(o2.x); v[1] = bfhi(o1.x) - lam * bfhi(o2.x); v[2] = bflo(o1.y) - lam * bflo(o2.y); v[3] = bfhi(o1.y) - lam * bfhi(o2.y);
        v[4] = bflo(o1.z) - lam * bflo(o2.z); v[5] = bfhi(o1.z) - lam * bfhi(o2.z); v[6] = bflo(o1.w) - lam * bflo(o2.w); v[7] = bfhi(o1.w) - lam * bfhi(o2.w);
        float ss = 0.f;
#pragma unroll
        for (int q = 0; q < 8; ++q) ss += v[q] * v[q];
        ss = xor_add<1>(ss); ss = xor_add<2>(ss); ss = xor_add<4>(ss); ss = xor_add<8>(ss);
        const float rs = rsqrtf(ss * (1.0f / 128.0f) + 1e-5f) * (1.0f - lam_init);
        u32x4 o; o.x = pk2(v[0] * rs * g0[0], v[1] * rs * g0[1]); o.y = pk2(v[2] * rs * g0[2], v[3] * rs * g0[3]); o.z = pk2(v[4] * rs * g1[0], v[5] * rs * g1[1]); o.w = pk2(v[6] * rs * g1[2], v[7] * rs * g1[3]);
        *(u32x4*)(ymix + (size_t)t * 1024 + h * 128 + 8 * j) = o; }
}

__device__ __forceinline__ KArgs kargs() { KArgs k = (KArgs)__builtin_amdgcn_kernarg_segment_ptr(); asm volatile("" : "+s"(k)); return k; }
constexpr size_t WS_BAR = WS_WM + 8 * MiB + 6 * MiB + MiB / 2;
constexpr int LDS_XB = 131072 + 1024;
#define LAS __attribute__((address_space(3)))
#define XB_TMO      128
#define XB_XCNT(j)  (256  + 64 * (j))
#define XB_XSUB(j)  (1280 + 64 * (j))
#define XB_XGEN(j)  (2304 + 64 * (j))
#define XB_TOP      3328
#define XB_TOPGEN   3392
#define XCD_BAR_WORDS 3456
#define XB_SPIN_CAP (1u << 18)

__device__ __forceinline__ unsigned xb_ld(unsigned* p)              { return __hip_atomic_load(p, __ATOMIC_RELAXED, __HIP_MEMORY_SCOPE_AGENT); }
__device__ __forceinline__ unsigned xb_add(unsigned* p, unsigned v) { return __hip_atomic_fetch_add(p, v, __ATOMIC_RELAXED, __HIP_MEMORY_SCOPE_AGENT); }
__device__ __forceinline__ unsigned xb_xcc_id() { return (unsigned)__builtin_amdgcn_s_getreg((3 << 11) | 20) & 0xFu; }
#define XB_SPIN(cond, bar) do { unsigned _sp = 0; while (cond) { __builtin_amdgcn_s_sleep(1); \
    if ((++_sp & 255u) == 0u) { if (xb_ld(&(bar)[XB_TMO])) break; if (_sp > XB_SPIN_CAP) { atomicAdd(&(bar)[XB_TMO], 1u); break; } } } } while (0)

struct XcdBarrier {
    unsigned* bar; unsigned x;
    volatile LAS unsigned* st;
};

__device__ __forceinline__ XcdBarrier xcd_barrier_post(unsigned* bar, volatile LAS unsigned* st) {
    XcdBarrier b; b.bar = bar; b.x = xb_xcc_id(); b.st = st;
    if (threadIdx.x == 0) (void)xb_add(&bar[XB_XCNT(b.x)], 1u);
    return b;
}
__device__ __forceinline__ void xcd_barrier_complete(unsigned* bar, unsigned x, unsigned& nloc, unsigned& nx) {
    const unsigned G = gridDim.x * gridDim.y * gridDim.z;
    unsigned sum, cnt, mine, sp = 0u;
    for (;;) {
        sum = 0u; cnt = 0u; mine = 0u;
#pragma unroll
        for (unsigned j = 0; j < 16; ++j) { const unsigned c = xb_ld(&bar[XB_XCNT(j)]); sum += c; cnt += (c > 0u) ? 1u : 0u; mine = (j == x) ? c : mine; }
        if (sum == G) break;
        __builtin_amdgcn_s_sleep(1);
        if ((++sp & 255u) == 0u) { if (xb_ld(&bar[XB_TMO])) break; if (sp > XB_SPIN_CAP) { atomicAdd(&bar[XB_TMO], 1u); break; } }
    }
    nloc = mine > 0u ? mine : 1u; nx = cnt > 0u ? cnt : 1u;
}

__device__ __forceinline__ void xcd_barrier(const XcdBarrier& b) {
    asm volatile("s_waitcnt vmcnt(0)" ::: "memory");
    __syncthreads();
    if (threadIdx.x == 0) {
        unsigned* bar = b.bar;
        __builtin_amdgcn_s_waitcnt(0);
        unsigned nloc = b.st[0], nx = b.st[1];
        if (nloc == 0u) { xcd_barrier_complete(bar, b.x, nloc, nx); b.st[0] = nloc; b.st[1] = nx; }
        const unsigned old = xb_add(&bar[XB_XSUB(b.x)], 1u);
        const unsigned gen = old / nloc;
        if (old + 1u == (gen + 1u) * nloc) {
            __builtin_amdgcn_fence(__ATOMIC_RELEASE, "agent");
            asm volatile("s_waitcnt vmcnt(0)" ::: "memory");
            const unsigned og = xb_add(&bar[XB_TOP], 1u);
            const unsigned tg = og / nx;
            if (og + 1u == (tg + 1u) * nx) xb_add(&bar[XB_TOPGEN], 1u);
            else XB_SPIN(xb_ld(&bar[XB_TOPGEN]) == tg, bar);
            __builtin_amdgcn_fence(__ATOMIC_ACQUIRE, "agent");
            xb_add(&bar[XB_XGEN(b.x)], 1u);
            asm volatile("s_waitcnt vmcnt(0)" ::: "memory");
        } else {
            XB_SPIN(xb_ld(&bar[XB_XGEN(b.x)]) == gen, bar);
            __builtin_amdgcn_fence(__ATOMIC_ACQUIRE, "agent");
            asm volatile("s_waitcnt vmcnt(0)" ::: "memory");
        }
    }
    __syncthreads();
}

__device__ __forceinline__ void grid_bar1(unsigned) {
    XcdBarrier xbv; xbv.bar = (unsigned*)((unsigned char*)kargs()->ws + WS_BAR); xbv.x = xb_xcc_id(); xbv.st = (volatile LAS unsigned*)(LDS_XB);
    xcd_barrier(xbv);
}
__device__ __forceinline__ void grid_bar(unsigned epoch) { for (int rp = 0; rp < RP_BAR; ++rp) grid_bar1(epoch); }
#define PH_BEGIN KArgs ka = kargs(); unsigned char* ws = (unsigned char*)ka->ws; int tid = threadIdx.x; asm volatile("" : "+v"(tid)); int bid = blockIdx.x; asm volatile("" : "+s"(bid)); const int lane = tid & 63, wid = __builtin_amdgcn_readfirstlane(tid >> 6), G = gridDim.x; \
    const int gw = bid * 8 + wid, ngw = G * 8, gtid = bid * 512 + tid, nthr = G * 512; (void)lane; (void)gw; (void)ngw; (void)gtid; (void)nthr; (void)ws;
#define WL(i) (ws + WS_W + (size_t)(i) * WS_WL)
#define WM(i) (ws + WS_WM + (size_t)(i) * 8 * MiB)
#define SBUF(j) ((bf16_t*)ka->out + (size_t)((j) & 1) * T * 1024)
#define SSQ(k) ((float*)(ws + WS_SSQ + (size_t)((k) & 1) * 2 * MiB))
template <int i> __device__ __forceinline__ void layer_body(unsigned char* lds, PG8_LAS unsigned char* ldsp) {
    unsigned ep = (i == 0 ? 0u : i == 1 ? 8u : i == 2 ? 15u : 23u);
        for (int rp = 0; rp < RP_INP; ++rp) { PH_BEGIN const bool odd = (i & 1) != 0; const int N = odd ? 2048 : 3072;
            pg8::Gemm g{SBUF(i), (const bf16_t*)WM(i), T, N, 1024};     pg8::StaticOrder SO; SO.init(T, N, G, bid);
            pg8::EpiRow<0> E{(bf16_t*)(ws + WS_BIG), odd ? 2048 : 512, SSQ(3 * i), odd ? 0u : 0xC3u, C2, odd ? 0 : 512, TSQ};
            pg8::gemm_phase<pg8::EpiRow<0>, pg8::StaticOrder, true, true>(ldsp, g, SO, E); }
        grid_bar(++ep);
        if ((i & 1) == 0) {
            { PH_BEGIN const int vcu0 = (G % 8 == 0) ? (bid % 8) * (G / 8) + (bid / 8) : bid;
                for (int rp = 0; rp < RP_ATTN; ++rp) for (int vcu = vcu0; vcu < 256; vcu += G) { const int pair = vcu >> 1, s = vcu & 1, b = pair >> 4, vh = pair & 15, h = vh >> 2, c = (vh >> 1) & 1, vhalf = vh & 1;
                    for (int it = 0; it < 8; ++it) { const int j = s + 2 * (it >> 1), qb = (it & 1) ? 15 - j : j;
                        const attn_body::bf16* P = (const attn_body::bf16*)((unsigned char*)kargs()->ws + WS_BIG);
                        attn_body::attn_unit<8>(b, 0, qb, P + h * 128 + c * 64, P + TSQ + h * 128 + c * 64, P + 2 * TSQ + h * 128 + vhalf * 64, (attn_body::bf16*)((unsigned char*)kargs()->ws + WS_O16) + vh * 64, (char*)lds); } } }
            __syncthreads();
            { PH_BEGIN float* dm = (float*)(ws + WS_DML);
                for (int rp = 0; rp < RP_DIL; ++rp) dil_pass<0>(1, (const bf16_t*)(ws + WS_BIG), (float*)(ws + WS_HB), dm, dm + (size_t)T * 8, (bf16_t*)(ws + WS_YMIX), lds, wid, lane, gw, ngw);
                convert_p((const float*)ka->in[1] + (size_t)i * T * 256, (bf16_t*)(ws + WS_PB), gtid, nthr); }
            grid_bar(++ep);
            { PH_BEGIN float* dm = (float*)(ws + WS_DML);
                dil_pass<1>(4, (const bf16_t*)(ws + WS_BIG), (float*)(ws + WS_HB), dm, dm + (size_t)T * 8, (bf16_t*)(ws + WS_YMIX), lds, wid, lane, gw, ngw); }
            grid_bar(++ep);
            { PH_BEGIN float* dm = (float*)(ws + WS_DML);
                dil_pass<2>(16, (const bf16_t*)(ws + WS_BIG), (float*)(ws + WS_HB), dm, dm + (size_t)T * 8, (bf16_t*)(ws + WS_YMIX), lds, wid, lane, gw, ngw); }
            { PH_BEGIN const float lam_init = 0.8f - 0.6f * expf(-0.3f * (float)i);
                for (int rp = 0; rp < RP_ELT; ++rp) diff_post(ka, i >> 1, lam_init, (const bf16_t*)(ws + WS_O16), (bf16_t*)(ws + WS_YMIX), lane, gtid, nthr); }
            grid_bar(++ep);
        } else {
            for (int rp = 0; rp < RP_S5; ++rp) { PH_BEGIN s5_phase(ka, i >> 1, (const bf16_t*)(ws + WS_BIG), (bf16_t*)(ws + WS_HB), lds, tid, lane, wid, G, bid); }
            for (int rp = 0; rp < RP_ELT; ++rp) { PH_BEGIN conv_phase((const float*)ka->in[27] + (i >> 1) * 3 * 512, (const bf16_t*)(ws + WS_BIG), (bf16_t*)(ws + WS_YMIX), gtid, nthr);
                convert_p((const float*)ka->in[1] + (size_t)i * T * 256, (bf16_t*)(ws + WS_PB), gtid, nthr); }
            grid_bar(++ep);
            for (int rp = 0; rp < RP_GLU; ++rp) { PH_BEGIN pg8::Gemm g{(const bf16_t*)(ws + WS_HB), (const bf16_t*)(WM(i) + 6 * MiB), T, 512, 512}; pg8::StaticOrder SO; SO.init(T, 512, G, bid);
                pg8::EpiGlu E{(bf16_t*)(ws + WS_YMIX), (const bf16_t*)(ws + WS_HB)};
                pg8::gemm_phase<pg8::EpiGlu, pg8::StaticOrder, true, true>(ldsp, g, SO, E); }
            grid_bar(++ep);
        }
        for (int rp = 0; rp < RP_OUT; ++rp) { PH_BEGIN const bool odd = (i & 1) != 0;
            pg8::Gemm g{(const bf16_t*)(ws + WS_YMIX), (const bf16_t*)(WM(i) + (odd ? 4 : 6) * MiB), T, 1024, 1024}; pg8::StaticOrder SO; SO.init(T, 1024, G, bid);
            pg8::EpiRes<0> E{SBUF(i), (rp < RP_OUT - 1) ? (bf16_t*)(ws + WS_HB) : SBUF(i), SSQ(3 * i + 1), nullptr, nullptr};
            pg8::gemm_phase<pg8::EpiRes<0>, pg8::StaticOrder, true, true>(ldsp, g, SO, E); }
        grid_bar(++ep);
        for (int rp = 0; rp < RP_PP; ++rp) { PH_BEGIN pg8::Gemm g{(const bf16_t*)(ws + WS_PB), (const bf16_t*)(WL(i) + 18 * MiB), T, 1024, 256}; pg8::StaticOrder SO; SO.init(T, 1024, G, bid);
            pg8::EpiPP E{(bf16_t*)(ws + WS_YMIX)};
            pg8::gemm_phase<pg8::EpiPP, pg8::StaticOrder, true, true>(ldsp, g, SO, E); }
        for (int rp = 0; rp < RP_UP; ++rp) { PH_BEGIN pg8::Gemm g{SBUF(i), (const bf16_t*)WL(i), T, 4096, 1024}; pg8::StaticOrder SO; SO.init(T, 4096, G, bid);
            pg8::EpiRow<1> E{(bf16_t*)(ws + WS_BIG), 4096, SSQ(3 * i + 1), 0u, 1.f, 0, 0};
            pg8::gemm_phase<pg8::EpiRow<1>, pg8::StaticOrder, true, true>(ldsp, g, SO, E); }
        grid_bar(++ep);
        for (int rp = 0; rp < RP_DOWN; ++rp) { PH_BEGIN pg8::Gemm g{(const bf16_t*)(ws + WS_BIG), (const bf16_t*)(WL(i) + 8 * MiB), T, 1024, 4096}; pg8::StaticOrder SO; SO.init(T, 1024, G, bid); SO.rev = 1;
            pg8::EpiRes<0> E{SBUF(i), (rp < RP_DOWN - 1) ? (bf16_t*)(ws + WS_HB) : SBUF(i), SSQ(3 * i + 2), nullptr, nullptr};
            pg8::gemm_phase<pg8::EpiRes<0>, pg8::StaticOrder, true, true>(ldsp, g, SO, E); }
        grid_bar(++ep);
        for (int rp = 0; rp < RP_PLE; ++rp) { PH_BEGIN pg8::Gemm g{SBUF(i), (const bf16_t*)(WL(i) + 16 * MiB), T, 1024, 1024}; pg8::StaticOrder SO; SO.init(T, 1024, G, bid);
            pg8::EpiRes<1> E{SBUF(i), (rp < RP_PLE - 1) ? (bf16_t*)(ws + WS_BIG) : (i == 3) ? (bf16_t*)(ws + WS_HB) : SBUF(i + 1), SSQ(3 * i + 3), SSQ(3 * i + 2), (const bf16_t*)(ws + WS_YMIX)};
            pg8::gemm_phase<pg8::EpiRes<1>, pg8::StaticOrder, true, true>(ldsp, g, SO, E); }
        grid_bar(++ep);
}
__global__ void __launch_bounds__(512, 2) fwd(Params p_unused) {
    extern __shared__ __attribute__((aligned(16))) unsigned char lds[];
    PG8_LAS unsigned char* ldsp = (PG8_LAS unsigned char*)lds;
    for (int rp = 0; rp < RP_PRO; ++rp) {
    { PH_BEGIN
        float* ssq = SSQ(0); bf16_t* hb = SBUF(0); const float* x = (const float*)ka->in[0];
        { f32x4 vn[4]; int m = gw;
            if (m < T) { const f32x4* xr = (const f32x4*)(x + (size_t)m * 1024) + lane;
#pragma unroll
                for (int j = 0; j < 4; ++j) vn[j] = __builtin_nontemporal_load(xr + 64 * j); }
            for (; m < T; m += ngw) { f32x4 v[4]; float s = 0.f;
#pragma unroll
                for (int j = 0; j < 4; ++j) v[j] = vn[j];
                if (m + ngw < T) { const f32x4* xn = (const f32x4*)(x + (size_t)(m + ngw) * 1024) + lane;
#pragma unroll
                    for (int j = 0; j < 4; ++j) vn[j] = __builtin_nontemporal_load(xn + 64 * j); }
#pragma unroll
                for (int j = 0; j < 4; ++j) s += (v[j][0] * v[j][0] + v[j][1] * v[j][1]) + (v[j][2] * v[j][2] + v[j][3] * v[j][3]);
                s = wave_sum(s); if (lane < 16) ssq[(size_t)m * 16 + lane] = (lane == 0) ? s : 0.f;
                u32x2* o8 = (u32x2*)(hb + (size_t)m * 1024) + lane;
#pragma unroll
                for (int j = 0; j < 4; ++j) { u32x2 w; w.x = pk2(v[j][0], v[j][1]); w.y = pk2(v[j][2], v[j][3]); o8[64 * j] = w; } } } }
    for (int i = 0; i < 4; ++i) { PH_BEGIN
        float* scr = (float*)(lds + wid * 8448); unsigned char* wl = WL(i); unsigned char* wm = WM(i); const int e = i >> 1;
        transpose_items((const float*)ka->in[5] + (size_t)i * 1024 * 4096, 1024, 4096, (const float*)ka->in[3] + i * 1024, (bf16_t*)wl, scr, gw, ngw, lane);
        transpose_items((const float*)ka->in[6] + (size_t)i * 1024 * 4096, 4096, 1024, nullptr, (bf16_t*)(wl + 8 * MiB), scr, gw, ngw, lane);
        transpose_items((const float*)ka->in[8] + (size_t)i * 1024 * 1024, 1024, 1024, (const float*)ka->in[4] + i * 1024, (bf16_t*)(wl + 16 * MiB), scr, gw, ngw, lane);
        transpose_items((const float*)ka->in[7] + (size_t)i * 256 * 1024, 256, 1024, nullptr, (bf16_t*)(wl + 18 * MiB), scr, gw, ngw, lane);
        if ((i & 1) == 0) {
            transpose_items((const float*)ka->in[9] + (size_t)e * 1024 * 3072, 1024, 3072, (const float*)ka->in[2] + i * 1024, (bf16_t*)wm, scr, gw, ngw, lane);
            transpose_items((const float*)ka->in[10] + (size_t)e * 1024 * 1024, 1024, 1024, nullptr, (bf16_t*)(wm + 6 * MiB), scr, gw, ngw, lane);
        } else {
            transpose_items((const float*)ka->in[16] + (size_t)e * 1024 * 2048, 1024, 2048, (const float*)ka->in[2] + i * 1024, (bf16_t*)wm, scr, gw, ngw, lane);
            transpose_items((const float*)ka->in[17] + (size_t)e * 1024 * 1024, 1024, 1024, nullptr, (bf16_t*)(wm + 4 * MiB), scr, gw, ngw, lane);
            transpose_items((const float*)ka->in[26] + (size_t)e * 512 * 512, 512, 512, nullptr, (bf16_t*)(wm + 6 * MiB), scr, gw, ngw, lane);
        } }
    }
    { KArgs ka0 = kargs(); unsigned* bw = (unsigned*)((unsigned char*)ka0->ws + WS_BAR);
        if (blockIdx.x == 0) for (int w = threadIdx.x; w < XCD_BAR_WORDS; w += 512) __hip_atomic_store(bw + w, 0u, __ATOMIC_RELAXED, __HIP_MEMORY_SCOPE_AGENT);
        if (threadIdx.x < 2) ((volatile LAS unsigned*)(LDS_XB))[threadIdx.x] = 0u; }
    cg::this_grid().sync();
    { KArgs ka0 = kargs(); (void)xcd_barrier_post((unsigned*)((unsigned char*)ka0->ws + WS_BAR), (volatile LAS unsigned*)(LDS_XB)); }
    layer_body<0>(lds, ldsp); layer_body<1>(lds, ldsp); layer_body<2>(lds, ldsp); layer_body<3>(lds, ldsp);
    { PH_BEGIN const float* gf = (const float*)ka->in[28]; const float* sq = SSQ(12); float* hf = (float*)ka->out; const bf16_t* hs = (const bf16_t*)(ws + WS_HB);
        for (int m = gw; m < T; m += ngw) { f32x4* xr = (f32x4*)(hf + (size_t)m * 1024) + lane; const u32x2* hr = (const u32x2*)(hs + (size_t)m * 1024) + lane; const float rs = rsqrtf(pg8::ssq16(sq, m) * (1.0f / 1024.0f) + 1e-6f);
#pragma unroll
            for (int j = 0; j < 4; ++j) { const f32x4 gv = ((const f32x4*)gf)[lane + 64 * j]; const u32x2 hv = hr[64 * j]; xr[64 * j] = (f32x4){bflo(hv.x), bfhi(hv.x), bflo(hv.y), bfhi(hv.y)} * rs * gv; } } }
}
}

extern "C" void kernel_launch(void* const* d_in, const int* in_sizes, int n_in, void* d_out, int out_size, void* d_ws, size_t ws_size, hipStream_t stream) {
    static int grid_blocks = 0;
    if (!grid_blocks) {
        int dev = 0, cus = 0, per_cu = 0;
        (void)hipGetDevice(&dev);
        (void)hipDeviceGetAttribute(&cus, hipDeviceAttributeMultiprocessorCount, dev);
        (void)hipFuncSetAttribute((const void*)mk::fwd, hipFuncAttributeMaxDynamicSharedMemorySize, mk::LDS_BYTES);
        (void)hipOccupancyMaxActiveBlocksPerMultiprocessor(&per_cu, (const void*)mk::fwd, 512, mk::LDS_BYTES);
        (void)hipGetLastError();
        grid_blocks = cus > 0 ? cus : 256;
        if (ws_size < mk::WS_END || n_in != 29) { fprintf(stderr, "kernel_launch: workspace %zu < %zu or n_in %d != 29\n", ws_size, (size_t)mk::WS_END, n_in); }
    }
    (void)hipMemsetAsync((unsigned char*)d_ws + mk::WS_BAR, 0, 256, stream);
    mk::Params p{};
    for (int i = 0; i < 29; ++i) p.in[i] = (const float*)d_in[i];
    p.out = (float*)d_out; p.ws = (unsigned char*)d_ws;
    void* args[] = {&p};
    hipError_t e = hipLaunchCooperativeKernel((const void*)mk::fwd, dim3(grid_blocks), dim3(512), args, mk::LDS_BYTES, stream);
    if (e != hipSuccess) fprintf(stderr, "cooperative launch failed: %s (grid %d)\n", hipGetErrorString(e), grid_blocks);
}
```

```cpp
#include <hip/hip_runtime.h>
#include <cstdio>
#include <cstdint>

template <int K> __device__ __forceinline__ float xor_add(float v) {
    if constexpr (K < 32) return v + __int_as_float(__builtin_amdgcn_ds_swizzle(__float_as_int(v), (K << 10) | 0x1f));
    else { auto rr = __builtin_amdgcn_permlane32_swap(__float_as_uint(v), __float_as_uint(v), false, false); return __uint_as_float(rr[0]) + __uint_as_float(rr[1]); }
}
template <int K> __device__ __forceinline__ float xor_max(float v) {
    if constexpr (K < 32) return fmaxf(v, __int_as_float(__builtin_amdgcn_ds_swizzle(__float_as_int(v), (K << 10) | 0x1f)));
    else { auto rr = __builtin_amdgcn_permlane32_swap(__float_as_uint(v), __float_as_uint(v), false, false); return fmaxf(__uint_as_float(rr[0]), __uint_as_float(rr[1])); }
}
namespace pg8 {
#define PG8_LAS __attribute__((address_space(3)))
typedef unsigned short bf16_t;
typedef short bf16x8 __attribute__((ext_vector_type(8)));
typedef float f32x4 __attribute__((ext_vector_type(4)));
typedef unsigned u32x4 __attribute__((ext_vector_type(4)));
constexpr int BM = 256, BK = 64, HALF = 128, HTB = HALF * BK * 2  , STAGE_BYTES = 8 * HTB, NXCD = 8, WGM = 8;

__host__ __device__ __forceinline__ int lds_byte(int r, int c) { const int st = (r >> 4) * 2 + (c >> 5), rr = r & 15, cc = c & 31, ob = rr * 64 + cc * 2; return st * 1024 + (ob ^ (((ob >> 9) & 1) << 5)); }
__host__ __device__ __forceinline__ void stage_rc(int b, int& R, int& C) { const int st = b / 1024, sb = b % 1024, swz = sb ^ (((sb >> 9) & 1) << 5); R = (st >> 1) * 16 + swz / 64; C = (st & 1) * 32 + (swz % 64) / 2; }
__host__ __device__ __forceinline__ int perm32(int rho) { const int n = rho >> 4, i = rho & 15; return 8 * (i >> 2) + 4 * n + (i & 3); }

struct Unit { int pm, pn; };
struct Gemm { const bf16_t* A; const bf16_t* Bt; int M, N, K; };

struct StaticOrder {
    int nM, nN, nwg, G, c, rev;
    __host__ __device__ void init(int M, int N, int G_, int c_) { nM = M / BM; nN = N / BM; nwg = nM * nN; G = G_; c = c_; rev = 0; }
    __host__ __device__ bool next(int i, Unit& u) const {
        const long L = (long)i * G + c; if (L >= nwg) return false;
        int wgid = (int)L; { const int q = nwg / NXCD, r = nwg % NXCD, xcd = wgid % NXCD, off = wgid / NXCD; wgid = (xcd < r ? xcd * (q + 1) : r * (q + 1) + (xcd - r) * q) + off; }
        const int nig = WGM * nN, gid = wgid / nig, fm = gid * WGM, gsz = (nM - fm) < WGM ? (nM - fm) : WGM;
        u.pm = fm + ((wgid % nig) % gsz); u.pn = (wgid % nig) / gsz; if (rev) u.pm = nM - 1 - u.pm; return true;
    }
    __device__ __forceinline__ void a_ready(const Unit&) const {}
    __device__ __forceinline__ void done(const Unit&) const {}
};

__device__ __forceinline__ unsigned cvt_pk_bf16(float lo, float hi) { unsigned r; asm volatile("v_cvt_pk_bf16_f32 %0, %1, %2" : "=v"(r) : "v"(lo), "v"(hi)); return r; }
typedef float f32x2 __attribute__((ext_vector_type(2)));
constexpr float RMS_EPS = 1e-6f;
typedef unsigned u32x2 __attribute__((ext_vector_type(2)));
__device__ __forceinline__ float sigm(float x) { return __builtin_amdgcn_rcpf(1.0f + __expf(-x)); }
__device__ __forceinline__ float bflo(unsigned w) { return __uint_as_float(w << 16); }
__device__ __forceinline__ float bfhi(unsigned w) { return __uint_as_float(w & 0xffff0000u); }
__device__ __forceinline__ float ssq16(const float* s, int r) { const f32x4* q = (const f32x4*)(s + (size_t)r * 16); const f32x4 a = q[0] + q[1], b = q[2] + q[3], c = a + b; return (c[0] + c[1]) + (c[2] + c[3]); }
template <int ACT> struct EpiRow {
    static constexpr bool PERM = true, AFTER_DRAIN = false;
    bf16_t* O; int ldc; const float* ssq; unsigned qmask; float qscale; int split_cols; size_t split_stride;
    __device__ __forceinline__ void operator()(const f32x4 (&acc)[2][2][4][2], const Unit& u, int wr, int wc, int fr, int fq) const {
        int colt = u.pn * BM; bf16_t* Ob = O; if (split_cols) { const int t = colt / split_cols; Ob += (size_t)t * split_stride; colt -= t * split_cols; }
        const int row0 = u.pm * BM + wr * 64 + fr, col0 = colt + wc * 32 + 8 * fq;
        const float cs = ((qmask >> u.pn) & 1u) ? qscale : 1.f;
#pragma unroll
        for (int ai = 0; ai < 2; ++ai)
#pragma unroll
            for (int m = 0; m < 4; ++m) { const int r = row0 + ai * HALF + m * 16; const float rs = rsqrtf(ssq16(ssq, r) * (1.0f / 1024.0f) + RMS_EPS) * cs;
                bf16_t* rowp = Ob + (size_t)r * ldc + col0;
#pragma unroll
                for (int bj = 0; bj < 2; ++bj) { f32x4 v0 = acc[ai][bj][m][0] * rs, v1 = acc[ai][bj][m][1] * rs;
                    if (ACT == 1) {
#pragma unroll
                        for (int e = 0; e < 4; ++e) { const float a = fmaxf(v0[e], 0.f), b = fmaxf(v1[e], 0.f); v0[e] = a * a; v1[e] = b * b; } }
                    u32x4 w; w.x = cvt_pk_bf16(v0[0], v0[1]); w.y = cvt_pk_bf16(v0[2], v0[3]); w.z = cvt_pk_bf16(v1[0], v1[1]); w.w = cvt_pk_bf16(v1[2], v1[3]);
                    *(u32x4*)(rowp + bj * HALF) = w; } }
    }
};
template <int MODE> struct EpiRes {
    static constexpr bool PERM = false, AFTER_DRAIN = false;
    const bf16_t* base; bf16_t* outb; float* ssq_next; const float* ssq_cur; const bf16_t* pp;
    __device__ __forceinline__ void operator()(const f32x4 (&acc)[2][2][4][2], const Unit& u, int wr, int wc, int fr, int fq) const {
        const int row0 = u.pm * BM + wr * 64 + fr, col0 = u.pn * BM + wc * 32 + 4 * fq;
#pragma unroll
        for (int ai = 0; ai < 2; ++ai)
#pragma unroll
            for (int m = 0; m < 4; ++m) { const int r = row0 + ai * HALF + m * 16; const size_t off = (size_t)r * 1024 + col0; float sq = 0.f;
                float rs = 0.f; if (MODE == 1) rs = rsqrtf(ssq16(ssq_cur, r) * (1.0f / 1024.0f) + RMS_EPS);
#pragma unroll
                for (int bj = 0; bj < 2; ++bj)
#pragma unroll
                    for (int n = 0; n < 2; ++n) { const size_t o = off + bj * HALF + n * 16; f32x4 a = acc[ai][bj][m][n];
                        if (MODE == 1) { const u32x2 g = *(const u32x2*)(pp + o);
                            a[0] = bflo(g.x) * sigm(a[0] * rs); a[1] = bfhi(g.x) * sigm(a[1] * rs); a[2] = bflo(g.y) * sigm(a[2] * rs); a[3] = bfhi(g.y) * sigm(a[3] * rs); }
                        const u32x2 bv = *(const u32x2*)(base + o);
                        const f32x4 hv = (f32x4){bflo(bv.x), bfhi(bv.x), bflo(bv.y), bfhi(bv.y)} + a;
                        u32x2 w; w.x = cvt_pk_bf16(hv[0], hv[1]); w.y = cvt_pk_bf16(hv[2], hv[3]); *(u32x2*)(outb + o) = w;
                        sq += (hv[0] * hv[0] + hv[1] * hv[1]) + (hv[2] * hv[2] + hv[3] * hv[3]); }
                sq = xor_add<16>(sq); sq = xor_add<32>(sq);
                if (fq == 0) ssq_next[(size_t)r * 16 + u.pn * 4 + wc] = sq; }
    }
};
struct EpiPP {
    static constexpr bool PERM = false, AFTER_DRAIN = false;
    bf16_t* O;
    __device__ __forceinline__ void operator()(const f32x4 (&acc)[2][2][4][2], const Unit& u, int wr, int wc, int fr, int fq) const {
        const int row0 = u.pm * BM + wr * 64 + fr, col0 = u.pn * BM + wc * 32 + 4 * fq;
#pragma unroll
        for (int ai = 0; ai < 2; ++ai)
#pragma unroll
            for (int m = 0; m < 4; ++m) { const size_t off = (size_t)(row0 + ai * HALF + m * 16) * 1024 + col0;
#pragma unroll
                for (int bj = 0; bj < 2; ++bj)
#pragma unroll
                    for (int n = 0; n < 2; ++n) { const f32x4 a = acc[ai][bj][m][n]; u32x2 w; w.x = cvt_pk_bf16(a[0], a[1]); w.y = cvt_pk_bf16(a[2], a[3]); *(u32x2*)(O + off + bj * HALF + n * 16) = w; } }
    }
};
struct EpiGlu {
    static constexpr bool PERM = true, AFTER_DRAIN = false;
    bf16_t* O; const bf16_t* yg;
    __device__ __forceinline__ void operator()(const f32x4 (&acc)[2][2][4][2], const Unit& u, int wr, int wc, int fr, int fq) const {
        const int row0 = u.pm * BM + wr * 64 + fr, col0 = u.pn * BM + wc * 32 + 8 * fq;
#pragma unroll
        for (int ai = 0; ai < 2; ++ai)
#pragma unroll
            for (int m = 0; m < 4; ++m) { const int r = row0 + ai * HALF + m * 16;
#pragma unroll
                for (int bj = 0; bj < 2; ++bj) { const int c = col0 + bj * HALF; const u32x4 y = *(const u32x4*)(yg + (size_t)r * 512 + c);
                    const f32x4 v0 = acc[ai][bj][m][0], v1 = acc[ai][bj][m][1]; u32x4 w;
                    w.x = cvt_pk_bf16(bflo(y.x) * sigm(v0[0]), bfhi(y.x) * sigm(v0[1])); w.y = cvt_pk_bf16(bflo(y.y) * sigm(v0[2]), bfhi(y.y) * sigm(v0[3]));
                    w.z = cvt_pk_bf16(bflo(y.z) * sigm(v1[0]), bfhi(y.z) * sigm(v1[1])); w.w = cvt_pk_bf16(bflo(y.w) * sigm(v1[2]), bfhi(y.w) * sigm(v1[3]));
                    *(u32x4*)(O + (size_t)r * 1024 + c) = w; } }
    }
};
template <class Epi, class Sched, bool ALIGN_EPI = false, bool SP2 = false>
__device__ __forceinline__ void gemm_phase(PG8_LAS unsigned char* lds, const Gemm g, const Sched& S, const Epi& E) {
    int tid = threadIdx.x; asm volatile("" : "+v"(tid)); const int wid = __builtin_amdgcn_readfirstlane(tid >> 6), lane = tid & 63, wr = wid >> 2, wc = wid & 3, fr = lane & 15, fq = lane >> 4;
    const int K = g.K, nt = K / BK;
    unsigned voffA[2], voffB[2];
#pragma unroll
    for (int i = 0; i < 2; ++i) { int R, C; stage_rc(tid * 16 + i * 8192, R, C); const int Rb = Epi::PERM ? ((R & ~31) + perm32(R & 31)) : R;
        voffA[i] = (unsigned)(R * K + C) * 2u; voffB[i] = (unsigned)(Rb * K + C) * 2u; }
    const size_t kstep = (size_t)(BK * 2);
    const size_t hstep = (size_t)HALF * K * 2;
    const size_t tstep = 2 * hstep;
    const unsigned ldsw = (unsigned)wid * 1024u;
    const int aoff = lds_byte(wr * 64 + fr, fq * 8), boff = lds_byte(wc * 32 + fr, fq * 8);
#define PG8_SA(b, h) (((b) * 2 + (h)) * HTB)
#define PG8_SB(b, h) ((4 + (b) * 2 + (h)) * HTB)
#define PG8_STAGE(bufoff, gbase, voff) do { _Pragma("unroll") for (int _i = 0; _i < 2; ++_i) \
        __builtin_amdgcn_global_load_lds((const unsigned*)((const char*)(gbase) + (voff)[_i]), (PG8_LAS unsigned*)(lds + (bufoff) + ldsw + _i * 8192), 16, 0, 0); } while (0)
#define PG8_LDA(dst, b, h) do { _Pragma("unroll") for (int m = 0; m < 4; ++m) _Pragma("unroll") for (int k = 0; k < 2; ++k) dst[m][k] = *(const PG8_LAS bf16x8*)(lds + PG8_SA(b, h) + aoff + m * 2048 + k * 1024); } while (0)
#define PG8_LDB(dst, b, h) do { _Pragma("unroll") for (int n = 0; n < 2; ++n) _Pragma("unroll") for (int k = 0; k < 2; ++k) dst[n][k] = *(const PG8_LAS bf16x8*)(lds + PG8_SB(b, h) + boff + n * 2048 + k * 1024); } while (0)
#define PG8_MMA(ai, bj, At, Bt) do { __builtin_amdgcn_s_setprio(1); _Pragma("unroll") for (int m = 0; m < 4; ++m) _Pragma("unroll") for (int n = 0; n < 2; ++n) _Pragma("unroll") for (int k = 0; k < 2; ++k) \
        acc[ai][bj][m][n] = __builtin_amdgcn_mfma_f32_16x16x32_bf16(Bt[n][k], At[m][k], acc[ai][bj][m][n], 0, 0, 0); __builtin_amdgcn_s_setprio(0); } while (0)
#define PG8_WAIT_V(n) asm volatile("s_waitcnt vmcnt(" #n ")" ::: "memory")
#define PG8_WAIT_L(n) asm volatile("s_waitcnt lgkmcnt(" #n ")" ::: "memory")
#define PG8_BAR __builtin_amdgcn_s_barrier()
#define PG8_SCHED __builtin_amdgcn_sched_barrier(0)
    Unit cur, nxt; int ui = 0;
    if (!S.next(0, cur)) return;
    f32x4 acc[2][2][4][2];
#pragma unroll
    for (int a = 0; a < 2; ++a)
#pragma unroll
        for (int b = 0; b < 2; ++b)
#pragma unroll
            for (int m = 0; m < 4; ++m)
#pragma unroll
                for (int n = 0; n < 2; ++n) acc[a][b][m][n] = (f32x4){0.f, 0.f, 0.f, 0.f};
    bf16x8 At[4][2], B0[2][2], B1[2][2];
    const char* cA = (const char*)g.A + (size_t)cur.pm * tstep; const char* cB = (const char*)g.Bt + (size_t)cur.pn * tstep;
    S.a_ready(cur);
    if constexpr (SP2) {
        PG8_STAGE(PG8_SB(0, 0), cB, voffB); PG8_STAGE(PG8_SB(0, 1), cB + hstep, voffB); PG8_STAGE(PG8_SA(0, 0), cA, voffA); PG8_STAGE(PG8_SA(0, 1), cA + hstep, voffA);
        if (wr == 1) PG8_BAR;
        PG8_WAIT_V(2); PG8_BAR;
        PG8_STAGE(PG8_SB(1, 0), cB + kstep, voffB); PG8_STAGE(PG8_SA(1, 0), cA + kstep, voffA); PG8_STAGE(PG8_SB(1, 1), cB + hstep + kstep, voffB);
        PG8_WAIT_V(6); PG8_BAR;
    } else {
        PG8_STAGE(PG8_SB(0, 0), cB, voffB); PG8_STAGE(PG8_SA(0, 0), cA, voffA); PG8_STAGE(PG8_SB(0, 1), cB + hstep, voffB); PG8_STAGE(PG8_SA(0, 1), cA + hstep, voffA);
        if (wr == 1) PG8_BAR;
        PG8_WAIT_V(4); PG8_BAR;
        PG8_STAGE(PG8_SB(1, 0), cB + kstep, voffB); PG8_STAGE(PG8_SA(1, 0), cA + kstep, voffA); PG8_STAGE(PG8_SB(1, 1), cB + hstep + kstep, voffB);
        PG8_WAIT_V(6); PG8_BAR;
    }
    for (;;) {
        const bool has_next = S.next(ui + 1, nxt);
        const char* nA = has_next ? (const char*)g.A + (size_t)nxt.pm * tstep : cA; const char* nB = has_next ? (const char*)g.Bt + (size_t)nxt.pn * tstep : cB;
        for (int t = 0; t < nt; t += 2) {
            const bool last = (t == nt - 2);
            const char* a1 = cA + (size_t)(t + 1) * kstep;
            const char* a2 = last ? nA : cA + (size_t)(t + 2) * kstep; const char* b2 = last ? nB : cB + (size_t)(t + 2) * kstep;
            const char* a3 = a2 + kstep; const char* b3 = b2 + kstep;
            if (last && has_next) S.a_ready(nxt);
            if constexpr (SP2) {
            PG8_LDB(B0, 0, 0); PG8_LDB(B1, 0, 1); PG8_SCHED; PG8_LDA(At, 0, 0); PG8_STAGE(PG8_SA(1, 1), a1 + hstep, voffA);
            PG8_WAIT_V(8); PG8_WAIT_L(0); PG8_BAR; PG8_MMA(0, 0, At, B0); PG8_MMA(0, 1, At, B1); PG8_BAR; PG8_SCHED;
            PG8_LDA(At, 0, 1); PG8_STAGE(PG8_SB(0, 0), b2, voffB); PG8_STAGE(PG8_SB(0, 1), b2 + hstep, voffB); PG8_STAGE(PG8_SA(0, 0), a2, voffA);
            PG8_WAIT_V(8); PG8_WAIT_L(0); PG8_BAR; PG8_MMA(1, 0, At, B0); PG8_MMA(1, 1, At, B1); PG8_BAR; PG8_SCHED;
            PG8_LDB(B0, 1, 0); PG8_LDB(B1, 1, 1); PG8_SCHED; PG8_LDA(At, 1, 0); PG8_STAGE(PG8_SA(0, 1), a2 + hstep, voffA);
            PG8_WAIT_V(8); PG8_WAIT_L(0); PG8_BAR; PG8_MMA(0, 0, At, B0); PG8_MMA(0, 1, At, B1); PG8_BAR; PG8_SCHED;
            PG8_LDA(At, 1, 1); PG8_STAGE(PG8_SB(1, 0), b3, voffB); PG8_STAGE(PG8_SB(1, 1), b3 + hstep, voffB); PG8_STAGE(PG8_SA(1, 0), a3, voffA);
            PG8_WAIT_V(8); PG8_WAIT_L(0); PG8_BAR; PG8_MMA(1, 0, At, B0); PG8_MMA(1, 1, At, B1); PG8_BAR; PG8_SCHED;
            } else {
            PG8_LDB(B0, 0, 0); PG8_SCHED; PG8_LDA(At, 0, 0); PG8_STAGE(PG8_SA(1, 1), a1 + hstep, voffA);
            PG8_WAIT_L(8); PG8_BAR; PG8_WAIT_L(0); PG8_MMA(0, 0, At, B0); PG8_BAR; PG8_SCHED;
            PG8_LDB(B1, 0, 1); PG8_STAGE(PG8_SB(0, 0), b2, voffB);
            PG8_BAR; PG8_WAIT_L(0); PG8_MMA(0, 1, At, B1); PG8_BAR;
            PG8_LDA(At, 0, 1); PG8_STAGE(PG8_SA(0, 0), a2, voffA);
            PG8_BAR; PG8_WAIT_L(0); PG8_MMA(1, 0, At, B0); PG8_BAR; PG8_SCHED;
            PG8_STAGE(PG8_SB(0, 1), b2 + hstep, voffB);
            PG8_WAIT_V(6); PG8_BAR; PG8_MMA(1, 1, At, B1); PG8_BAR;
            PG8_LDB(B0, 1, 0); PG8_SCHED; PG8_LDA(At, 1, 0); PG8_STAGE(PG8_SA(0, 1), a2 + hstep, voffA);
            PG8_WAIT_L(8); PG8_BAR; PG8_WAIT_L(0); PG8_MMA(0, 0, At, B0); PG8_BAR; PG8_SCHED;
            PG8_LDB(B1, 1, 1); PG8_STAGE(PG8_SB(1, 0), b3, voffB);
            PG8_BAR; PG8_WAIT_L(0); PG8_MMA(0, 1, At, B1); PG8_BAR;
            PG8_LDA(At, 1, 1); PG8_STAGE(PG8_SA(1, 0), a3, voffA);
            PG8_BAR; PG8_WAIT_L(0); PG8_MMA(1, 0, At, B0); PG8_BAR; PG8_SCHED;
            PG8_STAGE(PG8_SB(1, 1), b3 + hstep, voffB);
            PG8_WAIT_V(6); PG8_BAR; PG8_MMA(1, 1, At, B1); PG8_BAR;
            }
        }
        if constexpr (ALIGN_EPI) { if (wr == 0) PG8_BAR; }
        if constexpr (!Epi::AFTER_DRAIN) { E(acc, cur, wr, wc, fr, fq); S.done(cur); }
        if (!has_next) break;
#pragma unroll
        for (int a = 0; a < 2; ++a)
#pragma unroll
            for (int b = 0; b < 2; ++b)
#pragma unroll
                for (int m = 0; m < 4; ++m)
#pragma unroll
                    for (int n = 0; n < 2; ++n) acc[a][b][m][n] = (f32x4){0.f, 0.f, 0.f, 0.f};
        cur = nxt; cA = nA; cB = nB; ++ui;
        if constexpr (ALIGN_EPI) { if (wr == 1) PG8_BAR; }
    }
    PG8_WAIT_V(0);
    if constexpr (!ALIGN_EPI) { if (wr == 0) PG8_BAR; }
    PG8_BAR;
    if constexpr (Epi::AFTER_DRAIN) { E.fused(acc, cur, wr, wc, fr, fq, lds, wid, lane); S.done(cur); }
#undef PG8_SA
#undef PG8_SB
#undef PG8_STAGE
#undef PG8_LDA
#undef PG8_LDB
#undef PG8_MMA
#undef PG8_WAIT_V
#undef PG8_WAIT_L
#undef PG8_BAR
#undef PG8_SCHED
}
}
#include <hip/hip_bf16.h>
#include <cmath>
namespace attn_body {
using bf16=__hip_bfloat16;
using bf16x8=__attribute__((ext_vector_type(8)))short;
using s16x4=__attribute__((ext_vector_type(4)))short;
using f32x16=__attribute__((ext_vector_type(16)))float;
using u32x4=__attribute__((ext_vector_type(4)))unsigned;
constexpr int SEQ=4096,D=64,PQ=512,PO=1024;
constexpr int NW=8,QBLK=32,QB=QBLK*NW,KVBLK=64,NQB=SEQ/QB;

__device__ __forceinline__ int crow(int r,int hi){return (r&3)+8*(r>>2)+4*hi;}
#define SBAR() __builtin_amdgcn_sched_barrier(0)
__device__ __forceinline__ void cmask(f32x16&p0,f32x16&p1,int jb,int qrel,int hi){
  const float NEG=-INFINITY; int kb=64*jb+4*hi;
  #pragma unroll
  for(int r=0;r<16;++r){int kv=kb+(r&3)+8*(r>>2); if(kv>qrel)p0[r]=NEG; if(kv+32>qrel)p1[r]=NEG;}
}

constexpr int NSLOT=3, SLOTB=8192;
constexpr int LDS_K=0, LDS_V=NSLOT*SLOTB, LDS_WS=2*NSLOT*SLOTB, LDS_OST=LDS_WS+NW*64*4, LDS_BYTES=LDS_OST+NW*4096;
constexpr float C2=0.125f*1.4426950408889634f;
__device__ __forceinline__ void glds16(const void*gsrc,unsigned lds_dst){unsigned keep;
  asm volatile("s_mov_b32 %0, m0\n\ts_mov_b32 m0, %2\n\ts_nop 0\n\tglobal_load_lds_dwordx4 %1, off\n\ts_mov_b32 m0, %0":"=&s"(keep):"v"(gsrc),"s"(lds_dst):"memory");}
__device__ __forceinline__ float max3f(float a,float b,float c){float r;asm("v_max3_f32 %0, %1, %2, %3":"=v"(r):"v"(a),"v"(b),"v"(c));return r;}
__device__ __forceinline__ float max2f(float a,float b){float r;asm("v_max_f32_e32 %0, %1, %2":"=v"(r):"v"(a),"v"(b));return r;}
__device__ __forceinline__ float fadd_s(float a,float b){float r;asm("v_add_f32_e32 %0, %1, %2":"=v"(r):"v"(a),"v"(b));return r;}
__device__ __forceinline__ float fsub_s(float a,float b){float r;asm("v_sub_f32_e32 %0, %1, %2":"=v"(r):"v"(a),"v"(b));return r;}
typedef float f32x2_t __attribute__((ext_vector_type(2))); typedef __bf16 bf16x2_t __attribute__((ext_vector_type(2)));
__device__ __forceinline__ unsigned cvtpk_s(float lo,float hi){f32x2_t v={lo,hi};bf16x2_t b=__builtin_convertvector(v,bf16x2_t);return __builtin_bit_cast(unsigned,b);}
#define WAIT_BAR(N) asm volatile("s_waitcnt vmcnt(" #N ") lgkmcnt(0)\n\ts_barrier":::"memory")

__device__ __forceinline__ void qkt(f32x16&p0,f32x16&p1,const char*Kslot,const bf16x8*qr,const f32x16&negm,int r32,int hi){
  const char*kb=Kslot+hi*1024+r32*16;
  #pragma unroll
  for(int d0=0;d0<4;++d0){
    const bf16x8 b0=*reinterpret_cast<const bf16x8*>(kb+d0*2048);
    const bf16x8 b1=*reinterpret_cast<const bf16x8*>(kb+d0*2048+512);
    if(d0==0){p0=__builtin_amdgcn_mfma_f32_32x32x16_bf16(b0,qr[0],negm,0,0,0);p1=__builtin_amdgcn_mfma_f32_32x32x16_bf16(b1,qr[0],negm,0,0,0);}
    else{p0=__builtin_amdgcn_mfma_f32_32x32x16_bf16(b0,qr[d0],p0,0,0,0);p1=__builtin_amdgcn_mfma_f32_32x32x16_bf16(b1,qr[d0],p1,0,0,0);}}
}
typedef __attribute__((address_space(3))) const char* lds_cptr;
typedef short v4i16_t __attribute__((ext_vector_type(4)));
__device__ __forceinline__ void kload8(bf16x8*kf,lds_cptr kp){
  kf[0]=*(const __attribute__((address_space(3))) bf16x8*)(kp);      kf[1]=*(const __attribute__((address_space(3))) bf16x8*)(kp+512);
  kf[2]=*(const __attribute__((address_space(3))) bf16x8*)(kp+2048); kf[3]=*(const __attribute__((address_space(3))) bf16x8*)(kp+2560);
  kf[4]=*(const __attribute__((address_space(3))) bf16x8*)(kp+4096); kf[5]=*(const __attribute__((address_space(3))) bf16x8*)(kp+4608);
  kf[6]=*(const __attribute__((address_space(3))) bf16x8*)(kp+6144); kf[7]=*(const __attribute__((address_space(3))) bf16x8*)(kp+6656);
}
__device__ __forceinline__ void kload2(bf16x8*kf,lds_cptr kp,int j){ kf[2*j]=*(const __attribute__((address_space(3))) bf16x8*)(kp+j*2048); kf[2*j+1]=*(const __attribute__((address_space(3))) bf16x8*)(kp+j*2048+512); }
__device__ __forceinline__ s16x4 vtr(lds_cptr p){ return __builtin_bit_cast(s16x4,__builtin_amdgcn_ds_read_tr16_b64_v4i16((__attribute__((address_space(3))) v4i16_t*)p)); }
__device__ __forceinline__ float rowmax(const f32x16&p0,const f32x16&p1){
  float a=max3f(p0[0],p0[1],p1[0]),b=max3f(p0[2],p0[3],p1[1]);a=max3f(a,p1[2],p1[3]);
  #pragma unroll
  for(int r=4;r<16;r+=4){a=max3f(a,p0[r],p0[r+1]);b=max3f(b,p0[r+2],p0[r+3]);a=max3f(a,p1[r],p1[r+1]);b=max3f(b,p1[r+2],p1[r+3]);}
  const float m=max2f(a,b);
  auto rr=__builtin_amdgcn_permlane32_swap(__float_as_uint(m),__float_as_uint(m),false,false);
  return max2f(__uint_as_float(rr[0]),__uint_as_float(rr[1]));
}
__device__ __forceinline__ void pv(f32x16*o,int vb,bf16x8 pa0,bf16x8 pa1,bf16x8 pa2,bf16x8 pa3){
  #pragma unroll
  for(int d0=0;d0<2;++d0){s16x4 lo[4],hi[4];
    #pragma unroll
    for(int ks=0;ks<4;++ks){
      asm volatile("ds_read_b64_tr_b16 %0,%1 offset:%c2":"=&v"(lo[ks]):"v"(vb),"i"(d0*4096+ks*1024):"memory");
      asm volatile("ds_read_b64_tr_b16 %0,%1 offset:%c2":"=&v"(hi[ks]):"v"(vb),"i"(d0*4096+ks*1024+512):"memory");}
    asm volatile("s_waitcnt lgkmcnt(0)":::"memory");SBAR();
    #define PK(k) (bf16x8){lo[k][0],lo[k][1],lo[k][2],lo[k][3],hi[k][0],hi[k][1],hi[k][2],hi[k][3]}
    o[d0]=__builtin_amdgcn_mfma_f32_32x32x16_bf16(pa0,PK(0),o[d0],0,0,0);
    o[d0]=__builtin_amdgcn_mfma_f32_32x32x16_bf16(pa1,PK(1),o[d0],0,0,0);
    o[d0]=__builtin_amdgcn_mfma_f32_32x32x16_bf16(pa2,PK(2),o[d0],0,0,0);
    o[d0]=__builtin_amdgcn_mfma_f32_32x32x16_bf16(pa3,PK(3),o[d0],0,0,0);
    #undef PK
  }
}

#ifndef ATTN_STORE16
#define ATTN_STORE16(p,v) (*(u32x4*)(p)=(v))
#endif
template<int THRL> __device__ __forceinline__ void attn_unit(int b,int h,int qb,const bf16*Q,const bf16*__restrict__ K,const bf16*__restrict__ V,bf16*O,char*shm){
  int tid=threadIdx.x; asm volatile("":"+v"(tid)); const int lane=tid&63,r32=lane&31,hi=lane>>5; const int wid=__builtin_amdgcn_readfirstlane(tid>>6);
  const long rowbase=(long)b*SEQ; const int q0=qb*QB;
  const bf16*Qw=Q+(rowbase+q0+wid*QBLK)*PQ;
  const bf16*Kh=K+rowbase*PQ,*Vh=V+rowbase*PQ;
  const unsigned lds0=(unsigned)(uintptr_t)shm;
  float*wsf=(float*)(shm+LDS_WS)+wid*64;
  const bf16*ksrc=Kh+(long)lane*PQ+wid*8;
  const bf16*vsrc=Vh+(long)(16*(wid&3)+(lane>>2))*PQ+(wid>>2)*32+(lane&3)*8;
  const unsigned kdst=lds0+LDS_K+wid*1024, vdst=lds0+LDS_V+wid*1024;
  #define DMA_K(t,slot) glds16(ksrc+(long)(t)*KVBLK*PQ,(unsigned)__builtin_amdgcn_readfirstlane(kdst+(slot)))
  #define DMA_V(t,slot) glds16(vsrc+(long)(t)*KVBLK*PQ,(unsigned)__builtin_amdgcn_readfirstlane(vdst+(slot)))
  const int vb0=(int)(lds0+LDS_V)+((lane>>4)&1)*32+(lane&3)*8+(4*hi+((lane&15)>>2))*64;
  const char*Kbase=shm+LDS_K; bf16x8 kf[8];
  const lds_cptr shm3=(lds_cptr)shm; const lds_cptr kp0=shm3+LDS_K+hi*1024+r32*16; const lds_cptr vp0=shm3+LDS_V+((lane>>4)&1)*32+(lane&3)*8+(4*hi+((lane&15)>>2))*64;
  const int NT=(q0+QB)/KVBLK;
  DMA_K(0,0);DMA_V(0,0);DMA_K(1,SLOTB);
  bf16x8 qr[4];
  #pragma unroll
  for(int d0=0;d0<4;++d0)qr[d0]=*reinterpret_cast<const bf16x8*>(&Qw[(long)r32*PQ+d0*16+hi*8]);
  float mhat=0.f,l_reg=0.f;f32x16 o[2];o[0]=f32x16{};o[1]=f32x16{};float zz_=0.f;asm volatile("":"+v"(zz_));f32x16 negm;
  _Pragma("unroll") for(int r=0;r<16;++r)negm[r]=zz_;
  const int qrel=wid*QBLK+r32;
  #define CMASK(P0,P1,t) do{int jb_=(t)-(NT-4); if(jb_>=0)cmask(P0,P1,jb_,qrel,hi);}while(0)
  bool resc=false;
  #define START(P0,P1) do{ const float rm=rowmax(P0,P1); resc=false; \
    { const float dl=rm; mhat=fadd_s(mhat,dl); \
      _Pragma("unroll") for(int r=0;r<16;++r){P0[r]=fsub_s(P0[r],dl);P1[r]=fsub_s(P1[r],dl);} \
      _Pragma("unroll") for(int r=0;r<16;++r)negm[r]=-mhat; asm volatile("":"+v"(negm)); } \
    _Pragma("unroll") for(int r=0;r<16;++r)P0[r]=__builtin_amdgcn_exp2f(P0[r]); }while(0)
  #define RESC() do{ if(resc){ asm volatile("s_waitcnt lgkmcnt(0)":::"memory"); \
      _Pragma("unroll") for(int d_=0;d_<2;++d_) _Pragma("unroll") for(int r=0;r<16;++r)o[d_][r]*=wsf[crow(r,hi)]; } }while(0)
  f32x16 pA0,pA1,pB0,pB1;
  int sl_prev=0,sl_cur=0,sl_next=SLOTB;
  #define ROT() do{sl_prev=sl_cur;sl_cur=sl_next;sl_next=(sl_next==(NSLOT-1)*SLOTB)?0:sl_next+SLOTB;}while(0)
  DMA_K(2,2*SLOTB);
  WAIT_BAR(3);
  qkt(pA0,pA1,Kbase,qr,negm,r32,hi);asm volatile("s_nop 15\n\ts_nop 7":"+v"(pA0),"+v"(pA1));CMASK(pA0,pA1,0);
  START(pA0,pA1);
  _Pragma("unroll") for(int r=0;r<16;++r)pA1[r]=__builtin_amdgcn_exp2f(pA1[r]);
  WAIT_BAR(0);
  DMA_K(3,0);DMA_V(1,SLOTB);
  ROT();
  kload8(kf,kp0+sl_cur);
  WAIT_BAR(2);
  s16x4 vlo[8],vhi[8]; u32x4 pw0,pw1,pw2,pw3;
  #define PKW(P,B) cvtpk_s(P[B],P[B+1])
  #define PAF(k) __builtin_bit_cast(bf16x8,pw##k)
  #define VFR(i) (bf16x8){vlo[i][0],vlo[i][1],vlo[i][2],vlo[i][3],vhi[i][0],vhi[i][1],vhi[i][2],vhi[i][3]}
  #define PIN(x) asm volatile("":"+v"(x))
  #define MX3(a,b,c) __builtin_fmaxf(__builtin_fmaxf((a),(b)),(c))
  #define GAPA(MF,A0,A1,A2,A3,W0,W1,PW) do{ MF; sacc+=A0; sacc+=A1; sacc+=A2; sacc+=A3; PIN(sacc); W0; W1; PIN(PW); SBAR(); }while(0)
  #define EX(v) __builtin_amdgcn_exp2f(v)
  #define GAPB(MF,X,B) do{ MF; X[B]=EX(X[B]); X[B+1]=EX(X[B+1]); X[B+2]=EX(X[B+2]); X[B+3]=EX(X[B+3]); PIN(X); SBAR(); }while(0)
  #define VRD(i) do{ vlo[i]=vtr(vp_+(((i)>>2)*4096+((i)&3)*1024)); vhi[i]=vtr(vp_+(((i)>>2)*4096+((i)&3)*1024+512)); }while(0)
  #define KRD(G,j) do{ if(G){ kload2(kf,kp0+sl_next,j); SBAR(); } }while(0)
  #define STEP(C0,C1,P0,P1,t,GK,GV,GL) do{ SBAR(); \
    const lds_cptr vp_=vp0+sl_prev; \
    VRD(0); SBAR(); float sacc=(P0[0]+P0[1]); \
    GAPA(C0=__builtin_amdgcn_mfma_f32_32x32x16_bf16(kf[0],qr[0],negm,0,0,0), P0[2],P0[3],P0[4],P0[5],     pw0[0]=PKW(P0,0), pw0[1]=PKW(P0,2), pw0); \
    VRD(4); SBAR(); GAPA(C1=__builtin_amdgcn_mfma_f32_32x32x16_bf16(kf[1],qr[0],negm,0,0,0), P0[6],P0[7],P0[8],P0[9],     pw0[2]=PKW(P0,4), pw0[3]=PKW(P0,6), pw0); \
    VRD(1); SBAR(); GAPA(C0=__builtin_amdgcn_mfma_f32_32x32x16_bf16(kf[2],qr[1],C0,0,0,0),   P0[10],P0[11],P0[12],P0[13], pw1[0]=PKW(P0,8), pw1[1]=PKW(P0,10), pw1); \
    VRD(5); SBAR(); GAPA(C1=__builtin_amdgcn_mfma_f32_32x32x16_bf16(kf[3],qr[1],C1,0,0,0),   P0[14],P0[15],P1[0],P1[1],   pw1[2]=PKW(P0,12),pw1[3]=PKW(P0,14), pw1); \
    VRD(2); SBAR(); GAPA(C0=__builtin_amdgcn_mfma_f32_32x32x16_bf16(kf[4],qr[2],C0,0,0,0),   P1[2],P1[3],P1[4],P1[5],     pw2[0]=PKW(P1,0), pw2[1]=PKW(P1,2), pw2); \
    VRD(6); SBAR(); GAPA(C1=__builtin_amdgcn_mfma_f32_32x32x16_bf16(kf[5],qr[2],C1,0,0,0),   P1[6],P1[7],P1[8],P1[9],     pw2[2]=PKW(P1,4), pw2[3]=PKW(P1,6), pw2); \
    VRD(3); SBAR(); GAPA(C0=__builtin_amdgcn_mfma_f32_32x32x16_bf16(kf[6],qr[3],C0,0,0,0),   P1[10],P1[11],P1[12],P1[13], pw3[0]=PKW(P1,8), pw3[1]=PKW(P1,10), pw3); \
    VRD(7); SBAR(); GAPA(C1=__builtin_amdgcn_mfma_f32_32x32x16_bf16(kf[7],qr[3],C1,0,0,0),   P1[14],P1[15],0.f,0.f,       pw3[2]=PKW(P1,12),pw3[3]=PKW(P1,14), pw3); \
    l_reg+=sacc; \
    if(GK){DMA_K((t)+3,sl_cur);} if(GV){DMA_V((t)+1,sl_next);} \
    CMASK(C0,C1,t); \
    { float a=MX3(C0[0],C0[1],C1[0]),b=MX3(C0[2],C0[3],C1[1]); a=MX3(a,C1[2],C1[3]); \
      _Pragma("unroll") for(int r=4;r<16;r+=4){a=MX3(a,C0[r],C0[r+1]);b=MX3(b,C0[r+2],C0[r+3]);a=MX3(a,C1[r],C1[r+1]);b=MX3(b,C1[r+2],C1[r+3]);} \
      float rm=__builtin_fmaxf(a,b); { auto rr=__builtin_amdgcn_permlane32_swap(__float_as_uint(rm),__float_as_uint(rm),false,false); rm=__builtin_fmaxf(__uint_as_float(rr[0]),__uint_as_float(rr[1])); } \
      resc=false; \
      if(__builtin_expect(__any(rm>(float)THRL),0)){ const float dl=__builtin_fmaxf(rm,0.f); mhat+=dl; \
        _Pragma("unroll") for(int r=0;r<16;++r){C0[r]-=dl;C1[r]-=dl;} \
        _Pragma("unroll") for(int r=0;r<16;++r)negm[r]=-mhat; asm volatile("":"+v"(negm)); \
        const float f=__builtin_amdgcn_exp2f(-dl); l_reg*=f; if(hi==0)wsf[r32]=f; resc=true; } } \
    SBAR(); \
    GAPB(o[0]=__builtin_amdgcn_mfma_f32_32x32x16_bf16(PAF(0),VFR(0),o[0],0,0,0), C0,0); \
    GAPB(o[1]=__builtin_amdgcn_mfma_f32_32x32x16_bf16(PAF(0),VFR(4),o[1],0,0,0), C0,4); \
    KRD(GL,0); GAPB(o[0]=__builtin_amdgcn_mfma_f32_32x32x16_bf16(PAF(1),VFR(1),o[0],0,0,0), C0,8); \
    KRD(GL,1); GAPB(o[1]=__builtin_amdgcn_mfma_f32_32x32x16_bf16(PAF(1),VFR(5),o[1],0,0,0), C0,12); \
    KRD(GL,2); GAPB(o[0]=__builtin_amdgcn_mfma_f32_32x32x16_bf16(PAF(2),VFR(2),o[0],0,0,0), C1,0); \
    KRD(GL,3); GAPB(o[1]=__builtin_amdgcn_mfma_f32_32x32x16_bf16(PAF(2),VFR(6),o[1],0,0,0), C1,4); \
    GAPB(o[0]=__builtin_amdgcn_mfma_f32_32x32x16_bf16(PAF(3),VFR(3),o[0],0,0,0), C1,8); \
    GAPB(o[1]=__builtin_amdgcn_mfma_f32_32x32x16_bf16(PAF(3),VFR(7),o[1],0,0,0), C1,12); \
    }while(0)
  int t=1;
  #undef CMASK
  #define CMASK(P0,P1,t) do{}while(0)
  for(;t+5<NT;t+=2){
    STEP(pB0,pB1,pA0,pA1,t,true,true,true);     WAIT_BAR(2); RESC(); ROT();
    STEP(pA0,pA1,pB0,pB1,t+1,true,true,true);   WAIT_BAR(2); RESC(); ROT();
  }
  #undef CMASK
  #define CMASK(P0,P1,t) do{int jb_=(t)-(NT-4); if(jb_>=0)cmask(P0,P1,jb_,qrel,hi);}while(0)
  #define ENDW(tt) do{ if((tt)+3<NT){WAIT_BAR(2);} else if((tt)+2<NT){WAIT_BAR(1);} else {WAIT_BAR(0);} }while(0)
  for(;t+1<NT;t+=2){
    STEP(pB0,pB1,pA0,pA1,t,(t+3<NT),(t+1<NT),(t+1<NT));       ENDW(t);   RESC(); ROT();
    STEP(pA0,pA1,pB0,pB1,t+1,(t+4<NT),(t+2<NT),(t+2<NT));     ENDW(t+1); RESC(); ROT();
  }
  STEP(pB0,pB1,pA0,pA1,NT-1,false,false,false); RESC();
  { float sacc=pB0[0]+pB0[1]; _Pragma("unroll") for(int r=2;r<16;++r)sacc+=pB0[r]; _Pragma("unroll") for(int r=0;r<16;++r)sacc+=pB1[r]; l_reg+=sacc;
    pw0=(u32x4){PKW(pB0,0),PKW(pB0,2),PKW(pB0,4),PKW(pB0,6)};pw1=(u32x4){PKW(pB0,8),PKW(pB0,10),PKW(pB0,12),PKW(pB0,14)};pw2=(u32x4){PKW(pB1,0),PKW(pB1,2),PKW(pB1,4),PKW(pB1,6)};pw3=(u32x4){PKW(pB1,8),PKW(pB1,10),PKW(pB1,12),PKW(pB1,14)};
    SBAR(); pv(o,vb0+sl_cur,PAF(0),PAF(1),PAF(2),PAF(3)); }
  #undef PKW
  #undef PAF
  #undef VFR
  #undef PIN
  #undef MX3
  #undef GAPA
  #undef GAPB
  #undef EX
  #undef VRD
  #undef KRD
  #undef STEP
  #undef ENDW
  {auto rr=__builtin_amdgcn_permlane32_swap(__float_as_uint(l_reg),__float_as_uint(l_reg),false,false);l_reg=__uint_as_float(rr[0])+__uint_as_float(rr[1]);}
  if(hi==0)wsf[32+r32]=l_reg;asm volatile("s_waitcnt lgkmcnt(0)":::"memory");
  float rli[16];
  #pragma unroll
  for(int r=0;r<16;++r)rli[r]=__builtin_amdgcn_rcpf(wsf[32+crow(r,hi)]);
  bf16*Ow=O+(rowbase+q0+wid*QBLK)*PO;
  { bf16*stg=(bf16*)(shm+LDS_OST)+wid*2048;
    #pragma unroll
    for(int r=0;r<16;++r){const int orow=crow(r,hi);
      #pragma unroll
      for(int d0=0;d0<2;++d0)stg[orow*64+d0*32+r32]=__float2bfloat16(o[d0][r]*rli[r]);}
    asm volatile("s_waitcnt lgkmcnt(0)":::"memory");
    #pragma unroll
    for(int i=0;i<4;++i){const int row=i*8+(lane>>3),ch=lane&7; const u32x4 v=*(const u32x4*)(stg+row*64+ch*8); ATTN_STORE16(Ow+(long)row*PO+ch*8,v);} }
  asm volatile("s_waitcnt lgkmcnt(0)\n\ts_barrier":::"memory");
  #undef DMA_K
  #undef DMA_V
  #undef CMASK
  #undef START
  #undef RESC
  #undef ROT
}
constexpr int ATTN_LDS_BYTES=LDS_BYTES;
#undef SBAR
#undef WAIT_BAR
}
#include <hip/hip_cooperative_groups.h>
namespace cg = cooperative_groups;
namespace mk {
typedef unsigned short bf16_t;
typedef short bf16x8 __attribute__((ext_vector_type(8)));
typedef short s16x4 __attribute__((ext_vector_type(4)));
typedef float f32x4 __attribute__((ext_vector_type(4)));
typedef float f32x16 __attribute__((ext_vector_type(16)));
typedef unsigned u32x4 __attribute__((ext_vector_type(4)));
typedef unsigned u32x2 __attribute__((ext_vector_type(2)));
typedef float f32x2_t __attribute__((ext_vector_type(2))); typedef __bf16 bf16x2_t __attribute__((ext_vector_type(2)));
constexpr int T = 32768, S = 4096;
constexpr size_t TSQ = (size_t)T * 512;
constexpr size_t MiB = 1u << 20;
constexpr size_t WS_SSQ = 0, WS_DML = 4 * MiB, WS_W = 6 * MiB, WS_WL = 18 * MiB + MiB / 2, WS_WM = WS_W + 74 * MiB, WS_PB = 112 * MiB, WS_HB = 128 * MiB, WS_YMIX = 192 * MiB, WS_BIG = 256 * MiB, WS_O16 = WS_BIG + 192 * MiB, WS_END = 512 * MiB;
constexpr int LDS_BYTES = 147456;
constexpr float C2 = 0.125f * 1.4426950408889634f;
struct Params { const float* in[29]; float* out; unsigned char* ws; };

__device__ __forceinline__ unsigned pk2(float lo, float hi) { f32x2_t v = {lo, hi}; bf16x2_t b = __builtin_convertvector(v, bf16x2_t); return __builtin_bit_cast(unsigned, b); }
__device__ __forceinline__ float bflo(unsigned w) { return __uint_as_float(w << 16); }
__device__ __forceinline__ float bfhi(unsigned w) { return __uint_as_float(w & 0xffff0000u); }
__device__ __forceinline__ float bf1(bf16_t h) { return __uint_as_float((unsigned)h << 16); }
__device__ __forceinline__ float wave_sum(float v) {
v = xor_add<1>(v); v = xor_add<2>(v); v = xor_add<4>(v); v = xor_add<8>(v); v = xor_add<16>(v); v = xor_add<32>(v);
    return v;
}
#define WAVE_LDS_SYNC() asm volatile("s_waitcnt lgkmcnt(0)" ::: "memory")
__device__ __forceinline__ int crow(int r, int hi) { return (r & 3) + 8 * (r >> 2) + 4 * hi; }

__device__ __forceinline__ void transpose_items(const float* W, int K, int N, const float* gain, bf16_t* WT, float* scr, int gw, int ngw, int lane) {
    const int nblk = N / 32, nitems = (K / 64) * nblk;
    const int lr = lane >> 3, lc = (lane & 7) * 4;
    f32x4 r[8];
    int it = gw;
    if (it < nitems) { const int k0 = 64 * (it / nblk), n0 = 32 * (it % nblk);
#pragma unroll
        for (int i = 0; i < 8; ++i) r[i] = __builtin_nontemporal_load((const f32x4*)(W + (size_t)(k0 + lr + 8 * i) * N + n0 + lc)); }
    for (; it < nitems; it += ngw) {
        const int kb = it / nblk, nb = it % nblk, k0 = 64 * kb, n0 = 32 * nb;
#pragma unroll
        for (int i = 0; i < 8; ++i) { const int kk = lr + 8 * i; const float g = gain ? gain[k0 + kk] : 1.0f; float* d = scr + kk * 33 + lc;
            d[0] = r[i][0] * g; d[1] = r[i][1] * g; d[2] = r[i][2] * g; d[3] = r[i][3] * g; }
        WAVE_LDS_SYNC();
        const int itn = it + ngw;
        if (itn < nitems) { const int k1 = 64 * (itn / nblk), n1 = 32 * (itn % nblk);
#pragma unroll
            for (int i = 0; i < 8; ++i) r[i] = __builtin_nontemporal_load((const f32x4*)(W + (size_t)(k1 + lr + 8 * i) * N + n1 + lc)); }
        const int c = lane & 7;
#pragma unroll
        for (int j = 0; j < 4; ++j) { const int n = (lane >> 3) + 8 * j; const float* s = scr + (8 * c) * 33 + n;
            u32x4 o; o.x = pk2(s[0 * 33], s[1 * 33]); o.y = pk2(s[2 * 33], s[3 * 33]); o.z = pk2(s[4 * 33], s[5 * 33]); o.w = pk2(s[6 * 33], s[7 * 33]);
            *(u32x4*)(WT + (size_t)(n0 + n) * K + k0 + 8 * c) = o; }
        WAVE_LDS_SYNC();
    }
}
__device__ __forceinline__ void convert_p(const float* psrc, bf16_t* pb, int gtid, int nthr) {
    int i = gtid; f32x4 a = (f32x4){0.f, 0.f, 0.f, 0.f}, b = a;
    if (i < T * 256 / 8) { a = __builtin_nontemporal_load((const f32x4*)psrc + 2 * i); b = __builtin_nontemporal_load((const f32x4*)psrc + 2 * i + 1); }
    for (; i < T * 256 / 8; i += nthr) { const f32x4 ca = a, cb = b; const int in = i + nthr;
        if (in < T * 256 / 8) { a = __builtin_nontemporal_load((const f32x4*)psrc + 2 * in); b = __builtin_nontemporal_load((const f32x4*)psrc + 2 * in + 1); }
        u32x4 o; o.x = pk2(ca[0], ca[1]); o.y = pk2(ca[2], ca[3]); o.z = pk2(cb[0], cb[1]); o.w = pk2(cb[2], cb[3]); ((u32x4*)pb)[i] = o; }
}

template <int PASS> __device__ __forceinline__ void dil_unit(int u, int dilv, const bf16_t* proj, float* accst, float* mst, float* lst, bf16_t* ymix, short* vts, int lane) {
    const int r32 = lane & 31, hi = lane >> 5;
    const int LB = 128 / dilv, ql = u & 127, head = (u >> 7) & 7, b = u >> 10, r = ql / LB, qblk = ql % LB;
    const long rowq = (long)b * S + (long)(32 * qblk + r32) * dilv + r;
    const bf16_t* qp = proj + 3 * TSQ + rowq * 512 + head * 64 + 8 * hi;
    const int j0 = qblk < 4 ? 4 - qblk : 0;
    const float NEG = -1e30f;
#define DIL_ROW(j) ((long)b * S + (long)(32 * qblk - 128 + 32 * ((j) >= j0 ? (j) : j0) + r32) * dilv + r)
    bf16x8 qf[4], kn[4];
#pragma unroll
    for (int d0 = 0; d0 < 4; ++d0) qf[d0] = *(const bf16x8*)(qp + 16 * d0);
    { const bf16_t* kp = proj + 4 * TSQ + DIL_ROW(0) * 512 + head * 64 + 8 * hi;
#pragma unroll
        for (int d0 = 0; d0 < 4; ++d0) kn[d0] = *(const bf16x8*)(kp + 16 * d0); }
    const size_t sidx = (size_t)rowq * 8 + head;
    float m_old = NEG, l_old = 0.f;
    if (PASS > 0) { m_old = mst[sidx]; l_old = lst[sidx]; }
    f32x16 st[5]; float mt = NEG;
#pragma unroll
    for (int j = 0; j < 5; ++j) {
        bf16x8 kc[4];
#pragma unroll
        for (int d0 = 0; d0 < 4; ++d0) kc[d0] = kn[d0];
        if (j < 4) { const bf16_t* kp = proj + 4 * TSQ + DIL_ROW(j + 1) * 512 + head * 64 + 8 * hi;
#pragma unroll
            for (int d0 = 0; d0 < 4; ++d0) kn[d0] = *(const bf16x8*)(kp + 16 * d0); }
        if (j >= j0) {
            f32x16 a = f32x16{};
#pragma unroll
            for (int d0 = 0; d0 < 4; ++d0) a = __builtin_amdgcn_mfma_f32_32x32x16_bf16(kc[d0], qf[d0], a, 0, 0, 0);
            if (j == 0) {
#pragma unroll
                for (int i = 0; i < 16; ++i) if (crow(i, hi) < r32) a[i] = NEG; }
            if (j == 4) {
#pragma unroll
                for (int i = 0; i < 16; ++i) if (crow(i, hi) > r32) a[i] = NEG; }
#pragma unroll
            for (int i = 0; i < 16; ++i) mt = fmaxf(mt, a[i]);
            st[j] = a;
        } else st[j] = f32x16{};
    }
    bf16x8 vn[4];
    { const bf16_t* vp = proj + 5 * TSQ + DIL_ROW(0) * 512 + head * 64 + 8 * hi;
#pragma unroll
        for (int d0 = 0; d0 < 4; ++d0) vn[d0] = *(const bf16x8*)(vp + 16 * d0); }
    f32x16 O[2]; float* ap = accst + sidx * 64 + 4 * hi;
    if (PASS > 0) {
#pragma unroll
        for (int dt = 0; dt < 2; ++dt)
#pragma unroll
            for (int i4 = 0; i4 < 4; ++i4) { const f32x4 v = *(const f32x4*)(ap + 32 * dt + 8 * i4);
#pragma unroll
                for (int e = 0; e < 4; ++e) O[dt][4 * i4 + e] = v[e]; }
    } else { O[0] = f32x16{}; O[1] = f32x16{}; }
    mt = xor_max<32>(mt);
    const float m_new = fmaxf(m_old, mt), sc = __builtin_amdgcn_exp2f(m_old - m_new);
    float ls = 0.f;
#pragma unroll
    for (int j = 0; j < 5; ++j) if (j >= j0) {
#pragma unroll
        for (int i = 0; i < 16; ++i) { const float e = __builtin_amdgcn_exp2f(st[j][i] - m_new); st[j][i] = e; ls += e; } }
    ls = xor_add<32>(ls);
    const float l_new = l_old * sc + ls;
    if (PASS > 0) {
#pragma unroll
        for (int dt = 0; dt < 2; ++dt)
#pragma unroll
            for (int i = 0; i < 16; ++i) O[dt][i] *= sc; }
#pragma unroll
    for (int j = 0; j < 5; ++j) {
        bf16x8 vc[4];
#pragma unroll
        for (int d0 = 0; d0 < 4; ++d0) vc[d0] = vn[d0];
        if (j < 4) { const bf16_t* vp = proj + 5 * TSQ + DIL_ROW(j + 1) * 512 + head * 64 + 8 * hi;
#pragma unroll
            for (int d0 = 0; d0 < 4; ++d0) vn[d0] = *(const bf16x8*)(vp + 16 * d0); }
        if (j >= j0) {
#pragma unroll
            for (int d0 = 0; d0 < 4; ++d0) {
#pragma unroll
                for (int e = 0; e < 8; ++e) vts[(16 * d0 + 8 * hi + e) * 36 + r32] = vc[d0][e]; }
            WAVE_LDS_SYNC();
#pragma unroll
            for (int cc = 0; cc < 2; ++cc) {
                u32x4 pw; pw.x = pk2(st[j][8 * cc + 0], st[j][8 * cc + 1]); pw.y = pk2(st[j][8 * cc + 2], st[j][8 * cc + 3]); pw.z = pk2(st[j][8 * cc + 4], st[j][8 * cc + 5]); pw.w = pk2(st[j][8 * cc + 6], st[j][8 * cc + 7]);
                const bf16x8 pf = __builtin_bit_cast(bf16x8, pw);
#pragma unroll
                for (int dt = 0; dt < 2; ++dt) { const short* vr = vts + (r32 + 32 * dt) * 36 + 16 * cc + 4 * hi;
                    const s16x4 lo = *(const s16x4*)vr, h4 = *(const s16x4*)(vr + 8);
                    const bf16x8 vf = (bf16x8){lo[0], lo[1], lo[2], lo[3], h4[0], h4[1], h4[2], h4[3]};
                    O[dt] = __builtin_amdgcn_mfma_f32_32x32x16_bf16(vf, pf, O[dt], 0, 0, 0); }
            }
            WAVE_LDS_SYNC();
        }
    }
#undef DIL_ROW
    if (PASS < 2) {
#pragma unroll
        for (int dt = 0; dt < 2; ++dt)
#pragma unroll
            for (int i4 = 0; i4 < 4; ++i4) *(f32x4*)(ap + 32 * dt + 8 * i4) = (f32x4){O[dt][4 * i4], O[dt][4 * i4 + 1], O[dt][4 * i4 + 2], O[dt][4 * i4 + 3]};
        if (hi == 0) { mst[sidx] = m_new; lst[sidx] = l_new; }
    } else {
        const float inv = 1.0f / l_new; bf16_t* yp = ymix + (size_t)rowq * 1024 + 512 + head * 64 + 4 * hi;
#pragma unroll
        for (int dt = 0; dt < 2; ++dt)
#pragma unroll
            for (int i4 = 0; i4 < 4; ++i4) { u32x2 w; w.x = pk2(O[dt][4 * i4] * inv, O[dt][4 * i4 + 1] * inv); w.y = pk2(O[dt][4 * i4 + 2] * inv, O[dt][4 * i4 + 3] * inv); *(u32x2*)(yp + 32 * dt + 8 * i4) = w; }
    }
}
template <int PASS> __device__ __forceinline__ void dil_pass(int dilv, const bf16_t* proj, float* accst, float* mst, float* lst, bf16_t* ymix, unsigned char* lds, int wid, int lane, int gw, int ngw) {
    short* vts = (short*)(lds + wid * 4608);
    for (int u = gw; u < 8192; u += ngw) dil_unit<PASS>(u, dilv, proj, accst, mst, lst, ymix, vts, lane);
}

__device__ __forceinline__ void s5_coef(float lr, float li, float dt, float& ar, float& ai, float& cr, float& ci) {
    const float mag = expf(lr * dt); const float th = li * dt; const float kq = rintf(th * 0.15915494309189535f);
    float rr = fmaf(-kq, 6.2831854820251465f, th); rr = fmaf(-kq, -1.7484556000744883e-07f, rr);
    const float sn = __sinf(rr), cs = __cosf(rr); ar = mag * cs; ai = mag * sn;
    const float den = lr * lr + li * li, nr = ar - 1.f, ni = ai; cr = (nr * lr + ni * li) / den; ci = (ni * lr - nr * li) / den;
}
__device__ __forceinline__ float gelu_tanh(float x) { const float z = 1.5957691216057308f * (x + 0.044715f * x * x * x); return x * __builtin_amdgcn_rcpf(1.0f + __expf(-z)); }

}
#ifndef RP_ATTN
#define RP_ATTN 1
#define RP_DIL 1
#define RP_S5 1
#define RP_BAR 1
#define RP_UP 1
#define RP_PRO 1
#define RP_INP 1
#define RP_PP 1
#define RP_ELT 1
#define RP_OUT 1
#define RP_DOWN 1
#define RP_PLE 1
#define RP_GLU 1
#endif
namespace mk {
#define GAS __attribute__((address_space(1)))
struct DParams { GAS const float* in[29]; GAS float* out; GAS unsigned char* ws; };
typedef const __attribute__((address_space(4))) DParams* KArgs;
__device__ __forceinline__ void s5_phase(KArgs p, int o, const bf16_t* proj, bf16_t* yg, unsigned char* lds, int tid, int lane, int wid, int G, int bid) {
    constexpr int TC = 64, NCH = S / TC, BUP = 132, XP = 136;
    float* Bu = (float*)lds;
    bf16_t* Xs = (bf16_t*)(lds + 2 * TC * BUP * 4);
    const int r32 = lane & 31, hi = lane >> 5, l16 = lane & 15, kq = lane >> 4;
    for (int bg = bid; bg < 256; bg += G) {
        const int b = bg >> 5, g = bg & 31, og = o * 32 + g;
        const float* lam_re = (const float*)p->in[18] + og * 64; const float* lam_im = (const float*)p->in[19] + og * 64; const float dt = expf(p->in[20][og]);
        const float* b_re = (const float*)p->in[21] + (size_t)og * 1024; const float* b_im = (const float*)p->in[22] + (size_t)og * 1024;
        const float* c_re = (const float*)p->in[23] + (size_t)og * 1024; const float* c_im = (const float*)p->in[24] + (size_t)og * 1024; const float* dsk = (const float*)p->in[25] + og * 16;
        const bf16_t* ub = proj + (size_t)b * S * 2048 + g * 16;
        float ar = 0.f, ai = 0.f, xr = 0.f, xi = 0.f;
        bf16x8 Bf[4], Cf[4]; float dsc = 0.f;
        if (wid == 0) { float cr, ci; s5_coef(lam_re[lane], lam_im[lane], dt, ar, ai, cr, ci); }
        else {
#pragma unroll
            for (int nt = 0; nt < 4; ++nt) { const int pp = 16 * nt + (r32 >> 1); float a0, a1, cr, ci; s5_coef(lam_re[pp], lam_im[pp], dt, a0, a1, cr, ci);
                const f32x4 br0 = *(const f32x4*)(b_re + pp * 16 + 8 * hi), br1 = *(const f32x4*)(b_re + pp * 16 + 8 * hi + 4);
                const f32x4 bi0 = *(const f32x4*)(b_im + pp * 16 + 8 * hi), bi1 = *(const f32x4*)(b_im + pp * 16 + 8 * hi + 4);
                f32x4 v0, v1; if (r32 & 1) { v0 = cr * bi0 + ci * br0; v1 = cr * bi1 + ci * br1; } else { v0 = cr * br0 - ci * bi0; v1 = cr * br1 - ci * bi1; }
                u32x4 w; w.x = pk2(v0[0], v0[1]); w.y = pk2(v0[2], v0[3]); w.z = pk2(v1[0], v1[1]); w.w = pk2(v1[2], v1[3]); Bf[nt] = __builtin_bit_cast(bf16x8, w); }
#pragma unroll
            for (int ks = 0; ks < 4; ++ks) { const int p0 = 16 * ks + 4 * kq; const f32x4 cr4 = *(const f32x4*)(c_re + l16 * 64 + p0), ci4 = *(const f32x4*)(c_im + l16 * 64 + p0);
                u32x4 w; w.x = pk2(cr4[0], -ci4[0]); w.y = pk2(cr4[1], -ci4[1]); w.z = pk2(cr4[2], -ci4[2]); w.w = pk2(cr4[3], -ci4[3]); Cf[ks] = __builtin_bit_cast(bf16x8, w); }
            dsc = dsk[l16];
        }
#define S5_LDU(k, tt) (*(const bf16x8*)(ub + (size_t)(((k) < NCH ? (k) : NCH - 1) * TC + 32 * (tt) + r32) * 2048 + 8 * hi))
#define S5_BU(k) do { float* Bb = Bu + ((k) & 1) * TC * BUP; \
        { const int tile = wid - 1, tt = tile >> 2, nt = tile & 3; \
            const f32x16 a = __builtin_amdgcn_mfma_f32_32x32x16_bf16(ufa, nt == 0 ? Bf[0] : nt == 1 ? Bf[1] : nt == 2 ? Bf[2] : Bf[3], f32x16{}, 0, 0, 0); \
            _Pragma("unroll") for (int i = 0; i < 16; ++i) Bb[(32 * tt + crow(i, hi)) * BUP + 32 * nt + r32] = a[i]; } \
        if (wid == 1) { const f32x16 a = __builtin_amdgcn_mfma_f32_32x32x16_bf16(ufb, Bf[3], f32x16{}, 0, 0, 0); \
            _Pragma("unroll") for (int i = 0; i < 16; ++i) Bb[(32 + crow(i, hi)) * BUP + 96 + r32] = a[i]; } \
        ufa = S5_LDU((k) + 1, (wid - 1) >> 2); if (wid == 1) ufb = S5_LDU((k) + 1, 1); } while (0)
#define S5_LDUU(k) do { if (wid <= 4) { _Pragma("unroll") for (int j = 0; j < 4; ++j) uun[j] = proj[((size_t)b * S + ((k) < NCH ? (k) : NCH - 1) * TC + 16 * (wid - 1) + 4 * kq + j) * 2048 + g * 16 + l16]; } } while (0)
#define S5_CP(k) do { const bf16_t* Xb = Xs + ((k) & 1) * TC * XP; \
        if (wid <= 4) { const int tile = wid - 1; f32x4 a = (f32x4){0.f, 0.f, 0.f, 0.f}; \
            _Pragma("unroll") for (int ks = 0; ks < 4; ++ks) { const bf16x8 xf = *(const bf16x8*)(Xb + (16 * tile + l16) * XP + 32 * ks + 8 * kq); \
                a = __builtin_amdgcn_mfma_f32_16x16x32_bf16(xf, Cf[ks], a, 0, 0, 0); } \
            _Pragma("unroll") for (int j = 0; j < 4; ++j) { const size_t tok = (size_t)b * S + (k) * TC + 16 * tile + 4 * kq + j; \
                const float y = gelu_tanh(a[j] + dsc * bf1(uun[j])); \
                yg[tok * 512 + g * 16 + l16] = (bf16_t)(pk2(y, 0.f) & 0xffffu); } } \
        S5_LDUU((k) + 1); } while (0)
        bf16x8 ufa = bf16x8{}, ufb = bf16x8{}; bf16_t uun[4] = {0, 0, 0, 0};
        if (wid > 0) { ufa = S5_LDU(0, (wid - 1) >> 2); if (wid == 1) ufb = S5_LDU(0, 1); S5_LDUU(0); S5_BU(0); }
        __syncthreads();
        for (int k = 0; k < NCH; ++k) {
            if (wid == 0) {
                const float* Bb = Bu + (k & 1) * TC * BUP; bf16_t* Xb = Xs + (k & 1) * TC * XP;
                for (int t0 = 0; t0 < TC; t0 += 16) { f32x2_t bv[16];
#pragma unroll
                    for (int j = 0; j < 16; ++j) bv[j] = *(const f32x2_t*)(Bb + (t0 + j) * BUP + 2 * lane);
#pragma unroll
                    for (int j = 0; j < 16; ++j) { const float nr = fmaf(ar, xr, fmaf(-ai, xi, bv[j].x)), ni = fmaf(ar, xi, fmaf(ai, xr, bv[j].y)); xr = nr; xi = ni;
                        *(unsigned*)(Xb + (t0 + j) * XP + 2 * lane) = pk2(xr, xi); } }
            } else {
                if (k + 1 < NCH) S5_BU(k + 1);
                if (k >= 1) S5_CP(k - 1);
            }
            __syncthreads();
        }
        if (wid > 0) S5_CP(NCH - 1);
        __syncthreads();
#undef S5_BU
#undef S5_LDU
#undef S5_LDUU
#undef S5_CP
    }
}
__device__ __forceinline__ void conv_phase(const float* cw, const bf16_t* proj, bf16_t* ymix, int gtid, int nthr) {
    for (int idx = gtid; idx < T * 64; idx += nthr) { const int t = idx >> 6, c8 = (idx & 63) * 8, s = t & (S - 1);
        const bf16_t* row = proj + (size_t)t * 2048;
        float y[8];
#pragma unroll
        for (int e = 0; e < 8; ++e) y[e] = 0.f;
#pragma unroll
        for (int j = 0; j < 3; ++j) if (s - j >= 0) { const u32x4 gc = *(const u32x4*)(row - (size_t)j * 2048 + 1024 + c8), xt = *(const u32x4*)(row - (size_t)j * 2048 + 1536 + c8);
            const f32x4 w0 = *(const f32x4*)(cw + j * 512 + c8), w1 = *(const f32x4*)(cw + j * 512 + c8 + 4);
            y[0] += w0[0] * bflo(gc.x) * bflo(xt.x); y[1] += w0[1] * bfhi(gc.x) * bfhi(xt.x); y[2] += w0[2] * bflo(gc.y) * bflo(xt.y); y[3] += w0[3] * bfhi(gc.y) * bfhi(xt.y);
            y[4] += w1[0] * bflo(gc.z) * bflo(xt.z); y[5] += w1[1] * bfhi(gc.z) * bfhi(xt.z); y[6] += w1[2] * bflo(gc.w) * bflo(xt.w); y[7] += w1[3] * bfhi(gc.w) * bfhi(xt.w); }
        const u32x4 gb = *(const u32x4*)(row + 512 + c8); u32x4 o;
        o.x = pk2(y[0] * bflo(gb.x), y[1] * bfhi(gb.x)); o.y = pk2(y[2] * bflo(gb.y), y[3] * bfhi(gb.y)); o.z = pk2(y[4] * bflo(gb.z), y[5] * bfhi(gb.z)); o.w = pk2(y[6] * bflo(gb.w), y[7] * bfhi(gb.w));
        *(u32x4*)(ymix + (size_t)t * 1024 + 512 + c8) = o; }
}
__device__ __forceinline__ void diff_post(KArgs p, int e, float lam_init, const bf16_t* O16, bf16_t* ymix, int lane, int gtid, int nthr) {
    float a = p->in[11][e * 64 + lane] * p->in[12][e * 64 + lane], bb = p->in[13][e * 64 + lane] * p->in[14][e * 64 + lane];
    a = wave_sum(a); bb = wave_sum(bb);
    const float lam = expf(a) - expf(bb) + lam_init; const float* gain = (const float*)p->in[15] + e * 128;
    const int j = gtid & 15, vhalf = j >> 3, dd = (j & 7) * 8;
    const f32x4 g0 = *(const f32x4*)(gain + 8 * j), g1 = *(const f32x4*)(gain + 8 * j + 4);
    for (int grp = gtid >> 4; grp < T * 4; grp += nthr >> 4) { const int t = grp >> 2, h = grp & 3;
        const u32x4 o1 = *(const u32x4*)(O16 + (size_t)t * 1024 + ((h * 2 + 0) * 2 + vhalf) * 64 + dd), o2 = *(const u32x4*)(O16 + (size_t)t * 1024 + ((h * 2 + 1) * 2 + vhalf) * 64 + dd);
        float v[8];
        v[0] = bflo(o1.x) - lam * bflo(o2.x); v[1] = bfhi(o1.x) - lam * bfhi(o2.x); v[2] = bflo(o1.y) - lam * bflo(o2.y); v[3] = bfhi(o1.y) - lam * bfhi(o2.y);
        v[4] = bflo(o1.z) - lam * bflo(o2.z); v[5] = bfhi(o1.z) - lam * bfhi(o2.z); v[6] = bflo(o1.w) - lam * bflo(o2.w); v[7] = bfhi(o1.w) - lam * bfhi(o2.w);
        float ss = 0.f;
#pragma unroll
        for (int q = 0; q < 8; ++q) ss += v[q] * v[q];
        ss = xor_add<1>(ss); ss = xor_add<2>(ss); ss = xor_add<4>(ss); ss = xor_add<8>(ss);
        const float rs = rsqrtf(ss * (1.0f / 128.0f) + 1e-5f) * (1.0f - lam_init);
        u32x4 o; o.x = pk2(v[0] * rs * g0[0], v[1] * rs * g0[1]); o.y = pk2(v[2] * rs * g0[2], v[3] * rs * g0[3]); o.z = pk2(v[4] * rs * g1[0], v[5] * rs * g1[1]); o.w = pk2(v[6] * rs * g1[2], v[7] * rs * g1[3]);
        *(u32x4*)(ymix + (size_t)t * 1024 + h * 128 + 8 * j) = o; }
}

__device__ __forceinline__ KArgs kargs() { KArgs k = (KArgs)__builtin_amdgcn_kernarg_segment_ptr(); asm volatile("" : "+s"(k)); return k; }
constexpr size_t WS_BAR = WS_WM + 8 * MiB + 6 * MiB + MiB / 2;
constexpr int LDS_XB = 131072 + 1024;
#define LAS __attribute__((address_space(3)))
#define XB_TMO      128
#define XB_XCNT(j)  (256  + 64 * (j))
#define XB_XSUB(j)  (1280 + 64 * (j))
#define XB_XGEN(j)  (2304 + 64 * (j))
#define XB_TOP      3328
#define XB_TOPGEN   3392
#define XCD_BAR_WORDS 3456
#define XB_SPIN_CAP (1u << 18)

__device__ __forceinline__ unsigned xb_ld(unsigned* p)              { return __hip_atomic_load(p, __ATOMIC_RELAXED, __HIP_MEMORY_SCOPE_AGENT); }
__device__ __forceinline__ unsigned xb_add(unsigned* p, unsigned v) { return __hip_atomic_fetch_add(p, v, __ATOMIC_RELAXED, __HIP_MEMORY_SCOPE_AGENT); }
__device__ __forceinline__ unsigned xb_xcc_id() { return (unsigned)__builtin_amdgcn_s_getreg((3 << 11) | 20) & 0xFu; }
#define XB_SPIN(cond, bar) do { unsigned _sp = 0; while (cond) { __builtin_amdgcn_s_sleep(1); \
    if ((++_sp & 255u) == 0u) { if (xb_ld(&(bar)[XB_TMO])) break; if (_sp > XB_SPIN_CAP) { atomicAdd(&(bar)[XB_TMO], 1u); break; } } } } while (0)

struct XcdBarrier {
    unsigned* bar; unsigned x;
    volatile LAS unsigned* st;
};

__device__ __forceinline__ XcdBarrier xcd_barrier_post(unsigned* bar, volatile LAS unsigned* st) {
    XcdBarrier b; b.bar = bar; b.x = xb_xcc_id(); b.st = st;
    if (threadIdx.x == 0) (void)xb_add(&bar[XB_XCNT(b.x)], 1u);
    return b;
}
__device__ __forceinline__ void xcd_barrier_complete(unsigned* bar, unsigned x, unsigned& nloc, unsigned& nx) {
    const unsigned G = gridDim.x * gridDim.y * gridDim.z;
    unsigned sum, cnt, mine, sp = 0u;
    for (;;) {
        sum = 0u; cnt = 0u; mine = 0u;
#pragma unroll
        for (unsigned j = 0; j < 16; ++j) { const unsigned c = xb_ld(&bar[XB_XCNT(j)]); sum += c; cnt += (c > 0u) ? 1u : 0u; mine = (j == x) ? c : mine; }
        if (sum == G) break;
        __builtin_amdgcn_s_sleep(1);
        if ((++sp & 255u) == 0u) { if (xb_ld(&bar[XB_TMO])) break; if (sp > XB_SPIN_CAP) { atomicAdd(&bar[XB_TMO], 1u); break; } }
    }
    nloc = mine > 0u ? mine : 1u; nx = cnt > 0u ? cnt : 1u;
}

__device__ __forceinline__ void xcd_barrier(const XcdBarrier& b) {
    asm volatile("s_waitcnt vmcnt(0)" ::: "memory");
    __syncthreads();
    if (threadIdx.x == 0) {
        unsigned* bar = b.bar;
        __builtin_amdgcn_s_waitcnt(0);
        unsigned nloc = b.st[0], nx = b.st[1];
        if (nloc == 0u) { xcd_barrier_complete(bar, b.x, nloc, nx); b.st[0] = nloc; b.st[1] = nx; }
        const unsigned old = xb_add(&bar[XB_XSUB(b.x)], 1u);
        const unsigned gen = old / nloc;
        if (old + 1u == (gen + 1u) * nloc) {
            __builtin_amdgcn_fence(__ATOMIC_RELEASE, "agent");
            asm volatile("s_waitcnt vmcnt(0)" ::: "memory");
            const unsigned og = xb_add(&bar[XB_TOP], 1u);
            const unsigned tg = og / nx;
            if (og + 1u == (tg + 1u) * nx) xb_add(&bar[XB_TOPGEN], 1u);
            else XB_SPIN(xb_ld(&bar[XB_TOPGEN]) == tg, bar);
            __builtin_amdgcn_fence(__ATOMIC_ACQUIRE, "agent");
            xb_add(&bar[XB_XGEN(b.x)], 1u);
            asm volatile("s_waitcnt vmcnt(0)" ::: "memory");
        } else {
            XB_SPIN(xb_ld(&bar[XB_XGEN(b.x)]) == gen, bar);
            __builtin_amdgcn_fence(__ATOMIC_ACQUIRE, "agent");
            asm volatile("s_waitcnt vmcnt(0)" ::: "memory");
        }
    }
    __syncthreads();
}

__device__ __forceinline__ void grid_bar1(unsigned) {
    XcdBarrier xbv; xbv.bar = (unsigned*)((unsigned char*)kargs()->ws + WS_BAR); xbv.x = xb_xcc_id(); xbv.st = (volatile LAS unsigned*)(LDS_XB);
    xcd_barrier(xbv);
}
__device__ __forceinline__ void grid_bar(unsigned epoch) { for (int rp = 0; rp < RP_BAR; ++rp) grid_bar1(epoch); }
#define PH_BEGIN KArgs ka = kargs(); unsigned char* ws = (unsigned char*)ka->ws; int tid = threadIdx.x; asm volatile("" : "+v"(tid)); int bid = blockIdx.x; asm volatile("" : "+s"(bid)); const int lane = tid & 63, wid = __builtin_amdgcn_readfirstlane(tid >> 6), G = gridDim.x; \
    const int gw = bid * 8 + wid, ngw = G * 8, gtid = bid * 512 + tid, nthr = G * 512; (void)lane; (void)gw; (void)ngw; (void)gtid; (void)nthr; (void)ws;
#define WL(i) (ws + WS_W + (size_t)(i) * WS_WL)
#define WM(i) (ws + WS_WM + (size_t)(i) * 8 * MiB)
#define SBUF(j) ((bf16_t*)ka->out + (size_t)((j) & 1) * T * 1024)
#define SSQ(k) ((float*)(ws + WS_SSQ + (size_t)((k) & 1) * 2 * MiB))
template <int i> __device__ __forceinline__ void layer_body(unsigned char* lds, PG8_LAS unsigned char* ldsp) {
    unsigned ep = (i == 0 ? 0u : i == 1 ? 8u : i == 2 ? 15u : 23u);
        for (int rp = 0; rp < RP_INP; ++rp) { PH_BEGIN const bool odd = (i & 1) != 0; const int N = odd ? 2048 : 3072;
            pg8::Gemm g{SBUF(i), (const bf16_t*)WM(i), T, N, 1024};     pg8::StaticOrder SO; SO.init(T, N, G, bid);
            pg8::EpiRow<0> E{(bf16_t*)(ws + WS_BIG), odd ? 2048 : 512, SSQ(3 * i), odd ? 0u : 0xC3u, C2, odd ? 0 : 512, TSQ};
            pg8::gemm_phase<pg8::EpiRow<0>, pg8::StaticOrder, true, true>(ldsp, g, SO, E); }
        grid_bar(++ep);
        if ((i & 1) == 0) {
            { PH_BEGIN const int vcu0 = (G % 8 == 0) ? (bid % 8) * (G / 8) + (bid / 8) : bid;
                for (int rp = 0; rp < RP_ATTN; ++rp) for (int vcu = vcu0; vcu < 256; vcu += G) { const int pair = vcu >> 1, s = vcu & 1, b = pair >> 4, vh = pair & 15, h = vh >> 2, c = (vh >> 1) & 1, vhalf = vh & 1;
                    for (int it = 0; it < 8; ++it) { const int j = s + 2 * (it >> 1), qb = (it & 1) ? 15 - j : j;
                        const attn_body::bf16* P = (const attn_body::bf16*)((unsigned char*)kargs()->ws + WS_BIG);
                        attn_body::attn_unit<8>(b, 0, qb, P + h * 128 + c * 64, P + TSQ + h * 128 + c * 64, P + 2 * TSQ + h * 128 + vhalf * 64, (attn_body::bf16*)((unsigned char*)kargs()->ws + WS_O16) + vh * 64, (char*)lds); } } }
            __syncthreads();
            { PH_BEGIN float* dm = (float*)(ws + WS_DML);
                for (int rp = 0; rp < RP_DIL; ++rp) dil_pass<0>(1, (const bf16_t*)(ws + WS_BIG), (float*)(ws + WS_HB), dm, dm + (size_t)T * 8, (bf16_t*)(ws + WS_YMIX), lds, wid, lane, gw, ngw);
                convert_p((const float*)ka->in[1] + (size_t)i * T * 256, (bf16_t*)(ws + WS_PB), gtid, nthr); }
            grid_bar(++ep);
            { PH_BEGIN float* dm = (float*)(ws + WS_DML);
                dil_pass<1>(4, (const bf16_t*)(ws + WS_BIG), (float*)(ws + WS_HB), dm, dm + (size_t)T * 8, (bf16_t*)(ws + WS_YMIX), lds, wid, lane, gw, ngw); }
            grid_bar(++ep);
            { PH_BEGIN float* dm = (float*)(ws + WS_DML);
                dil_pass<2>(16, (const bf16_t*)(ws + WS_BIG), (float*)(ws + WS_HB), dm, dm + (size_t)T * 8, (bf16_t*)(ws + WS_YMIX), lds, wid, lane, gw, ngw); }
            { PH_BEGIN const float lam_init = 0.8f - 0.6f * expf(-0.3f * (float)i);
                for (int rp = 0; rp < RP_ELT; ++rp) diff_post(ka, i >> 1, lam_init, (const bf16_t*)(ws + WS_O16), (bf16_t*)(ws + WS_YMIX), lane, gtid, nthr); }
            grid_bar(++ep);
        } else {
            for (int rp = 0; rp < RP_S5; ++rp) { PH_BEGIN s5_phase(ka, i >> 1, (const bf16_t*)(ws + WS_BIG), (bf16_t*)(ws + WS_HB), lds, tid, lane, wid, G, bid); }
            for (int rp = 0; rp < RP_ELT; ++rp) { PH_BEGIN conv_phase((const float*)ka->in[27] + (i >> 1) * 3 * 512, (const bf16_t*)(ws + WS_BIG), (bf16_t*)(ws + WS_YMIX), gtid, nthr);
                convert_p((const float*)ka->in[1] + (size_t)i * T * 256, (bf16_t*)(ws + WS_PB), gtid, nthr); }
            grid_bar(++ep);
            for (int rp = 0; rp < RP_GLU; ++rp) { PH_BEGIN pg8::Gemm g{(const bf16_t*)(ws + WS_HB), (const bf16_t*)(WM(i) + 6 * MiB), T, 512, 512}; pg8::StaticOrder SO; SO.init(T, 512, G, bid);
                pg8::EpiGlu E{(bf16_t*)(ws + WS_YMIX), (const bf16_t*)(ws + WS_HB)};
                pg8::gemm_phase<pg8::EpiGlu, pg8::StaticOrder, true, true>(ldsp, g, SO, E); }
            grid_bar(++ep);
        }
        for (int rp = 0; rp < RP_OUT; ++rp) { PH_BEGIN const bool odd = (i & 1) != 0;
            pg8::Gemm g{(const bf16_t*)(ws + WS_YMIX), (const bf16_t*)(WM(i) + (odd ? 4 : 6) * MiB), T, 1024, 1024}; pg8::StaticOrder SO; SO.init(T, 1024, G, bid);
            pg8::EpiRes<0> E{SBUF(i), (rp < RP_OUT - 1) ? (bf16_t*)(ws + WS_HB) : SBUF(i), SSQ(3 * i + 1), nullptr, nullptr};
            pg8::gemm_phase<pg8::EpiRes<0>, pg8::StaticOrder, true, true>(ldsp, g, SO, E); }
        grid_bar(++ep);
        for (int rp = 0; rp < RP_UP; ++rp) { PH_BEGIN pg8::Gemm g{SBUF(i), (const bf16_t*)WL(i), T, 4096, 1024}; pg8::StaticOrder SO; SO.init(T, 4096, G, bid);
            pg8::EpiRow<1> E{(bf16_t*)(ws + WS_BIG), 4096, SSQ(3 * i + 1), 0u, 1.f, 0, 0};
            pg8::gemm_phase<pg8::EpiRow<1>, pg8::StaticOrder, true, true>(ldsp, g, SO, E); }
        grid_bar(++ep);
        for (int rp = 0; rp < RP_DOWN; ++rp) { PH_BEGIN pg8::Gemm g{(const bf16_t*)(ws + WS_BIG), (const bf16_t*)(WL(i) + 8 * MiB), T, 1024, 4096}; pg8::StaticOrder SO; SO.init(T, 1024, G, bid); SO.rev = 1;
            pg8::EpiRes<0> E{SBUF(i), (rp < RP_DOWN - 1) ? (bf16_t*)(ws + WS_HB) : SBUF(i), SSQ(3 * i + 2), nullptr, nullptr};
            pg8::gemm_phase<pg8::EpiRes<0>, pg8::StaticOrder, true, true>(ldsp, g, SO, E); }
        for (int rp = 0; rp < RP_PP; ++rp) { PH_BEGIN pg8::Gemm g{(const bf16_t*)(ws + WS_PB), (const bf16_t*)(WL(i) + 18 * MiB), T, 1024, 256}; pg8::StaticOrder SO; SO.init(T, 1024, G, bid);
            pg8::EpiPP E{(bf16_t*)(ws + WS_YMIX)};
            pg8::gemm_phase<pg8::EpiPP, pg8::StaticOrder, true, true>(ldsp, g, SO, E); }
        grid_bar(++ep);
        for (int rp = 0; rp < RP_PLE; ++rp) { PH_BEGIN pg8::Gemm g{SBUF(i), (const bf16_t*)(WL(i) + 16 * MiB), T, 1024, 1024}; pg8::StaticOrder SO; SO.init(T, 1024, G, bid);
            pg8::EpiRes<1> E{SBUF(i), (rp < RP_PLE - 1) ? (bf16_t*)(ws + WS_BIG) : (i == 3) ? (bf16_t*)(ws + WS_HB) : SBUF(i + 1), SSQ(3 * i + 3), SSQ(3 * i + 2), (const bf16_t*)(ws + WS_YMIX)};
            pg8::gemm_phase<pg8::EpiRes<1>, pg8::StaticOrder, true, true>(ldsp, g, SO, E); }
        grid_bar(++ep);
}
__global__ void __launch_bounds__(512, 2) fwd(Params p_unused) {
    extern __shared__ __attribute__((aligned(16))) unsigned char lds[];
    PG8_LAS unsigned char* ldsp = (PG8_LAS unsigned char*)lds;
    for (int rp = 0; rp < RP_PRO; ++rp) {
    { PH_BEGIN
        float* ssq = SSQ(0); bf16_t* hb = SBUF(0); const float* x = (const float*)ka->in[0];
        { f32x4 vn[4]; int m = gw;
            if (m < T) { const f32x4* xr = (const f32x4*)(x + (size_t)m * 1024) + lane;
#pragma unroll
                for (int j = 0; j < 4; ++j) vn[j] = __builtin_nontemporal_load(xr + 64 * j); }
            for (; m < T; m += ngw) { f32x4 v[4]; float s = 0.f;
#pragma unroll
                for (int j = 0; j < 4; ++j) v[j] = vn[j];
                if (m + ngw < T) { const f32x4* xn = (const f32x4*)(x + (size_t)(m + ngw) * 1024) + lane;
#pragma unroll
                    for (int j = 0; j < 4; ++j) vn[j] = __builtin_nontemporal_load(xn + 64 * j); }
#pragma unroll
                for (int j = 0; j < 4; ++j) s += (v[j][0] * v[j][0] + v[j][1] * v[j][1]) + (v[j][2] * v[j][2] + v[j][3] * v[j][3]);
                s = wave_sum(s); if (lane < 16) ssq[(size_t)m * 16 + lane] = (lane == 0) ? s : 0.f;
                u32x2* o8 = (u32x2*)(hb + (size_t)m * 1024) + lane;
#pragma unroll
                for (int j = 0; j < 4; ++j) { u32x2 w; w.x = pk2(v[j][0], v[j][1]); w.y = pk2(v[j][2], v[j][3]); o8[64 * j] = w; } } } }
    for (int i = 0; i < 4; ++i) { PH_BEGIN
        float* scr = (float*)(lds + wid * 8448); unsigned char* wl = WL(i); unsigned char* wm = WM(i); const int e = i >> 1;
        transpose_items((const float*)ka->in[5] + (size_t)i * 1024 * 4096, 1024, 4096, (const float*)ka->in[3] + i * 1024, (bf16_t*)wl, scr, gw, ngw, lane);
        transpose_items((const float*)ka->in[6] + (size_t)i * 1024 * 4096, 4096, 1024, nullptr, (bf16_t*)(wl + 8 * MiB), scr, gw, ngw, lane);
        transpose_items((const float*)ka->in[8] + (size_t)i * 1024 * 1024, 1024, 1024, (const float*)ka->in[4] + i * 1024, (bf16_t*)(wl + 16 * MiB), scr, gw, ngw, lane);
        transpose_items((const float*)ka->in[7] + (size_t)i * 256 * 1024, 256, 1024, nullptr, (bf16_t*)(wl + 18 * MiB), scr, gw, ngw, lane);
        if ((i & 1) == 0) {
            transpose_items((const float*)ka->in[9] + (size_t)e * 1024 * 3072, 1024, 3072, (const float*)ka->in[2] + i * 1024, (bf16_t*)wm, scr, gw, ngw, lane);
            transpose_items((const float*)ka->in[10] + (size_t)e * 1024 * 1024, 1024, 1024, nullptr, (bf16_t*)(wm + 6 * MiB), scr, gw, ngw, lane);
        } else {
            transpose_items((const float*)ka->in[16] + (size_t)e * 1024 * 2048, 1024, 2048, (const float*)ka->in[2] + i * 1024, (bf16_t*)wm, scr, gw, ngw, lane);
            transpose_items((const float*)ka->in[17] + (size_t)e * 1024 * 1024, 1024, 1024, nullptr, (bf16_t*)(wm + 4 * MiB), scr, gw, ngw, lane);
            transpose_items((const float*)ka->in[26] + (size_t)e * 512 * 512, 512, 512, nullptr, (bf16_t*)(wm + 6 * MiB), scr, gw, ngw, lane);
        } }
    }
    { KArgs ka0 = kargs(); unsigned* bw = (unsigned*)((unsigned char*)ka0->ws + WS_BAR);
        if (blockIdx.x == 0) for (int w = threadIdx.x; w < XCD_BAR_WORDS; w += 512) __hip_atomic_store(bw + w, 0u, __ATOMIC_RELAXED, __HIP_MEMORY_SCOPE_AGENT);
        if (threadIdx.x < 2) ((volatile LAS unsigned*)(LDS_XB))[threadIdx.x] = 0u; }
    cg::this_grid().sync();
    { KArgs ka0 = kargs(); (void)xcd_barrier_post((unsigned*)((unsigned char*)ka0->ws + WS_BAR), (volatile LAS unsigned*)(LDS_XB)); }
    layer_body<0>(lds, ldsp); layer_body<1>(lds, ldsp); layer_body<2>(lds, ldsp); layer_body<3>(lds, ldsp);
    { PH_BEGIN const float* gf = (const float*)ka->in[28]; const float* sq = SSQ(12); float* hf = (float*)ka->out; const bf16_t* hs = (const bf16_t*)(ws + WS_HB);
        for (int m = gw; m < T; m += ngw) { f32x4* xr = (f32x4*)(hf + (size_t)m * 1024) + lane; const u32x2* hr = (const u32x2*)(hs + (size_t)m * 1024) + lane; const float rs = rsqrtf(pg8::ssq16(sq, m) * (1.0f / 1024.0f) + 1e-6f);
#pragma unroll
            for (int j = 0; j < 4; ++j) { const f32x4 gv = ((const f32x4*)gf)[lane + 64 * j]; const u32x2 hv = hr[64 * j]; xr[64 * j] = (f32x4){bflo(hv.x), bfhi(hv.x), bflo(hv.y), bfhi(hv.y)} * rs * gv; } } }
}
}

extern "C" void kernel_launch(void* const* d_in, const int* in_sizes, int n_in, void* d_out, int out_size, void* d_ws, size_t ws_size, hipStream_t stream) {
    static int grid_blocks = 0;
    if (!grid_blocks) {
        int dev = 0, cus = 0, per_cu = 0;
        (void)hipGetDevice(&dev);
        (void)hipDeviceGetAttribute(&cus, hipDeviceAttributeMultiprocessorCount, dev);
        (void)hipFuncSetAttribute((const void*)mk::fwd, hipFuncAttributeMaxDynamicSharedMemorySize, mk::LDS_BYTES);
        (void)hipOccupancyMaxActiveBlocksPerMultiprocessor(&per_cu, (const void*)mk::fwd, 512, mk::LDS_BYTES);
        (void)hipGetLastError();
        grid_blocks = cus > 0 ? cus : 256;
        if (ws_size < mk::WS_END || n_in != 29) { fprintf(stderr, "kernel_launch: workspace %zu < %zu or n_in %d != 29\n", ws_size, (size_t)mk::WS_END, n_in); }
    }
    (void)hipMemsetAsync((unsigned char*)d_ws + mk::WS_BAR, 0, 256, stream);
    mk::Params p{};
    for (int i = 0; i < 29; ++i) p.in[i] = (const float*)d_in[i];
    p.out = (float*)d_out; p.ws = (unsigned char*)d_ws;
    void* args[] = {&p};
    hipError_t e = hipLaunchCooperativeKernel((const void*)mk::fwd, dim3(grid_blocks), dim3(512), args, mk::LDS_BYTES, stream);
    if (e != hipSuccess) fprintf(stderr, "cooperative launch failed: %s (grid %d)\n", hipGetErrorString(e), grid_blocks);
}
```
